# Optimizing an MI355X kernel written in HIP

```python
import jax
import jax.numpy as jnp
from jax import lax
import numpy as np

D_MODEL = 1024
BATCH = 32
SEQ = 2048
DEPTH = 4

MLSTM_HEADS = 4
MLSTM_DH = 64
MLSTM_CHUNK = 64
CONV_K = 4
HGRN_HEADS = 4
HGRN_DK = 64
HGRN_DV = 64
HGRN_CHUNK = 32
SWA_Q_HEADS = 8
SWA_KV_HEADS = 2
SWA_DH = 64
WINDOW = 128
ROPE_THETA = 500000.0
ROT_DIM = SWA_DH // 4
D_FF = 4 * D_MODEL
PLE_DIM = 256
EPS = 1e-6

MLSTM_W = MLSTM_HEADS * MLSTM_DH
HGRN_KW = HGRN_HEADS * HGRN_DK
HGRN_VW = HGRN_HEADS * HGRN_DV
SWA_QW = SWA_Q_HEADS * SWA_DH
SWA_KVW = SWA_KV_HEADS * SWA_DH
MIX_W = MLSTM_W + HGRN_VW + SWA_QW
IN_SPLITS = (MLSTM_W, MLSTM_W, MLSTM_W, MLSTM_W, MLSTM_HEADS, MLSTM_HEADS,
             HGRN_KW, HGRN_KW, HGRN_VW, HGRN_VW, SWA_QW, SWA_KVW, SWA_KVW)
IN_W = 4 * MLSTM_W + 2 * MLSTM_HEADS + 2 * HGRN_KW + 2 * HGRN_VW + SWA_QW + 2 * SWA_KVW

kernel_name = "hybrid_mlstm_hgrn2_swa_trunk"


def _rms_norm(x, g):
    xf = x.astype(jnp.float32)
    y = xf * lax.rsqrt(jnp.mean(xf * xf, axis=-1, keepdims=True) + EPS) * g.astype(jnp.float32)
    return y.astype(x.dtype)


def _head_rms_norm(x, g, n_heads):
    B, S, W = x.shape
    d = W // n_heads
    y = _rms_norm(x.reshape(B, S, n_heads, d), g.reshape(n_heads, d))
    return y.reshape(B, S, W)


def _split_cols(y, sizes):
    out = []
    o = 0
    for s in sizes:
        out.append(y[..., o:o + s])
        o += s
    return out


def _heads(t, n_heads):
    B, S, W = t.shape
    return t.reshape(B, S, n_heads, W // n_heads)


def _to_chunks(t, L):
    B, S, H = t.shape[:3]
    t = t.reshape((B, S // L, L, H) + t.shape[3:])
    return jnp.moveaxis(t, (1, 3), (0, 2))


def _from_chunks(t):
    nc, B, H, L, d = t.shape
    return jnp.moveaxis(t, (0, 2), (1, 3)).reshape(B, nc * L, H * d)


def _causal_conv(u, w, b):
    K = w.shape[0]
    y = lax.conv_general_dilated(u, w[:, None, :].astype(u.dtype), window_strides=(1,),
                                 padding=[(K - 1, 0)], dimension_numbers=('NWC', 'WIO', 'NWC'),
                                 feature_group_count=u.shape[-1])
    return y + b.astype(u.dtype)


def _rope_tables(positions):
    inv_freq = ROPE_THETA ** (-jnp.arange(0, ROT_DIM, 2, dtype=jnp.float32) / ROT_DIM)
    ang = positions.astype(jnp.float32)[..., None] * inv_freq
    return jnp.cos(ang)[:, :, None, :], jnp.sin(ang)[:, :, None, :]


def _partial_rope(x, cos, sin):
    xf = x.astype(jnp.float32)
    half = ROT_DIM // 2
    x1, x2, rest = xf[..., :half], xf[..., half:ROT_DIM], xf[..., ROT_DIM:]
    y = jnp.concatenate([x1 * cos - x2 * sin, x2 * cos + x1 * sin, rest], axis=-1)
    return y.astype(x.dtype)


def mlstm_chunkwise(q, k, v, i_pre, f_pre):
    f32 = jnp.float32
    B, S, H, dk = q.shape
    dv = v.shape[-1]
    L = MLSTM_CHUNK
    xs = (_to_chunks(q.astype(f32), L), _to_chunks(k.astype(f32), L), _to_chunks(v.astype(f32), L),
          _to_chunks(i_pre.astype(f32), L), _to_chunks(jax.nn.log_sigmoid(f_pre.astype(f32)), L))
    causal = jnp.tril(jnp.ones((L, L), dtype=bool))

    def step(carry, inp):
        C, n, m = carry
        q_, k_, v_, i_, lf = inp
        b = jnp.cumsum(lf, axis=-1)
        dmat = jnp.where(causal, b[..., :, None] - b[..., None, :] + i_[..., None, :], -jnp.inf)
        inter = b + m[..., None]
        m_j = jnp.maximum(inter, jnp.max(dmat, axis=-1))
        w_intra = jnp.exp(dmat - m_j[..., None])
        w_inter = jnp.exp(inter - m_j)
        s = jnp.einsum('bhld,bhsd->bhls', q_, k_) * w_intra
        num = jnp.einsum('bhls,bhse->bhle', s, v_) + w_inter[..., None] * jnp.einsum('bhld,bhde->bhle', q_, C)
        den = jnp.sum(s, axis=-1) + w_inter * jnp.einsum('bhld,bhd->bhl', q_, n)
        h = num / jnp.maximum(jnp.abs(den), jnp.exp(-m_j))[..., None]
        m_new = m_j[..., -1]
        w_s = jnp.exp(b[..., -1:] - b + i_ - m_new[..., None])
        decay = jnp.exp(b[..., -1] + m - m_new)
        C_new = decay[..., None, None] * C + jnp.einsum('bhs,bhsd,bhse->bhde', w_s, k_, v_)
        n_new = decay[..., None] * n + jnp.einsum('bhs,bhsd->bhd', w_s, k_)
        return (C_new, n_new, m_new), h

    init = (jnp.zeros((B, H, dk, dv), f32), jnp.zeros((B, H, dk), f32), jnp.zeros((B, H), f32))
    _, h = lax.scan(step, init, xs)
    return _from_chunks(h)


def hgrn2_chunkwise(q, f_pre, inp, lb):
    f32 = jnp.float32
    B, S, H, dk = q.shape
    dv = inp.shape[-1]
    L = HGRN_CHUNK
    fp = f_pre.astype(f32)
    lb = lb.astype(f32)
    log_f = jnp.logaddexp(jnp.log(lb), jnp.log1p(-lb) + jax.nn.log_sigmoid(fp))
    key = (1.0 - lb) * jax.nn.sigmoid(-fp)
    qf = jax.nn.silu(q.astype(f32))
    xs = (_to_chunks(qf, L), _to_chunks(key, L), _to_chunks(inp.astype(f32), L), _to_chunks(log_f, L))
    causal = jnp.tril(jnp.ones((L, L), dtype=bool))[:, :, None]

    def step(S_state, chunk):
        q_, k_, v_, lf = chunk
        G = jnp.cumsum(lf, axis=2)
        inter = jnp.einsum('bhld,bhde->bhle', q_ * jnp.exp(G), S_state)
        diff = G[:, :, :, None, :] - G[:, :, None, :, :]
        decay = jnp.exp(jnp.where(causal, diff, -jnp.inf))
        A = jnp.einsum('bhld,bhlsd,bhsd->bhls', q_, decay, k_)
        o = inter + jnp.einsum('bhls,bhse->bhle', A, v_)
        G_last = G[:, :, -1]
        S_new = jnp.exp(G_last)[..., None] * S_state + jnp.einsum(
            'bhsd,bhse->bhde', k_ * jnp.exp(G_last[:, :, None] - G), v_)
        return S_new, o

    _, o = lax.scan(step, jnp.zeros((B, H, dk, dv), f32), xs)
    return _from_chunks(o)


def swa_sink_attention(q, k, v, sinks):
    B, S, HQ, d = q.shape
    HKV = k.shape[2]
    G = HQ // HKV
    W = WINDOW
    nb = S // W
    qb = q.reshape(B, nb, W, HKV, G, d)
    kb = k.reshape(B, nb, W, HKV, d)
    vb = v.reshape(B, nb, W, HKV, d)
    kk = jnp.concatenate([jnp.concatenate([jnp.zeros_like(kb[:, :1]), kb[:, :-1]], axis=1), kb], axis=2)
    vv = jnp.concatenate([jnp.concatenate([jnp.zeros_like(vb[:, :1]), vb[:, :-1]], axis=1), vb], axis=2)
    s = jnp.einsum('bnqhgd,bnkhd->bnhgqk', qb, kk).astype(jnp.float32) * (d ** -0.5)
    qi = jnp.arange(W)[:, None]
    ki = jnp.arange(2 * W)[None, :]
    blk = jnp.arange(nb)[:, None, None]
    mask = (ki > qi) & (ki <= qi + W) & ((blk > 0) | (ki >= W))
    s = jnp.where(mask[None, :, None, None], s, -jnp.inf)
    sink = sinks.astype(jnp.float32).reshape(HKV, G)[None, None, :, :, None, None]
    m = jnp.maximum(jnp.max(s, axis=-1, keepdims=True), sink)
    pexp = jnp.exp(s - m)
    probs = pexp / (jnp.sum(pexp, axis=-1, keepdims=True) + jnp.exp(sink - m))
    o = jnp.einsum('bnhgqk,bnkhd->bnqhgd', probs.astype(v.dtype), vv)
    return o.reshape(B, S, HQ * d)


def setup_inputs(seed: int = 0) -> dict:
    key = jax.random.key(seed)
    ks = jax.random.split(key, 24)
    f32 = jnp.float32
    nrm = lambda k, shape, scale: jax.random.normal(k, shape, f32) * scale
    x = nrm(ks[0], (BATCH, SEQ, D_MODEL), 1.0)
    p = nrm(ks[1], (DEPTH, BATCH, SEQ, PLE_DIM), 1.0)
    start = jax.random.randint(ks[2], (BATCH, 1), 0, 4096, dtype=jnp.int32)
    positions = (start + jnp.arange(SEQ, dtype=jnp.int32)[None, :]).astype(jnp.int32)
    return {
        "x": x,
        "p": p,
        "positions": positions,
        "in_norm_g": 1.0 + nrm(ks[3], (DEPTH, D_MODEL), 0.05),
        "w_in": nrm(ks[4], (DEPTH, D_MODEL, IN_W), D_MODEL ** -0.5),
        "b_in": nrm(ks[5], (DEPTH, IN_W), 0.02),
        "mlstm_f_bias": jnp.linspace(3.0, 6.0, MLSTM_HEADS, dtype=f32)[None, :] + nrm(ks[6], (DEPTH, MLSTM_HEADS), 0.1),
        "mlstm_conv_w": nrm(ks[7], (DEPTH, CONV_K, 2 * MLSTM_W), CONV_K ** -0.5),
        "mlstm_conv_b": nrm(ks[8], (DEPTH, 2 * MLSTM_W), 0.02),
        "mlstm_norm_g": 1.0 + nrm(ks[9], (DEPTH, MLSTM_W), 0.05),
        "hgrn_lb_logits": nrm(ks[10], (DEPTH, HGRN_KW), 0.1),
        "hgrn_norm_g": 1.0 + nrm(ks[11], (DEPTH, HGRN_VW), 0.05),
        "swa_q_norm_g": 1.0 + nrm(ks[12], (DEPTH, SWA_DH), 0.05),
        "swa_k_norm_g": 1.0 + nrm(ks[13], (DEPTH, SWA_DH), 0.05),
        "swa_sinks": nrm(ks[14], (DEPTH, SWA_Q_HEADS), 0.5),
        "w_out": nrm(ks[15], (DEPTH, MIX_W, D_MODEL), MIX_W ** -0.5),
        "mlp_norm_g": 1.0 + nrm(ks[16], (DEPTH, D_MODEL), 0.05),
        "w_up": nrm(ks[17], (DEPTH, D_MODEL, D_FF), D_MODEL ** -0.5),
        "w_down": nrm(ks[18], (DEPTH, D_FF, D_MODEL), D_FF ** -0.5),
        "ple_norm_g": 1.0 + nrm(ks[19], (DEPTH, D_MODEL), 0.05),
        "w_ple_gate": nrm(ks[20], (DEPTH, D_MODEL, D_MODEL), D_MODEL ** -0.5),
        "w_ple_proj": nrm(ks[21], (DEPTH, PLE_DIM, D_MODEL), PLE_DIM ** -0.5),
        "ple_post_norm_g": 1.0 + nrm(ks[22], (DEPTH, D_MODEL), 0.05),
    }


def reference(x, p, positions, in_norm_g, w_in, b_in, mlstm_f_bias, mlstm_conv_w, mlstm_conv_b,
              mlstm_norm_g, hgrn_lb_logits, hgrn_norm_g, swa_q_norm_g, swa_k_norm_g, swa_sinks,
              w_out, mlp_norm_g, w_up, w_down, ple_norm_g, w_ple_gate, w_ple_proj, ple_post_norm_g):
    cos, sin = _rope_tables(positions)
    lb_all = jnp.cumsum(jax.nn.softmax(hgrn_lb_logits.astype(jnp.float32), axis=0), axis=0)
    lb_all = lb_all - lb_all[0:1]
    B, S, _ = x.shape
    for l in range(DEPTH):
        h = _rms_norm(x, in_norm_g[l])
        y = h @ w_in[l] + b_in[l]
        (mq, mk, mv, mo, mi, mf, hq, hf, hi, hg, sq, sk, sv) = _split_cols(y, IN_SPLITS)

        qk = jax.nn.silu(_causal_conv(jnp.concatenate([mq, mk], axis=-1), mlstm_conv_w[l], mlstm_conv_b[l]))
        mq_c, mk_c = qk[..., :MLSTM_W], qk[..., MLSTM_W:]
        m_h = mlstm_chunkwise(_heads(mq_c, MLSTM_HEADS), _heads(mk_c, MLSTM_HEADS) * (MLSTM_DH ** -0.5),
                              _heads(mv, MLSTM_HEADS), mi, mf + mlstm_f_bias[l])
        m_out = (_head_rms_norm(m_h, mlstm_norm_g[l], MLSTM_HEADS)
                 * jax.nn.sigmoid(mo.astype(jnp.float32))).astype(x.dtype)

        h_h = hgrn2_chunkwise(_heads(hq, HGRN_HEADS), _heads(hf, HGRN_HEADS), _heads(hi, HGRN_HEADS),
                              lb_all[l].reshape(HGRN_HEADS, HGRN_DK))
        h_out = (_head_rms_norm(h_h, hgrn_norm_g[l], HGRN_HEADS)
                 * jax.nn.silu(hg.astype(jnp.float32))).astype(x.dtype)

        q_s = _partial_rope(_rms_norm(_heads(sq, SWA_Q_HEADS), swa_q_norm_g[l]), cos, sin)
        k_s = _partial_rope(_rms_norm(_heads(sk, SWA_KV_HEADS), swa_k_norm_g[l]), cos, sin)
        s_out = swa_sink_attention(q_s, k_s, _heads(sv, SWA_KV_HEADS), swa_sinks[l]).astype(x.dtype)

        x = x + jnp.concatenate([m_out, h_out, s_out], axis=-1) @ w_out[l]

        u = _rms_norm(x, mlp_norm_g[l]) @ w_up[l]
        x = x + jnp.square(jax.nn.relu(u)) @ w_down[l]

        gate = jax.nn.sigmoid((_rms_norm(x, ple_norm_g[l]) @ w_ple_gate[l]).astype(jnp.float32))
        e = _rms_norm(p[l] @ w_ple_proj[l], ple_post_norm_g[l]).astype(jnp.float32)
        x = x + (gate * e).astype(x.dtype)
    return x
```

```cpp
#include <hip/hip_runtime.h>
#include <cstdio>
#include <cstdint>
#include <cmath>
namespace pg8 {
#define PG8_LAS __attribute__((address_space(3)))
typedef unsigned short bf16_t;
typedef short bf16x8 __attribute__((ext_vector_type(8)));
typedef float f32x4 __attribute__((ext_vector_type(4)));
typedef unsigned u32x4 __attribute__((ext_vector_type(4)));
constexpr int BM = 256, BK = 64, HALF = 128, HTB = HALF * BK * 2  , STAGE_BYTES = 8 * HTB, NXCD = 8, WGM = 8;

__host__ __device__ __forceinline__ int lds_byte(int r, int c) { const int st = (r >> 4) * 2 + (c >> 5), rr = r & 15, cc = c & 31, ob = rr * 64 + cc * 2; return st * 1024 + (ob ^ (((ob >> 9) & 1) << 5)); }
__host__ __device__ __forceinline__ void stage_rc(int b, int& R, int& C) { const int st = b / 1024, sb = b % 1024, swz = sb ^ (((sb >> 9) & 1) << 5); R = (st >> 1) * 16 + swz / 64; C = (st & 1) * 32 + (swz % 64) / 2; }
__host__ __device__ __forceinline__ int perm32(int rho) { const int n = rho >> 4, i = rho & 15; return 8 * (i >> 2) + 4 * n + (i & 3); }

struct Unit { int pm, pn; };
struct Gemm { const bf16_t* A; const bf16_t* Bt; int M, N, K; };

struct StaticOrder {
    int nM, nN, nwg, G, c;
    __host__ __device__ void init(int M, int N, int G_, int c_) { nM = M / BM; nN = N / BM; nwg = nM * nN; G = G_; c = c_; }
    __host__ __device__ bool next(int i, Unit& u) const {
        const long L = (long)i * G + c; if (L >= nwg) return false;
        int wgid = (int)L; { const int q = nwg / NXCD, r = nwg % NXCD, xcd = wgid % NXCD, off = wgid / NXCD; wgid = (xcd < r ? xcd * (q + 1) : r * (q + 1) + (xcd - r) * q) + off; }
        const int nig = WGM * nN, gid = wgid / nig, fm = gid * WGM, gsz = (nM - fm) < WGM ? (nM - fm) : WGM;
        u.pm = fm + ((wgid % nig) % gsz); u.pn = (wgid % nig) / gsz; return true;
    }
    __device__ __forceinline__ void a_ready(const Unit&) const {}
    __device__ __forceinline__ void done(const Unit&) const {}
};
__device__ __forceinline__ unsigned cvt_pk_bf16(float lo, float hi) { unsigned r; asm volatile("v_cvt_pk_bf16_f32 %0, %1, %2" : "=v"(r) : "v"(lo), "v"(hi)); return r; }
typedef float f32x2 __attribute__((ext_vector_type(2)));
template <class Epi, class Sched, bool ALIGN_EPI = false, bool SP2 = false>
__device__ __forceinline__ void gemm_phase(PG8_LAS unsigned char* lds, const Gemm g, const Sched& S, const Epi& E, const int wave_id) {
    int lid_; asm volatile("v_mbcnt_lo_u32_b32 %0, -1, 0\n\tv_mbcnt_hi_u32_b32 %0, -1, %0" : "=v"(lid_)); const int tid_ = __builtin_amdgcn_readfirstlane(wave_id) * 64 + lid_;
    const int tid = tid_, wid = __builtin_amdgcn_readfirstlane(tid >> 6), lane = tid & 63, wr = wid >> 2, wc = wid & 3, fr = lane & 15, fq = lane >> 4;
    const int K = g.K, nt = K / BK;
    unsigned voffA[2], voffB[2];
#pragma unroll
    for (int i = 0; i < 2; ++i) { int R, C; stage_rc(tid * 16 + i * 8192, R, C); const int Rb = Epi::PERM ? ((R & ~31) + perm32(R & 31)) : R;
        voffA[i] = (unsigned)(R * K + C) * 2u; voffB[i] = (unsigned)(Rb * K + C) * 2u; }
    const size_t kstep = (size_t)(BK * 2);
    const size_t hstep = (size_t)HALF * K * 2;
    const size_t tstep = 2 * hstep;
    const unsigned ldsw = (unsigned)wid * 1024u;
    const int aoff = lds_byte(wr * 64 + fr, fq * 8), boff = lds_byte(wc * 32 + fr, fq * 8);
#define PG8_SA(b, h) (((b) * 2 + (h)) * HTB)
#define PG8_SB(b, h) ((4 + (b) * 2 + (h)) * HTB)
#define PG8_STAGE(bufoff, gbase, voff) do { _Pragma("unroll") for (int _i = 0; _i < 2; ++_i) \
        __builtin_amdgcn_global_load_lds((const unsigned*)((const char*)(gbase) + (voff)[_i]), (PG8_LAS unsigned*)(lds + (bufoff) + ldsw + _i * 8192), 16, 0, 0); } while (0)
#define PG8_LDA(dst, b, h) do { _Pragma("unroll") for (int m = 0; m < 4; ++m) _Pragma("unroll") for (int k = 0; k < 2; ++k) dst[m][k] = *(const PG8_LAS bf16x8*)(lds + PG8_SA(b, h) + aoff + m * 2048 + k * 1024); } while (0)
#define PG8_LDB(dst, b, h) do { _Pragma("unroll") for (int n = 0; n < 2; ++n) _Pragma("unroll") for (int k = 0; k < 2; ++k) dst[n][k] = *(const PG8_LAS bf16x8*)(lds + PG8_SB(b, h) + boff + n * 2048 + k * 1024); } while (0)
#define PG8_MMA(ai, bj, At, Bt) do { __builtin_amdgcn_s_setprio(1); _Pragma("unroll") for (int m = 0; m < 4; ++m) _Pragma("unroll") for (int n = 0; n < 2; ++n) _Pragma("unroll") for (int k = 0; k < 2; ++k) \
        acc[ai][bj][m][n] = __builtin_amdgcn_mfma_f32_16x16x32_bf16(Bt[n][k], At[m][k], acc[ai][bj][m][n], 0, 0, 0); __builtin_amdgcn_s_setprio(0); } while (0)
#define PG8_WAIT_V(n) asm volatile("s_waitcnt vmcnt(" #n ")" ::: "memory")
#define PG8_WAIT_L(n) asm volatile("s_waitcnt lgkmcnt(" #n ")" ::: "memory")
#define PG8_BAR __builtin_amdgcn_s_barrier()
#define PG8_SCHED __builtin_amdgcn_sched_barrier(0)
    Unit cur, nxt; int ui = 0;
    if (!S.next(0, cur)) return;
    f32x4 acc[2][2][4][2];
#pragma unroll
    for (int a = 0; a < 2; ++a)
#pragma unroll
        for (int b = 0; b < 2; ++b)
#pragma unroll
            for (int m = 0; m < 4; ++m)
#pragma unroll
                for (int n = 0; n < 2; ++n) acc[a][b][m][n] = (f32x4){0.f, 0.f, 0.f, 0.f};
    bf16x8 At[4][2], B0[2][2], B1[2][2];
    const char* cA = (const char*)g.A + (size_t)cur.pm * tstep; const char* cB = (const char*)g.Bt + (size_t)cur.pn * tstep;
    S.a_ready(cur);
    if constexpr (SP2) {
        PG8_STAGE(PG8_SB(0, 0), cB, voffB); PG8_STAGE(PG8_SB(0, 1), cB + hstep, voffB); PG8_STAGE(PG8_SA(0, 0), cA, voffA); PG8_STAGE(PG8_SA(0, 1), cA + hstep, voffA);
        if (wr == 1) PG8_BAR;
        PG8_WAIT_V(2); PG8_BAR;
        PG8_STAGE(PG8_SB(1, 0), cB + kstep, voffB); PG8_STAGE(PG8_SA(1, 0), cA + kstep, voffA); PG8_STAGE(PG8_SB(1, 1), cB + hstep + kstep, voffB);
        PG8_WAIT_V(6); PG8_BAR;
    } else {
        PG8_STAGE(PG8_SB(0, 0), cB, voffB); PG8_STAGE(PG8_SA(0, 0), cA, voffA); PG8_STAGE(PG8_SB(0, 1), cB + hstep, voffB); PG8_STAGE(PG8_SA(0, 1), cA + hstep, voffA);
        if (wr == 1) PG8_BAR;
        PG8_WAIT_V(4); PG8_BAR;
        PG8_STAGE(PG8_SB(1, 0), cB + kstep, voffB); PG8_STAGE(PG8_SA(1, 0), cA + kstep, voffA); PG8_STAGE(PG8_SB(1, 1), cB + hstep + kstep, voffB);
        PG8_WAIT_V(6); PG8_BAR;
    }
    for (;;) {
        const bool has_next = S.next(ui + 1, nxt);
        const char* nA = has_next ? (const char*)g.A + (size_t)nxt.pm * tstep : cA; const char* nB = has_next ? (const char*)g.Bt + (size_t)nxt.pn * tstep : cB;
        for (int t = 0; t < nt; t += 2) {
            const bool last = (t == nt - 2);
            const char* a1 = cA + (size_t)(t + 1) * kstep;
            const char* a2 = last ? nA : cA + (size_t)(t + 2) * kstep; const char* b2 = last ? nB : cB + (size_t)(t + 2) * kstep;
            const char* a3 = a2 + kstep; const char* b3 = b2 + kstep;
            if (last && has_next) S.a_ready(nxt);
            if constexpr (SP2) {
            PG8_LDB(B0, 0, 0); PG8_LDB(B1, 0, 1); PG8_SCHED; PG8_LDA(At, 0, 0); PG8_STAGE(PG8_SA(1, 1), a1 + hstep, voffA);
            PG8_WAIT_V(8); PG8_WAIT_L(0); PG8_BAR; PG8_MMA(0, 0, At, B0); PG8_MMA(0, 1, At, B1); PG8_BAR; PG8_SCHED;
            PG8_LDA(At, 0, 1); PG8_STAGE(PG8_SB(0, 0), b2, voffB); PG8_STAGE(PG8_SB(0, 1), b2 + hstep, voffB); PG8_STAGE(PG8_SA(0, 0), a2, voffA);
            PG8_WAIT_V(8); PG8_WAIT_L(0); PG8_BAR; PG8_MMA(1, 0, At, B0); PG8_MMA(1, 1, At, B1); PG8_BAR; PG8_SCHED;
            PG8_LDB(B0, 1, 0); PG8_LDB(B1, 1, 1); PG8_SCHED; PG8_LDA(At, 1, 0); PG8_STAGE(PG8_SA(0, 1), a2 + hstep, voffA);
            PG8_WAIT_V(8); PG8_WAIT_L(0); PG8_BAR; PG8_MMA(0, 0, At, B0); PG8_MMA(0, 1, At, B1); PG8_BAR; PG8_SCHED;
            PG8_LDA(At, 1, 1); PG8_STAGE(PG8_SB(1, 0), b3, voffB); PG8_STAGE(PG8_SB(1, 1), b3 + hstep, voffB); PG8_STAGE(PG8_SA(1, 0), a3, voffA);
            PG8_WAIT_V(8); PG8_WAIT_L(0); PG8_BAR; PG8_MMA(1, 0, At, B0); PG8_MMA(1, 1, At, B1); PG8_BAR; PG8_SCHED;
            } else {
            PG8_LDB(B0, 0, 0); PG8_SCHED; PG8_LDA(At, 0, 0); PG8_STAGE(PG8_SA(1, 1), a1 + hstep, voffA);
            PG8_WAIT_L(8); PG8_BAR; PG8_WAIT_L(0); PG8_MMA(0, 0, At, B0); PG8_BAR; PG8_SCHED;
            PG8_LDB(B1, 0, 1); PG8_STAGE(PG8_SB(0, 0), b2, voffB);
            PG8_BAR; PG8_WAIT_L(0); PG8_MMA(0, 1, At, B1); PG8_BAR;
            PG8_LDA(At, 0, 1); PG8_STAGE(PG8_SA(0, 0), a2, voffA);
            PG8_BAR; PG8_WAIT_L(0); PG8_MMA(1, 0, At, B0); PG8_BAR; PG8_SCHED;
            PG8_STAGE(PG8_SB(0, 1), b2 + hstep, voffB);
            PG8_WAIT_V(6); PG8_BAR; PG8_MMA(1, 1, At, B1); PG8_BAR;
            PG8_LDB(B0, 1, 0); PG8_SCHED; PG8_LDA(At, 1, 0); PG8_STAGE(PG8_SA(0, 1), a2 + hstep, voffA);
            PG8_WAIT_L(8); PG8_BAR; PG8_WAIT_L(0); PG8_MMA(0, 0, At, B0); PG8_BAR; PG8_SCHED;
            PG8_LDB(B1, 1, 1); PG8_STAGE(PG8_SB(1, 0), b3, voffB);
            PG8_BAR; PG8_WAIT_L(0); PG8_MMA(0, 1, At, B1); PG8_BAR;
            PG8_LDA(At, 1, 1); PG8_STAGE(PG8_SA(1, 0), a3, voffA);
            PG8_BAR; PG8_WAIT_L(0); PG8_MMA(1, 0, At, B0); PG8_BAR; PG8_SCHED;
            PG8_STAGE(PG8_SB(1, 1), b3 + hstep, voffB);
            PG8_WAIT_V(6); PG8_BAR; PG8_MMA(1, 1, At, B1); PG8_BAR;
            }
        }
        if constexpr (ALIGN_EPI) { if (wr == 0) PG8_BAR; }
        if constexpr (!Epi::AFTER_DRAIN) { E(acc, cur, wr, wc, fr, fq); S.done(cur); }
        if (!has_next) break;
#pragma unroll
        for (int a = 0; a < 2; ++a)
#pragma unroll
            for (int b = 0; b < 2; ++b)
#pragma unroll
                for (int m = 0; m < 4; ++m)
#pragma unroll
                    for (int n = 0; n < 2; ++n) acc[a][b][m][n] = (f32x4){0.f, 0.f, 0.f, 0.f};
        cur = nxt; cA = nA; cB = nB; ++ui;
        if constexpr (ALIGN_EPI) { if (wr == 1) PG8_BAR; }
    }
    PG8_WAIT_V(0);
    if constexpr (!ALIGN_EPI) { if (wr == 0) PG8_BAR; }
    PG8_BAR;
    if constexpr (Epi::AFTER_DRAIN) { E.fused(acc, cur, wr, wc, fr, fq, lds, wid, lane); S.done(cur); }
#undef PG8_SA
#undef PG8_SB
#undef PG8_STAGE
#undef PG8_LDA
#undef PG8_LDB
#undef PG8_MMA
#undef PG8_WAIT_V
#undef PG8_WAIT_L
#undef PG8_BAR
#undef PG8_SCHED
}
}

constexpr int NWAVES = 8;
constexpr int BATCH = 32, SEQ = 2048, DM = 1024, DEPTH = 4, M = BATCH * SEQ, NY = 3072, FF = 4096, PLE = 256, INW = 2824;
constexpr float EPS = 1e-6f;
constexpr int YC_MQ = 0, YC_MK = 256, YC_MV = 512, YC_MO = 768, YC_HQ = 1024, YC_HF = 1280, YC_HI = 1536, YC_HG = 1792, YC_SQ = 2048, YC_SK = 2560, YC_SV = 2688, YC_MI = 2816, YC_MF = 2820;

constexpr size_t MiB = 1u << 20;
constexpr size_t WS_CTL = 0, WS_STATS = 1 * MiB, ZERO_BYTES = 9 * MiB;
constexpr size_t WS_ROPE = 9 * MiB;
constexpr size_t WS_BIASY = 13 * MiB;
constexpr size_t WS_WIN = 14 * MiB, WS_WOUT = 38 * MiB, WS_WUP = 46 * MiB, WS_WDN = 78 * MiB, WS_WG = 110 * MiB, WS_WP = 118 * MiB;
constexpr size_t WS_XB0 = 120 * MiB, WS_XB1 = 248 * MiB;
constexpr size_t WS_BIG = 376 * MiB;
constexpr size_t WS_MIX = WS_BIG + 384 * MiB;
constexpr size_t WS_ERAW = 888 * MiB;
constexpr size_t WS_END = 1016 * MiB;
constexpr int SS_IN = 0, SS_MLP = 4, SS_PLE = 8, SS_E = 12;
constexpr int CW_BAR = 4096;

constexpr int SCR_BYTES = 143360;
constexpr int LDSCTL_OFF = SCR_BYTES, MISC_OFF = LDSCTL_OFF + 320;
constexpr int LDS_BYTES = 147456;

#define GAS __attribute__((address_space(1)))
#define LAS __attribute__((address_space(3)))
typedef unsigned short bf16;
typedef unsigned v4u __attribute__((ext_vector_type(4)));
typedef float f32x4 __attribute__((ext_vector_type(4)));
typedef short bf16x8 __attribute__((ext_vector_type(8)));
typedef GAS unsigned gu32;
typedef GAS unsigned long long gu64;
#define RLX_AGENT __ATOMIC_RELAXED, __HIP_MEMORY_SCOPE_AGENT
#define LDS_WAIT() asm volatile("s_waitcnt lgkmcnt(0)" ::: "memory")
#define VM_WAIT() asm volatile("s_waitcnt vmcnt(0)" ::: "memory")
__device__ __forceinline__ unsigned long long rt() { return __builtin_amdgcn_s_memrealtime(); }
__device__ __forceinline__ unsigned f2bf(float f) { unsigned u = __builtin_bit_cast(unsigned, f); return (u + 0x7fffu + ((u >> 16) & 1u)) >> 16; }
__device__ __forceinline__ unsigned pk2(float lo, float hi) { return f2bf(lo) | (f2bf(hi) << 16); }
typedef unsigned u32x4 __attribute__((ext_vector_type(4)));
typedef unsigned u32x2 __attribute__((ext_vector_type(2)));
#define XB_TMO      128
#define XB_XCNT(j)  (256  + 64 * (j))
#define XB_XSUB(j)  (1280 + 64 * (j))
#define XB_XGEN(j)  (2304 + 64 * (j))
#define XB_TOP      3328
#define XB_TOPGEN   3392
#define XCD_BAR_WORDS 3456
#define XB_SPIN_CAP (1u << 18)

__device__ __forceinline__ unsigned xb_ld(unsigned* p)              { return __hip_atomic_load(p, __ATOMIC_RELAXED, __HIP_MEMORY_SCOPE_AGENT); }
__device__ __forceinline__ unsigned xb_add(unsigned* p, unsigned v) { return __hip_atomic_fetch_add(p, v, __ATOMIC_RELAXED, __HIP_MEMORY_SCOPE_AGENT); }
__device__ __forceinline__ unsigned xb_xcc_id() { return (unsigned)__builtin_amdgcn_s_getreg((3 << 11) | 20) & 0xFu; }
#define XB_SPIN(cond, bar) do { unsigned _sp = 0; while (cond) { __builtin_amdgcn_s_sleep(1); \
    if ((++_sp & 255u) == 0u) { if (xb_ld(&(bar)[XB_TMO])) break; if (_sp > XB_SPIN_CAP) { atomicAdd(&(bar)[XB_TMO], 1u); break; } } } } while (0)

struct XcdBarrier {
    unsigned* bar; unsigned x;
    volatile LAS unsigned* st;
};

__device__ __forceinline__ XcdBarrier xcd_barrier_post(unsigned* bar, volatile LAS unsigned* st) {
    XcdBarrier b; b.bar = bar; b.x = xb_xcc_id(); b.st = st;
    if (threadIdx.x == 0) (void)xb_add(&bar[XB_XCNT(b.x)], 1u);
    return b;
}
__device__ __forceinline__ void xcd_barrier_complete(unsigned* bar, unsigned x, unsigned& nloc, unsigned& nx) {
    const unsigned G = gridDim.x * gridDim.y * gridDim.z;
    unsigned sum, cnt, mine, sp = 0u;
    for (;;) {
        sum = 0u; cnt = 0u; mine = 0u;
#pragma unroll
        for (unsigned j = 0; j < 16; ++j) { const unsigned c = xb_ld(&bar[XB_XCNT(j)]); sum += c; cnt += (c > 0u) ? 1u : 0u; mine = (j == x) ? c : mine; }
        if (sum == G) break;
        __builtin_amdgcn_s_sleep(1);
        if ((++sp & 255u) == 0u) { if (xb_ld(&bar[XB_TMO])) break; if (sp > XB_SPIN_CAP) { atomicAdd(&bar[XB_TMO], 1u); break; } }
    }
    nloc = mine > 0u ? mine : 1u; nx = cnt > 0u ? cnt : 1u;
}

__device__ __forceinline__ void xcd_barrier(const XcdBarrier& b) {
    asm volatile("s_waitcnt vmcnt(0)" ::: "memory");
    __syncthreads();
    if (threadIdx.x == 0) {
        unsigned* bar = b.bar;
        __builtin_amdgcn_s_waitcnt(0);
        unsigned nloc = b.st[0], nx = b.st[1];
        if (nloc == 0u) { xcd_barrier_complete(bar, b.x, nloc, nx); b.st[0] = nloc; b.st[1] = nx; }
        const unsigned old = xb_add(&bar[XB_XSUB(b.x)], 1u);
        const unsigned gen = old / nloc;
        if (old + 1u == (gen + 1u) * nloc) {
            __builtin_amdgcn_fence(__ATOMIC_RELEASE, "agent");
            asm volatile("s_waitcnt vmcnt(0)" ::: "memory");
            const unsigned og = xb_add(&bar[XB_TOP], 1u);
            const unsigned tg = og / nx;
            if (og + 1u == (tg + 1u) * nx) xb_add(&bar[XB_TOPGEN], 1u);
            else XB_SPIN(xb_ld(&bar[XB_TOPGEN]) == tg, bar);
            __builtin_amdgcn_fence(__ATOMIC_ACQUIRE, "agent");
            xb_add(&bar[XB_XGEN(b.x)], 1u);
            asm volatile("s_waitcnt vmcnt(0)" ::: "memory");
        } else {
            XB_SPIN(xb_ld(&bar[XB_XGEN(b.x)]) == gen, bar);
            __builtin_amdgcn_fence(__ATOMIC_ACQUIRE, "agent");
            asm volatile("s_waitcnt vmcnt(0)" ::: "memory");
        }
    }
    __syncthreads();
}

__device__ __forceinline__ float bf2f(unsigned short b) { return __uint_as_float((unsigned)b << 16); }
__device__ __forceinline__ float bflo(unsigned w) { return __uint_as_float(w << 16); }
__device__ __forceinline__ float bfhi(unsigned w) { return __uint_as_float(w & 0xffff0000u); }
__device__ __forceinline__ unsigned short f2bf16(float f) { return (unsigned short)f2bf(f); }
__device__ __forceinline__ float sigmoid_f(float x) { return 1.f / (1.f + __expf(-x)); }
__device__ __forceinline__ float silu_f(float x) { return x * sigmoid_f(x); }
__device__ __forceinline__ float logsigmoid_f(float x) { return fminf(x, 0.f) - log1pf(__expf(-fabsf(x))); }
__device__ __forceinline__ float wave_sum(float v) {
#pragma unroll
    for (int o = 1; o < 64; o <<= 1) v += __shfl_xor(v, o);
    return v;
}
typedef unsigned long long ss_t;
__device__ __forceinline__ void atomic_add_ss(ss_t* p, float v) { atomicAdd(p, (ss_t)(long long)(v * 16777216.0f)); }
__device__ __forceinline__ float ss_rstd(const ss_t* p, float inv_n) { return rsqrtf((float)(*p) * (inv_n * (1.0f / 16777216.0f)) + 1e-6f); }

namespace pg8 {
__device__ __forceinline__ int epi_lane() { int x; asm volatile("v_mbcnt_lo_u32_b32 %0, -1, 0\n\tv_mbcnt_hi_u32_b32 %0, -1, %0" : "=v"(x)); return x; }
#define EPI_ROWCOL const int ln_ = epi_lane(); fr = ln_ & 15; fq = ln_ >> 4; const int row0 = u.pm * BM + wr * 64 + fr; const int col0 = u.pn * BM + wc * 32 + 8 * fq;
__device__ __forceinline__ u32x4 pack8(const f32x4 v0, const f32x4 v1) { u32x4 w; w.x = cvt_pk_bf16(v0[0], v0[1]); w.y = cvt_pk_bf16(v0[2], v0[3]); w.z = cvt_pk_bf16(v1[0], v1[1]); w.w = cvt_pk_bf16(v1[2], v1[3]); return w; }
__device__ __forceinline__ float sq8(const u32x4 w) { float s = 0.f;
    { float a = __uint_as_float(w.x << 16), b = __uint_as_float(w.x & 0xffff0000u); s += a * a + b * b; }
    { float a = __uint_as_float(w.y << 16), b = __uint_as_float(w.y & 0xffff0000u); s += a * a + b * b; }
    { float a = __uint_as_float(w.z << 16), b = __uint_as_float(w.z & 0xffff0000u); s += a * a + b * b; }
    { float a = __uint_as_float(w.w << 16), b = __uint_as_float(w.w & 0xffff0000u); s += a * a + b * b; } return s; }
__device__ __forceinline__ void unpack8(const u32x4 w, f32x4& v0, f32x4& v1) {
    v0 = (f32x4){__uint_as_float(w.x << 16), __uint_as_float(w.x & 0xffff0000u), __uint_as_float(w.y << 16), __uint_as_float(w.y & 0xffff0000u)};
    v1 = (f32x4){__uint_as_float(w.z << 16), __uint_as_float(w.z & 0xffff0000u), __uint_as_float(w.w << 16), __uint_as_float(w.w & 0xffff0000u)}; }

struct EpiIn {
    static constexpr bool PERM = true, AFTER_DRAIN = false;
    bf16_t* O; int ldc; const float* bias; const ss_t* ss;
    __device__ __forceinline__ void operator()(const f32x4 (&acc)[2][2][4][2], const Unit& u, int wr, int wc, int fr, int fq) const {
        EPI_ROWCOL
        f32x4 bv[2][2];
#pragma unroll
        for (int bj = 0; bj < 2; ++bj)
#pragma unroll
            for (int n = 0; n < 2; ++n) bv[bj][n] = *(const f32x4*)(bias + col0 + bj * HALF + 4 * n);
#pragma unroll
        for (int ai = 0; ai < 2; ++ai)
#pragma unroll
            for (int m = 0; m < 4; ++m) { const int row = row0 + ai * HALF + m * 16; const float rs = ss_rstd(ss + row, 1.0f / 1024.0f); bf16_t* rowp = O + (size_t)row * ldc + col0;
#pragma unroll
                for (int bj = 0; bj < 2; ++bj) { const f32x4 v0 = acc[ai][bj][m][0] * rs + bv[bj][0], v1 = acc[ai][bj][m][1] * rs + bv[bj][1]; *(u32x4*)(rowp + bj * HALF) = pack8(v0, v1); } }
    }
};
struct EpiRes {
    static constexpr bool PERM = true, AFTER_DRAIN = false;
    bf16_t* X; int ldc; ss_t* ss_out;
    __device__ __forceinline__ void operator()(const f32x4 (&acc)[2][2][4][2], const Unit& u, int wr, int wc, int fr, int fq) const {
        EPI_ROWCOL
#pragma unroll
        for (int ai = 0; ai < 2; ++ai)
#pragma unroll
            for (int m = 0; m < 4; ++m) { const int row = row0 + ai * HALF + m * 16; bf16_t* rowp = X + (size_t)row * ldc + col0; float sq = 0.f;
#pragma unroll
                for (int bj = 0; bj < 2; ++bj) { const u32x4 old = *(const u32x4*)(rowp + bj * HALF); f32x4 o0, o1; unpack8(old, o0, o1);
                    const u32x4 w = pack8(o0 + acc[ai][bj][m][0], o1 + acc[ai][bj][m][1]); *(u32x4*)(rowp + bj * HALF) = w; sq += sq8(w); }
                sq += __shfl_xor(sq, 16); sq += __shfl_xor(sq, 32);
                if (fq == 0) atomic_add_ss(ss_out + row, sq); }
    }
};
struct EpiUp {
    static constexpr bool PERM = true, AFTER_DRAIN = false;
    bf16_t* O; int ldc; const ss_t* ss;
    __device__ __forceinline__ void operator()(const f32x4 (&acc)[2][2][4][2], const Unit& u, int wr, int wc, int fr, int fq) const {
        EPI_ROWCOL
#pragma unroll
        for (int ai = 0; ai < 2; ++ai)
#pragma unroll
            for (int m = 0; m < 4; ++m) { const int row = row0 + ai * HALF + m * 16; const float rs = ss_rstd(ss + row, 1.0f / 1024.0f); bf16_t* rowp = O + (size_t)row * ldc + col0;
#pragma unroll
                for (int bj = 0; bj < 2; ++bj) { f32x4 v0 = acc[ai][bj][m][0] * rs, v1 = acc[ai][bj][m][1] * rs;
#pragma unroll
                    for (int j = 0; j < 4; ++j) { const float a = fmaxf(v0[j], 0.f), b = fmaxf(v1[j], 0.f); v0[j] = a * a; v1[j] = b * b; }
                    *(u32x4*)(rowp + bj * HALF) = pack8(v0, v1); } }
    }
};
struct EpiPle {
    static constexpr bool PERM = true, AFTER_DRAIN = false;
    bf16_t* O; int ldc; ss_t* ss_out;
    __device__ __forceinline__ void operator()(const f32x4 (&acc)[2][2][4][2], const Unit& u, int wr, int wc, int fr, int fq) const {
        EPI_ROWCOL
#pragma unroll
        for (int ai = 0; ai < 2; ++ai)
#pragma unroll
            for (int m = 0; m < 4; ++m) { const int row = row0 + ai * HALF + m * 16; bf16_t* rowp = O + (size_t)row * ldc + col0; float sq = 0.f;
#pragma unroll
                for (int bj = 0; bj < 2; ++bj) { const u32x4 w = pack8(acc[ai][bj][m][0], acc[ai][bj][m][1]); *(u32x4*)(rowp + bj * HALF) = w; sq += sq8(w); }
                sq += __shfl_xor(sq, 16); sq += __shfl_xor(sq, 32);
                if (fq == 0) atomic_add_ss(ss_out + row, sq); }
    }
};
struct EpiGate {
    static constexpr bool PERM = true, AFTER_DRAIN = false;
    const bf16_t* Xin; bf16_t* Xout; float* Fout; const bf16_t* E; int ldc; const ss_t* ss_x; const ss_t* ss_e; const float* gpost; ss_t* ss_out;
    __device__ __forceinline__ void operator()(const f32x4 (&acc)[2][2][4][2], const Unit& u, int wr, int wc, int fr, int fq) const {
        EPI_ROWCOL
        f32x4 gp[2][2];
#pragma unroll
        for (int bj = 0; bj < 2; ++bj)
#pragma unroll
            for (int n = 0; n < 2; ++n) gp[bj][n] = *(const f32x4*)(gpost + col0 + bj * HALF + 4 * n);
#pragma unroll
        for (int ai = 0; ai < 2; ++ai)
#pragma unroll
            for (int m = 0; m < 4; ++m) { const int row = row0 + ai * HALF + m * 16; const size_t off = (size_t)row * ldc + col0; float sq = 0.f;
                const float rsx = ss_rstd(ss_x + row, 1.0f / 1024.0f), rse = ss_rstd(ss_e + row, 1.0f / 1024.0f);
#pragma unroll
                for (int bj = 0; bj < 2; ++bj) { const u32x4 xo = *(const u32x4*)(Xin + off + bj * HALF), ev = *(const u32x4*)(E + off + bj * HALF);
                    f32x4 x0, x1, e0, e1; unpack8(xo, x0, x1); unpack8(ev, e0, e1);
                    f32x4 r0, r1;
#pragma unroll
                    for (int j = 0; j < 4; ++j) { const float g0 = 1.f / (1.f + __expf(-acc[ai][bj][m][0][j] * rsx)), g1 = 1.f / (1.f + __expf(-acc[ai][bj][m][1][j] * rsx));
                        r0[j] = x0[j] + g0 * (e0[j] * rse * gp[bj][0][j]); r1[j] = x1[j] + g1 * (e1[j] * rse * gp[bj][1][j]); }
                    if (Fout) { *(f32x4*)(Fout + off + bj * HALF) = r0; *(f32x4*)(Fout + off + bj * HALF + 4) = r1; }
                    else { const u32x4 w = pack8(r0, r1); *(u32x4*)(Xout + off + bj * HALF) = w; sq += sq8(w); } }
                if (!Fout) { sq += __shfl_xor(sq, 16); sq += __shfl_xor(sq, 32); if (fq == 0) atomic_add_ss(ss_out + row, sq); } }
    }
};
}

struct Args {
    const float* x; const float* p; const int* pos;
    const float *in_norm_g, *w_in, *b_in, *mlstm_f_bias, *conv_w, *conv_b, *mlstm_norm_g, *hgrn_lb_logits, *hgrn_norm_g, *swa_q_g, *swa_k_g, *swa_sinks, *w_out, *mlp_norm_g, *w_up, *w_down,
        *ple_norm_g, *w_ple_gate, *w_ple_proj, *ple_post_g;
    float* out; unsigned char* ws;
    double rope_rev[8];
    int ph_lo, ph_hi;
};
struct Frame {
    LAS unsigned char* lds; int wave, G, gw, NGW;
};
__device__ __forceinline__ int lane_id() { int x; asm volatile("v_mbcnt_lo_u32_b32 %0, -1, 0\n\tv_mbcnt_hi_u32_b32 %0, -1, %0" : "=v"(x)); return x; }

template <class ColMap>
__device__ __forceinline__ void transpose_item(const float* W, int K, int N, const float* gain, bf16* WT, int nblk, LAS float* scr, int item, int lane, ColMap cm) {
    const int kb = item / nblk, nb = item % nblk, k0 = 64 * kb, n0 = 32 * nb;
    const int src = cm(n0 + (lane & 31));
#pragma unroll 8
    for (int i = 0; i < 32; ++i) { const int kk = 2 * i + (lane >> 5); float v = 0.f; if (src >= 0) v = W[(size_t)(k0 + kk) * N + src]; if (gain) v *= gain[k0 + kk]; scr[kk * 33 + (lane & 31)] = v; }
    LDS_WAIT(); asm volatile("" ::: "memory");
    const int c = lane & 7;
#pragma unroll
    for (int j = 0; j < 4; ++j) { const int n = (lane >> 3) + 8 * j; const LAS float* s = scr + (8 * c) * 33 + n;
        v4u o; o.x = pk2(s[0 * 33], s[1 * 33]); o.y = pk2(s[2 * 33], s[3 * 33]); o.z = pk2(s[4 * 33], s[5 * 33]); o.w = pk2(s[6 * 33], s[7 * 33]);
        *(GAS v4u*)(WT + (size_t)(n0 + n) * K + k0 + 8 * c) = o; }
    LDS_WAIT(); asm volatile("" ::: "memory");
}
struct IdMap { __device__ __forceinline__ int operator()(int n) const { return n; } };
struct YMap { __device__ __forceinline__ int operator()(int n) const { return n < 1024 ? n : (n < 2816 ? n + 8 : (n < 2824 ? n - 2816 + 1024 : -1)); } };

__device__ __forceinline__ void p0_prologue(const Frame& F, const Args& a) {
    unsigned char* ws = a.ws; const int lane = lane_id();
    LAS float* scr = (LAS float*)(F.lds + F.wave * 16384);
    const int gw = F.gw, NGW = F.NGW;
    constexpr int I_IN = 16 * (NY / 32), I_OUT = 16 * 32, I_UP = 16 * (FF / 32), I_DN = 64 * 32, I_G = 16 * 32, I_P = 4 * 32, I_LAYER = I_IN + I_OUT + I_UP + I_DN + I_G + I_P;
    for (int it = gw; it < DEPTH * I_LAYER; it += NGW) {
        const int l = it / I_LAYER; int r = it % I_LAYER;
        if (r < I_IN) { transpose_item(a.w_in + (size_t)l * DM * INW, DM, INW, a.in_norm_g + l * DM, (bf16*)(ws + WS_WIN) + (size_t)l * NY * DM, NY / 32, scr, r, lane, YMap()); continue; } r -= I_IN;
        if (r < I_OUT) { transpose_item(a.w_out + (size_t)l * DM * DM, DM, DM, nullptr, (bf16*)(ws + WS_WOUT) + (size_t)l * DM * DM, DM / 32, scr, r, lane, IdMap()); continue; } r -= I_OUT;
        if (r < I_UP) { transpose_item(a.w_up + (size_t)l * DM * FF, DM, FF, a.mlp_norm_g + l * DM, (bf16*)(ws + WS_WUP) + (size_t)l * FF * DM, FF / 32, scr, r, lane, IdMap()); continue; } r -= I_UP;
        if (r < I_DN) { transpose_item(a.w_down + (size_t)l * FF * DM, FF, DM, nullptr, (bf16*)(ws + WS_WDN) + (size_t)l * DM * FF, DM / 32, scr, r, lane, IdMap()); continue; } r -= I_DN;
        if (r < I_G) { transpose_item(a.w_ple_gate + (size_t)l * DM * DM, DM, DM, a.ple_norm_g + l * DM, (bf16*)(ws + WS_WG) + (size_t)l * DM * DM, DM / 32, scr, r, lane, IdMap()); continue; } r -= I_G;
        transpose_item(a.w_ple_proj + (size_t)l * PLE * DM, PLE, DM, nullptr, (bf16*)(ws + WS_WP) + (size_t)l * DM * PLE, DM / 32, scr, r, lane, IdMap());
    }
    { bf16* XB = (bf16*)(ws + WS_XB0); ss_t* ss = (ss_t*)(ws + WS_STATS) + (size_t)SS_IN * M;
      for (int m = gw; m < M; m += NGW) { const GAS f32x4* xr = (const GAS f32x4*)(a.x + (size_t)m * DM) + lane; GAS u32x2* o8 = (GAS u32x2*)(XB + (size_t)m * DM) + lane; float s = 0.f;
#pragma unroll
          for (int j = 0; j < 4; ++j) { const f32x4 v = xr[64 * j]; u32x2 w; w.x = pk2(v.x, v.y); w.y = pk2(v.z, v.w); o8[64 * j] = w;
              const float a0 = bflo(w.x), a1 = bfhi(w.x), a2 = bflo(w.y), a3 = bfhi(w.y); s += (a0 * a0 + a1 * a1) + (a2 * a2 + a3 * a3); }
          s = wave_sum(s); if (lane == 0) ss[m] = (ss_t)(long long)(s * 16777216.0f); } }
    { const size_t n8 = (size_t)DEPTH * M * PLE / 8; bf16* PB = (bf16*)a.out;
      for (size_t i = (size_t)gw * 64 + lane; i < n8; i += (size_t)NGW * 64) { const f32x4 v0 = *(const GAS f32x4*)(a.p + i * 8), v1 = *(const GAS f32x4*)(a.p + i * 8 + 4);
          v4u w; w.x = pk2(v0.x, v0.y); w.y = pk2(v0.z, v0.w); w.z = pk2(v1.x, v1.y); w.w = pk2(v1.z, v1.w); *(GAS v4u*)(PB + i * 8) = w; } }
    { float* rope = (float*)(ws + WS_ROPE);
      for (int i = gw * 64 + lane; i < M * 8; i += NGW * 64) { const int m = i >> 3, f = i & 7; double rev = (double)a.pos[m] * a.rope_rev[f]; rev -= __builtin_floor(rev); const float fr = (float)rev;
          rope[2 * i] = __builtin_amdgcn_cosf(fr); rope[2 * i + 1] = __builtin_amdgcn_sinf(fr); } }
    { float* by = (float*)(ws + WS_BIASY); YMap ym;
      for (int i = gw * 64 + lane; i < DEPTH * NY; i += NGW * 64) { const int l = i / NY, c = i % NY, s = ym(c); by[i] = s >= 0 ? a.b_in[l * INW + s] : 0.f; } }
}

__device__ __forceinline__ bf16x8 ld_frag(const LAS bf16* tile, int ld, int r0, int k0, int lane) { return *(const LAS bf16x8*)(tile + (r0 + (lane & 15)) * ld + k0 + 8 * (lane >> 4)); }
template <int K>
__device__ __forceinline__ f32x4 mma_tile(f32x4 acc, const LAS bf16* A, int lda, int r0, const LAS bf16* Bt, int ldb, int c0, int lane) {
#pragma unroll
    for (int k0 = 0; k0 < K; k0 += 32) acc = __builtin_amdgcn_mfma_f32_16x16x32_bf16(ld_frag(A, lda, r0, k0, lane), ld_frag(Bt, ldb, c0, k0, lane), acc, 0, 0, 0);
    return acc;
}
__device__ __forceinline__ float scan_add(float v, int lane) {
#pragma unroll
    for (int o = 1; o < 64; o <<= 1) { const float t = __shfl_up(v, o); if (lane >= o) v += t; }
    return v;
}
__device__ __forceinline__ float scan_max(float v, int lane) {
#pragma unroll
    for (int o = 1; o < 64; o <<= 1) { const float t = __shfl_up(v, o); if (lane >= o) v = fmaxf(v, t); }
    return v;
}

__device__ __forceinline__ void mlstm_task(const Frame& F, const Args& a, int layer, int bh) {
    const int tid_ = F.wave * 64 + lane_id(); const int b = bh >> 2, h = bh & 3, tid = tid_, lane = tid & 63, w = F.wave;
    const bf16* Y = (const bf16*)(a.ws + WS_BIG); bf16* MIX = (bf16*)(a.ws + WS_MIX);
    constexpr int LD = 72;
    LAS bf16* Qs = (LAS bf16*)(F.lds); LAS bf16* Ks = Qs + 64 * LD; LAS bf16* Kt = Ks + 64 * LD; LAS bf16* Vt = Kt + 64 * LD; LAS bf16* Ps = Vt + 64 * LD; LAS bf16* Cts = Ps + 64 * LD;
    LAS float* Hs = (LAS float*)(Cts + 64 * LD);
    LAS float* fa = Hs + 64 * 68;
    LAS float* a_ = fa, *g_ = fa + 64, *winter_ = fa + 128, *emm_ = fa + 192, *ws_ = fa + 256, *qn_ = fa + 320, *n_ = fa + 384, *denp = fa + 448  , *cw = fa + 704  , *gn = fa + 704 + 640, *sc = fa + 704 + 704;
    const int j = tid >> 3, d8 = (tid & 7) * 8;
    for (int i = tid; i < 64 * LD; i += 512) Cts[i] = 0;
    if (tid < 64) { n_[tid] = 0.f; gn[tid] = a.mlstm_norm_g[layer * 256 + h * 64 + tid]; cw[512 + tid] = a.conv_b[layer * 512 + h * 64 + tid]; cw[576 + tid] = a.conv_b[layer * 512 + 256 + h * 64 + tid]; }
    if (tid < 256) { const int tap = tid >> 6, d = tid & 63; cw[tap * 64 + d] = a.conv_w[(layer * 4 + tap) * 512 + h * 64 + d]; cw[256 + tap * 64 + d] = a.conv_w[(layer * 4 + tap) * 512 + 256 + h * 64 + d]; }
    const float fbias = a.mlstm_f_bias[layer * 4 + h];
    f32x4 Ct[2]; Ct[0] = (f32x4){0.f, 0.f, 0.f, 0.f}; Ct[1] = Ct[0];
    float mcar = 0.f;
    __syncthreads();
    for (int c = 0; c < SEQ / 64; ++c) {
        const int t = c * 64 + j; const size_t row = (size_t)b * SEQ + t; const bf16* yr = Y + row * NY;
        float kreg[8];
        { float qa[8], ka[8];
#pragma unroll
          for (int i = 0; i < 8; ++i) { qa[i] = cw[512 + d8 + i]; ka[i] = cw[576 + d8 + i]; }
#pragma unroll
          for (int tap = 0; tap < 4; ++tap) { if (t - 3 + tap >= 0) { const u32x4 rq = *(const u32x4*)(yr + (tap - 3) * NY + YC_MQ + h * 64 + d8), rk = *(const u32x4*)(yr + (tap - 3) * NY + YC_MK + h * 64 + d8);
                f32x4 q0, q1, k0, k1; pg8::unpack8(rq, q0, q1); pg8::unpack8(rk, k0, k1);
#pragma unroll
                for (int i = 0; i < 4; ++i) { qa[i] += cw[tap * 64 + d8 + i] * q0[i]; qa[4 + i] += cw[tap * 64 + d8 + 4 + i] * q1[i]; ka[i] += cw[256 + tap * 64 + d8 + i] * k0[i]; ka[4 + i] += cw[256 + tap * 64 + d8 + 4 + i] * k1[i]; } } }
          f32x4 q0, q1, k0, k1;
#pragma unroll
          for (int i = 0; i < 4; ++i) { q0[i] = silu_f(qa[i]); q1[i] = silu_f(qa[4 + i]); k0[i] = silu_f(ka[i]) * 0.125f; k1[i] = silu_f(ka[4 + i]) * 0.125f; kreg[i] = k0[i]; kreg[4 + i] = k1[i]; }
          *(LAS u32x4*)(Qs + j * LD + d8) = pg8::pack8(q0, q1); *(LAS u32x4*)(Ks + j * LD + d8) = pg8::pack8(k0, k1);
          const u32x4 rv = *(const u32x4*)(yr + YC_MV + h * 64 + d8); const unsigned vw[4] = {rv.x, rv.y, rv.z, rv.w};
#pragma unroll
          for (int i = 0; i < 4; ++i) { Vt[(d8 + 2 * i) * LD + j] = (bf16)(vw[i] & 0xffffu); Vt[(d8 + 2 * i + 1) * LD + j] = (bf16)(vw[i] >> 16); } }
        if (w == 0) { const bf16* yl = Y + ((size_t)b * SEQ + c * 64 + lane) * NY; const float ip = bf2f(yl[YC_MI + h]), fp = bf2f(yl[YC_MF + h]) + fbias; const float lf = logsigmoid_f(fp);
            const float bc = scan_add(lf, lane), g = ip - bc, cm = scan_max(g, lane), av = fmaxf(mcar, cm); const float a63 = __shfl(av, 63), b63 = __shfl(bc, 63);
            a_[lane] = av; g_[lane] = g; winter_[lane] = __expf(mcar - av); emm_[lane] = __expf(-(bc + av)); ws_[lane] = __expf(g - a63); if (lane == 0) sc[0] = __expf(mcar - a63); mcar = b63 + a63; }
        __syncthreads();
        { const int rt = w >> 1;
#pragma unroll
          for (int ci = 0; ci < 2; ++ci) { const int ct = (w & 1) * 2 + ci; f32x4 acc = (f32x4){0.f, 0.f, 0.f, 0.f};
              if (ct <= rt) acc = mma_tile<64>(acc, Qs, LD, rt * 16, Ks, LD, ct * 16, lane);
              const int s = ct * 16 + (lane & 15); const float gs = g_[s];
#pragma unroll
              for (int i = 0; i < 4; ++i) { const int jr = rt * 16 + 4 * (lane >> 4) + i; float p = (s <= jr) ? acc[i] * __expf(gs - a_[jr]) : 0.f; Ps[jr * LD + s] = f2bf16(p);
                  p += __shfl_xor(p, 1); p += __shfl_xor(p, 2); p += __shfl_xor(p, 4); p += __shfl_xor(p, 8); if ((lane & 15) == 0) denp[jr * 4 + ct] = p; } } }
        { const u32x4 rq = *(const LAS u32x4*)(Qs + j * LD + d8); f32x4 q0, q1; pg8::unpack8(rq, q0, q1); float s = 0.f;
#pragma unroll
          for (int i = 0; i < 4; ++i) s += q0[i] * n_[d8 + i] + q1[i] * n_[d8 + 4 + i];
          s += __shfl_xor(s, 1); s += __shfl_xor(s, 2); s += __shfl_xor(s, 4); if ((tid & 7) == 0) qn_[j] = s;
          const float wsj = ws_[j];
#pragma unroll
          for (int i = 0; i < 8; ++i) Kt[(d8 + i) * LD + j] = f2bf16(kreg[i] * wsj); }
        __syncthreads();
        { const int rt = w >> 1;
#pragma unroll
          for (int ci = 0; ci < 2; ++ci) { const int ct = (w & 1) * 2 + ci; f32x4 acc = (f32x4){0.f, 0.f, 0.f, 0.f};
              acc = mma_tile<64>(acc, Qs, LD, rt * 16, Cts, LD, ct * 16, lane);
#pragma unroll
              for (int i = 0; i < 4; ++i) acc[i] *= winter_[rt * 16 + 4 * (lane >> 4) + i];
              acc = mma_tile<64>(acc, Ps, LD, rt * 16, Vt, LD, ct * 16, lane);
#pragma unroll
              for (int i = 0; i < 4; ++i) { const int jr = rt * 16 + 4 * (lane >> 4) + i; const f32x4 dp = *(const LAS f32x4*)(denp + jr * 4); const float den = (dp[0] + dp[1]) + (dp[2] + dp[3]) + winter_[jr] * qn_[jr];
                  Hs[jr * 68 + ct * 16 + (lane & 15)] = acc[i] / fmaxf(fabsf(den), emm_[jr]); } }
          const float decay = sc[0];
#pragma unroll
          for (int ci = 0; ci < 2; ++ci) { const int dt = (w & 1) * 2 + ci; Ct[ci] = Ct[ci] * decay; Ct[ci] = mma_tile<64>(Ct[ci], Vt, LD, rt * 16, Kt, LD, dt * 16, lane); }
          { const int dd = tid >> 3, s8 = (tid & 7) * 8; const u32x4 rk = *(const LAS u32x4*)(Kt + dd * LD + s8); f32x4 k0, k1; pg8::unpack8(rk, k0, k1); float s = (k0[0] + k0[1]) + (k0[2] + k0[3]) + (k1[0] + k1[1]) + (k1[2] + k1[3]);
            s += __shfl_xor(s, 1); s += __shfl_xor(s, 2); s += __shfl_xor(s, 4); if ((tid & 7) == 0) n_[dd] = n_[dd] * decay + s; } }
        __syncthreads();
        { const f32x4 h0 = *(const LAS f32x4*)(Hs + j * 68 + d8), h1 = *(const LAS f32x4*)(Hs + j * 68 + d8 + 4); float s = (h0[0] * h0[0] + h0[1] * h0[1]) + (h0[2] * h0[2] + h0[3] * h0[3]) + (h1[0] * h1[0] + h1[1] * h1[1]) + (h1[2] * h1[2] + h1[3] * h1[3]);
          s += __shfl_xor(s, 1); s += __shfl_xor(s, 2); s += __shfl_xor(s, 4); const float rs = rsqrtf(s * (1.0f / 64.0f) + EPS);
          const u32x4 ro = *(const u32x4*)(yr + YC_MO + h * 64 + d8); f32x4 o0, o1; pg8::unpack8(ro, o0, o1); f32x4 r0, r1;
#pragma unroll
          for (int i = 0; i < 4; ++i) { r0[i] = h0[i] * rs * gn[d8 + i] * sigmoid_f(o0[i]); r1[i] = h1[i] * rs * gn[d8 + 4 + i] * sigmoid_f(o1[i]); }
          *(u32x4*)(MIX + row * DM + h * 64 + d8) = pg8::pack8(r0, r1); }
        { const int et = w >> 1;
#pragma unroll
          for (int ci = 0; ci < 2; ++ci) { const int dt = (w & 1) * 2 + ci;
#pragma unroll
              for (int i = 0; i < 4; ++i) Cts[(et * 16 + 4 * (lane >> 4) + i) * LD + dt * 16 + (lane & 15)] = f2bf16(Ct[ci][i]); } }
    }
    __syncthreads();
}

__device__ __forceinline__ void hgrn_task(const Frame& F, const Args& a, int layer, int bh) {
    const int tid_ = F.wave * 64 + lane_id(); const int b = bh >> 2, h = bh & 3, tid = tid_, lane = tid & 63, w = F.wave;
    const bf16* Y = (const bf16*)(a.ws + WS_BIG); bf16* MIX = (bf16*)(a.ws + WS_MIX);
    LAS float* Qf = (LAS float*)(F.lds); LAS float* Gm = Qf + 32 * 68; LAS float* Kf = Gm + 32 * 68; LAS float* Os = Kf + 32 * 68;
    LAS float* part = Os + 32 * 68  ; LAS float* eg = part + 512; LAS float* gn = eg + 64;
    LAS bf16* Qt = (LAS bf16*)(gn + 64);   LAS bf16* St = Qt + 32 * 72;   LAS bf16* Kt = St + 64 * 72;   LAS bf16* Vt = Kt + 64 * 40;   LAS bf16* Am = Vt + 64 * 40;
    const int d = tid & 63, jg = tid >> 6;
    float lb, oml, loglb, l1mlb;
    { const int cidx = h * 64 + d; float z[4]; float zm = -INFINITY;
#pragma unroll
      for (int q = 0; q < 4; ++q) { z[q] = a.hgrn_lb_logits[q * 256 + cidx]; zm = fmaxf(zm, z[q]); }
      float e[4], es = 0.f;
#pragma unroll
      for (int q = 0; q < 4; ++q) { e[q] = expf(z[q] - zm); es += e[q]; }
      float cum = 0.f; lb = 0.f;
#pragma unroll
      for (int q = 0; q < 4; ++q) { cum += e[q] / es; if (q == layer) lb = cum; }
      lb -= e[0] / es; if (layer == 0) lb = 0.f;
      oml = 1.f - lb; loglb = (lb > 0.f) ? logf(lb) : -INFINITY; l1mlb = log1pf(-lb); }
    for (int i = tid; i < 64 * 72; i += 512) St[i] = 0;
    if (tid < 64) gn[tid] = a.hgrn_norm_g[layer * 256 + h * 64 + tid];
    f32x4 Sr[2]; Sr[0] = (f32x4){0.f, 0.f, 0.f, 0.f}; Sr[1] = Sr[0];
    __syncthreads();
    for (int c = 0; c < SEQ / 32; ++c) {
        const size_t rbase = (size_t)b * SEQ + c * 32;
        float qf[4], ky[4], vv[4], cs[4];
        { float run = 0.f;
#pragma unroll
          for (int r = 0; r < 4; ++r) { const bf16* yr = Y + (rbase + 4 * jg + r) * NY; const float qv = bf2f(yr[YC_HQ + h * 64 + d]), fv = bf2f(yr[YC_HF + h * 64 + d]); vv[r] = bf2f(yr[YC_HI + h * 64 + d]);
              qf[r] = silu_f(qv); const float ls = logsigmoid_f(fv); float lf;
              if (lb > 0.f) { const float bb = l1mlb + ls; const float mx = fmaxf(loglb, bb); lf = mx + log1pf(__expf(-fabsf(loglb - bb))); } else lf = ls;
              ky[r] = oml * sigmoid_f(-fv); run += lf; cs[r] = run; }
          part[jg * 64 + d] = run; }
        __syncthreads();
        { float pre = 0.f, tot = 0.f;
#pragma unroll
          for (int g = 0; g < 8; ++g) { const float pv = part[g * 64 + d]; tot += pv; if (g < jg) pre += pv; }
#pragma unroll
          for (int r = 0; r < 4; ++r) { const int jr = 4 * jg + r; const float G = pre + cs[r]; Qf[jr * 68 + d] = qf[r]; Gm[jr * 68 + d] = G; Kf[jr * 68 + d] = ky[r];
              Qt[jr * 72 + d] = f2bf16(qf[r] * __expf(G)); Kt[d * 40 + jr] = f2bf16(ky[r] * __expf(tot - G)); Vt[d * 40 + jr] = f2bf16(vv[r]); }
          if (jg == 0) eg[d] = __expf(tot); }
        __syncthreads();
        { const int l = tid >> 4, sg = tid & 15; float acc0 = 0.f, acc1 = 0.f; const bool do1 = (w >= 4);
#pragma unroll 4
          for (int d4 = 0; d4 < 64; d4 += 4) { const f32x4 ql = *(const LAS f32x4*)(Qf + l * 68 + d4), gl = *(const LAS f32x4*)(Gm + l * 68 + d4);
              { const f32x4 k0 = *(const LAS f32x4*)(Kf + sg * 68 + d4), g0 = *(const LAS f32x4*)(Gm + sg * 68 + d4);
#pragma unroll
                for (int i = 0; i < 4; ++i) acc0 += ql[i] * k0[i] * __expf(fminf(gl[i] - g0[i], 0.f)); }
              if (do1) { const f32x4 k1 = *(const LAS f32x4*)(Kf + (sg + 16) * 68 + d4), g1 = *(const LAS f32x4*)(Gm + (sg + 16) * 68 + d4);
#pragma unroll
                for (int i = 0; i < 4; ++i) acc1 += ql[i] * k1[i] * __expf(fminf(gl[i] - g1[i], 0.f)); } }
          Am[l * 40 + sg] = (sg <= l) ? f2bf16(acc0) : (bf16)0; Am[l * 40 + sg + 16] = (do1 && sg + 16 <= l) ? f2bf16(acc1) : (bf16)0; }
        __syncthreads();
        { const int rt = w >> 2, ct = w & 3; f32x4 acc = (f32x4){0.f, 0.f, 0.f, 0.f};
          acc = mma_tile<64>(acc, Qt, 72, rt * 16, St, 72, ct * 16, lane); acc = mma_tile<32>(acc, Am, 40, rt * 16, Vt, 40, ct * 16, lane);
#pragma unroll
          for (int i = 0; i < 4; ++i) Os[(rt * 16 + 4 * (lane >> 4) + i) * 68 + ct * 16 + (lane & 15)] = acc[i];
          const int et = w >> 1;
#pragma unroll
          for (int ci = 0; ci < 2; ++ci) { const int dt = (w & 1) * 2 + ci; Sr[ci] = Sr[ci] * eg[dt * 16 + (lane & 15)]; Sr[ci] = mma_tile<32>(Sr[ci], Vt, 40, et * 16, Kt, 40, dt * 16, lane); } }
        __syncthreads();
        { const int jr = tid >> 4, d4 = (tid & 15) * 4; const f32x4 o = *(const LAS f32x4*)(Os + jr * 68 + d4); float s = (o[0] * o[0] + o[1] * o[1]) + (o[2] * o[2] + o[3] * o[3]);
          s += __shfl_xor(s, 1); s += __shfl_xor(s, 2); s += __shfl_xor(s, 4); s += __shfl_xor(s, 8); const float rs = rsqrtf(s * (1.0f / 64.0f) + EPS);
          const u32x2 rg = *(const u32x2*)(Y + (rbase + jr) * NY + YC_HG + h * 64 + d4); const float g0 = bflo(rg.x), g1 = bfhi(rg.x), g2 = bflo(rg.y), g3 = bfhi(rg.y);
          u32x2 wv; wv.x = pg8::cvt_pk_bf16(o[0] * rs * gn[d4] * silu_f(g0), o[1] * rs * gn[d4 + 1] * silu_f(g1)); wv.y = pg8::cvt_pk_bf16(o[2] * rs * gn[d4 + 2] * silu_f(g2), o[3] * rs * gn[d4 + 3] * silu_f(g3));
          *(u32x2*)(MIX + (rbase + jr) * DM + 256 + h * 64 + d4) = wv; }
        { const int et = w >> 1;
#pragma unroll
          for (int ci = 0; ci < 2; ++ci) { const int dt = (w & 1) * 2 + ci;
#pragma unroll
              for (int i = 0; i < 4; ++i) St[(et * 16 + 4 * (lane >> 4) + i) * 72 + dt * 16 + (lane & 15)] = f2bf16(Sr[ci][i]); } }
    }
    __syncthreads();
}

__device__ __forceinline__ void swa_unit(const Frame& F, const Args& a, int layer, int unit) {
    const int tid_ = F.wave * 64 + lane_id(); const int qb = unit & 15, kvh = (unit >> 4) & 1, b = unit >> 5, tid = tid_, lane = tid & 63, w = F.wave;
    const bf16* Y = (const bf16*)(a.ws + WS_BIG); bf16* MIX = (bf16*)(a.ws + WS_MIX); const float* rope = (const float*)(a.ws + WS_ROPE);
    constexpr int LDK = 72, LDV = 264;
    LAS bf16* Ks = (LAS bf16*)(F.lds); LAS bf16* Vt = Ks + 256 * LDK; LAS bf16* Pw = Vt + 64 * LDV + w * 16 * LDV;
    { const int kk = tid >> 1, half = tid & 1; const int tk = (qb - 1) * 128 + kk;
      if (tk >= 0) { const size_t row = (size_t)b * SEQ + tk; const bf16* yr = Y + row * NY; float x[32];
#pragma unroll
          for (int q = 0; q < 4; ++q) { const u32x4 r = *(const u32x4*)(yr + YC_SK + kvh * 64 + 32 * half + 8 * q); f32x4 v0, v1; pg8::unpack8(r, v0, v1);
#pragma unroll
              for (int i = 0; i < 4; ++i) { x[8 * q + i] = v0[i]; x[8 * q + 4 + i] = v1[i]; } }
          float s = 0.f;
#pragma unroll
          for (int i = 0; i < 32; ++i) s += x[i] * x[i];
          s += __shfl_xor(s, 1); const float rs = rsqrtf(s * (1.0f / 64.0f) + EPS);
#pragma unroll
          for (int i = 0; i < 32; ++i) x[i] = x[i] * rs * a.swa_k_g[layer * 64 + 32 * half + i];
          if (half == 0) {
#pragma unroll
              for (int i = 0; i < 8; ++i) { const float cs = rope[(row * 8 + i) * 2], sn = rope[(row * 8 + i) * 2 + 1]; const float x1 = x[i], x2 = x[8 + i]; x[i] = x1 * cs - x2 * sn; x[8 + i] = x2 * cs + x1 * sn; } }
#pragma unroll
          for (int q = 0; q < 4; ++q) { const f32x4 v0 = {x[8 * q], x[8 * q + 1], x[8 * q + 2], x[8 * q + 3]}, v1 = {x[8 * q + 4], x[8 * q + 5], x[8 * q + 6], x[8 * q + 7]}; *(LAS u32x4*)(Ks + kk * LDK + 32 * half + 8 * q) = pg8::pack8(v0, v1); }
#pragma unroll
          for (int q = 0; q < 4; ++q) { const u32x4 r = *(const u32x4*)(yr + YC_SV + kvh * 64 + 32 * half + 8 * q); const unsigned vw[4] = {r.x, r.y, r.z, r.w};
#pragma unroll
              for (int i = 0; i < 4; ++i) { Vt[(32 * half + 8 * q + 2 * i) * LDV + kk] = (bf16)(vw[i] & 0xffffu); Vt[(32 * half + 8 * q + 2 * i + 1) * LDV + kk] = (bf16)(vw[i] >> 16); } } }
      else { unsigned z0 = 0u; asm volatile("" : "+v"(z0)); const u32x4 z = {z0, z0, z0, z0};
#pragma unroll
          for (int q = 0; q < 4; ++q) *(LAS u32x4*)(Ks + kk * LDK + 32 * half + 8 * q) = z;
#pragma unroll
          for (int i = 0; i < 32; ++i) Vt[(32 * half + i) * LDV + kk] = (bf16)z0; } }
    __syncthreads();
    const int qh = kvh * 4 + (w >> 1); const float sink = a.swa_sinks[layer * 8 + qh];
    const int g4 = lane >> 4;
    for (int grp = 0; grp < 4; ++grp) {
        const int qr0 = (w & 1) * 64 + grp * 16;
        bf16x8 A0, A1;
        { const size_t row = (size_t)b * SEQ + qb * 128 + qr0 + (lane & 15); const bf16* yr = Y + row * NY + YC_SQ + qh * 64;
          const u32x4 r0 = *(const u32x4*)(yr + 8 * g4), r1 = *(const u32x4*)(yr + 32 + 8 * g4); f32x4 a0, a1, b0, b1; pg8::unpack8(r0, a0, a1); pg8::unpack8(r1, b0, b1);
          float s = 0.f;
#pragma unroll
          for (int i = 0; i < 4; ++i) s += a0[i] * a0[i] + a1[i] * a1[i] + b0[i] * b0[i] + b1[i] * b1[i];
          s += __shfl_xor(s, 16); s += __shfl_xor(s, 32); const float rs = rsqrtf(s * (1.0f / 64.0f) + EPS) * 0.125f;
          const float* gq = a.swa_q_g + layer * 64;
#pragma unroll
          for (int i = 0; i < 4; ++i) { a0[i] *= rs * gq[8 * g4 + i]; a1[i] *= rs * gq[8 * g4 + 4 + i]; b0[i] *= rs * gq[32 + 8 * g4 + i]; b1[i] *= rs * gq[32 + 8 * g4 + 4 + i]; }
#pragma unroll
          for (int i = 0; i < 4; ++i) { const float p0 = __shfl_xor(a0[i], 16), p1 = __shfl_xor(a1[i], 16);
              const float c0 = rope[(row * 8 + i) * 2], s0 = rope[(row * 8 + i) * 2 + 1], c1 = rope[(row * 8 + 4 + i) * 2], s1 = rope[(row * 8 + 4 + i) * 2 + 1];
              if (g4 == 0) { a0[i] = a0[i] * c0 - p0 * s0; a1[i] = a1[i] * c1 - p1 * s1; } else if (g4 == 1) { a0[i] = a0[i] * c0 + p0 * s0; a1[i] = a1[i] * c1 + p1 * s1; } }
          A0 = __builtin_bit_cast(bf16x8, pg8::pack8(a0, a1)); A1 = __builtin_bit_cast(bf16x8, pg8::pack8(b0, b1)); }
        f32x4 S[16];
#pragma unroll
        for (int kt = 0; kt < 16; ++kt) { S[kt] = (f32x4){0.f, 0.f, 0.f, 0.f}; S[kt] = __builtin_amdgcn_mfma_f32_16x16x32_bf16(A0, ld_frag(Ks, LDK, kt * 16, 0, lane), S[kt], 0, 0, 0); S[kt] = __builtin_amdgcn_mfma_f32_16x16x32_bf16(A1, ld_frag(Ks, LDK, kt * 16, 32, lane), S[kt], 0, 0, 0); }
        float mx[4], sm[4];
#pragma unroll
        for (int i = 0; i < 4; ++i) { const int qi = qr0 + 4 * g4 + i; float m_ = -INFINITY;
#pragma unroll
            for (int kt = 0; kt < 16; ++kt) { const int ki = kt * 16 + (lane & 15); const bool ok = (ki > qi) && (ki <= qi + 128) && (qb > 0 || ki >= 128); if (!ok) S[kt][i] = -INFINITY; m_ = fmaxf(m_, S[kt][i]); }
            m_ = fmaxf(m_, __shfl_xor(m_, 1)); m_ = fmaxf(m_, __shfl_xor(m_, 2)); m_ = fmaxf(m_, __shfl_xor(m_, 4)); m_ = fmaxf(m_, __shfl_xor(m_, 8)); m_ = fmaxf(m_, sink); mx[i] = m_; float s_ = 0.f;
#pragma unroll
            for (int kt = 0; kt < 16; ++kt) { const float p = __expf(S[kt][i] - m_); s_ += p; Pw[(4 * g4 + i) * LDV + kt * 16 + (lane & 15)] = f2bf16(p); }
            s_ += __shfl_xor(s_, 1); s_ += __shfl_xor(s_, 2); s_ += __shfl_xor(s_, 4); s_ += __shfl_xor(s_, 8); sm[i] = 1.f / (s_ + __expf(sink - m_)); }
        asm volatile("s_waitcnt lgkmcnt(0)" ::: "memory");
        const size_t orow = (size_t)b * SEQ + qb * 128 + qr0 + 4 * g4;
#pragma unroll
        for (int et = 0; et < 4; ++et) { f32x4 o = (f32x4){0.f, 0.f, 0.f, 0.f};
#pragma unroll
            for (int k0 = 0; k0 < 256; k0 += 32) o = __builtin_amdgcn_mfma_f32_16x16x32_bf16(ld_frag(Pw, LDV, 0, k0, lane), ld_frag(Vt, LDV, et * 16, k0, lane), o, 0, 0, 0);
#pragma unroll
            for (int i = 0; i < 4; ++i) MIX[(orow + i) * DM + 512 + qh * 64 + et * 16 + (lane & 15)] = f2bf16(o[i] * sm[i]); }
        asm volatile("s_waitcnt lgkmcnt(0)" ::: "memory");
    }
    __syncthreads();
}

constexpr int N_PHASES = 1 + 6 * DEPTH;
__global__ void __launch_bounds__(NWAVES * 64, 2) trunk_fwd(Args args) {
    extern __shared__ __attribute__((aligned(16))) unsigned char lds_raw[];
    Frame F; F.lds = (LAS unsigned char*)lds_raw; F.wave = __builtin_amdgcn_readfirstlane((int)threadIdx.x >> 6); F.G = gridDim.x; F.gw = blockIdx.x * NWAVES + F.wave; F.NGW = F.G * NWAVES;
    unsigned char* ws = args.ws;
    gu32* ctl = (gu32*)(ws + WS_CTL);
    volatile LAS unsigned* MISC = (volatile LAS unsigned*)(F.lds + MISC_OFF);
    for (int u = threadIdx.x; u < (LDS_BYTES - LDSCTL_OFF) / 4; u += NWAVES * 64) ((LAS unsigned*)(F.lds + LDSCTL_OFF))[u] = 0u;
    __syncthreads();
    const int lo = args.ph_lo, hi = args.ph_hi;
    XcdBarrier bar; bar.bar = (unsigned*)(ctl + CW_BAR); bar.x = 0; bar.st = nullptr;
    if (hi - lo > 1) bar = xcd_barrier_post((unsigned*)(ctl + CW_BAR), MISC + 8);
#ifndef PHASE_MASK
#define PHASE_MASK 0xffff
#endif
#define PHM(b) ((PHASE_MASK >> (b)) & 1)
#define IN(k) (lo <= (k) && (k) < hi)
#define SEAM(k) do { if (IN(k) && IN((k) + 1)) xcd_barrier(bar); } while (0)
    ss_t* stats = (ss_t*)(ws + WS_STATS);
    bf16* Yb = (bf16*)(ws + WS_BIG); bf16* MIXb = (bf16*)(ws + WS_MIX); bf16* HID = (bf16*)(ws + WS_BIG); bf16* ERAW = (bf16*)(ws + WS_ERAW);

    if (PHM(6) && IN(0)) { p0_prologue(F, args); } SEAM(0);

    for (int l = 0; l < DEPTH; ++l) {
        const int pb = 1 + 6 * l;
        bf16* XBc = (bf16*)(ws + ((l & 1) ? WS_XB1 : WS_XB0)); bf16* XBn = (bf16*)(ws + ((l & 1) ? WS_XB0 : WS_XB1));
        if (PHM(0) && IN(pb)) { pg8::Gemm g{XBc, (const bf16*)(ws + WS_WIN) + (size_t)l * NY * DM, M, NY, DM}; pg8::StaticOrder S; S.init(M, NY, F.G, (int)blockIdx.x);
            pg8::EpiIn E{Yb, NY, (const float*)(ws + WS_BIASY) + l * NY, stats + (size_t)(SS_IN + l) * M};
            pg8::gemm_phase<pg8::EpiIn, pg8::StaticOrder, true, true>(F.lds, g, S, E, F.wave); }
        SEAM(pb);
        if (PHM(1) && IN(pb + 1)) { for (int task = blockIdx.x; task < 256 + 1024; task += F.G) {
#ifndef NO_MLSTM
            if (task < 128) mlstm_task(F, args, l, task);
#endif
#ifndef NO_HGRN
            if (task >= 128 && task < 256) hgrn_task(F, args, l, task - 128);
#endif
#ifndef NO_SWA
            if (task >= 256) swa_unit(F, args, l, task - 256);
#endif
 } }
        SEAM(pb + 1);
        if (PHM(2) && IN(pb + 2)) { pg8::Gemm g{MIXb, (const bf16*)(ws + WS_WOUT) + (size_t)l * DM * DM, M, DM, DM}; pg8::StaticOrder S; S.init(M, DM, F.G, (int)blockIdx.x);
            pg8::EpiRes E{XBc, DM, stats + (size_t)(SS_MLP + l) * M};
            pg8::gemm_phase<pg8::EpiRes, pg8::StaticOrder, true, true>(F.lds, g, S, E, F.wave); }
        SEAM(pb + 2);
        if (PHM(3) && IN(pb + 3)) { pg8::Gemm g{XBc, (const bf16*)(ws + WS_WUP) + (size_t)l * FF * DM, M, FF, DM}; pg8::StaticOrder S; S.init(M, FF, F.G, (int)blockIdx.x);
            pg8::EpiUp E{HID, FF, stats + (size_t)(SS_MLP + l) * M};
            pg8::gemm_phase<pg8::EpiUp, pg8::StaticOrder, true, true>(F.lds, g, S, E, F.wave); }
        SEAM(pb + 3);
        if (PHM(4) && IN(pb + 4)) {
            { pg8::Gemm g{HID, (const bf16*)(ws + WS_WDN) + (size_t)l * DM * FF, M, DM, FF}; pg8::StaticOrder S; S.init(M, DM, F.G, (int)blockIdx.x);
              pg8::EpiRes E{XBc, DM, stats + (size_t)(SS_PLE + l) * M};
              pg8::gemm_phase<pg8::EpiRes, pg8::StaticOrder, true, true>(F.lds, g, S, E, F.wave); }
            { pg8::Gemm g{(const bf16*)args.out + (size_t)l * M * PLE, (const bf16*)(ws + WS_WP) + (size_t)l * DM * PLE, M, DM, PLE}; pg8::StaticOrder S; S.init(M, DM, F.G, (int)blockIdx.x);
              pg8::EpiPle E{ERAW, DM, stats + (size_t)(SS_E + l) * M};
              pg8::gemm_phase<pg8::EpiPle, pg8::StaticOrder, true, true>(F.lds, g, S, E, F.wave); } }
        SEAM(pb + 4);
        if (PHM(5) && IN(pb + 5)) { pg8::Gemm g{XBc, (const bf16*)(ws + WS_WG) + (size_t)l * DM * DM, M, DM, DM}; pg8::StaticOrder S; S.init(M, DM, F.G, (int)blockIdx.x);
            const bool last = (l == DEPTH - 1);
            pg8::EpiGate E{XBc, XBn, last ? args.out : nullptr, ERAW, DM, stats + (size_t)(SS_PLE + l) * M, stats + (size_t)(SS_E + l) * M, args.ple_post_g + l * DM, stats + (size_t)(SS_IN + (last ? 0 : l + 1)) * M};
            pg8::gemm_phase<pg8::EpiGate, pg8::StaticOrder, true, true>(F.lds, g, S, E, F.wave); }
        SEAM(pb + 5);
    }
#undef IN
#undef SEAM
}

#ifndef MK_N_LAUNCHES
#define MK_N_LAUNCHES 1
#endif
extern "C" void kernel_launch(void* const* d_in, const int* in_sizes, int n_in, void* d_out, int out_size, void* d_ws, size_t ws_size, hipStream_t stream) {
    static int grid = 0;
    if (grid == 0) {
        if (n_in != 23 || in_sizes[0] != M * DM || out_size != M * DM || ws_size < WS_END) { fprintf(stderr, "kernel_launch: unexpected shapes (n_in %d in0 %d out %d ws %zu); nothing launched\n", n_in, n_in > 0 ? in_sizes[0] : -1, out_size, ws_size); grid = -1; return; }
        int dev = 0, cus = 0, per_cu = 0;
        if (hipGetDevice(&dev) != hipSuccess || hipDeviceGetAttribute(&cus, hipDeviceAttributeMultiprocessorCount, dev) != hipSuccess) { grid = -1; return; }
        if (hipFuncSetAttribute((const void*)trunk_fwd, hipFuncAttributeMaxDynamicSharedMemorySize, LDS_BYTES) != hipSuccess) { fprintf(stderr, "kernel_launch: hipFuncSetAttribute failed\n"); grid = -1; return; }
        if (hipOccupancyMaxActiveBlocksPerMultiprocessor(&per_cu, (const void*)trunk_fwd, NWAVES * 64, LDS_BYTES) != hipSuccess || per_cu < 1) { fprintf(stderr, "kernel_launch: occupancy query says %d blocks per CU\n", per_cu); }
        (void)hipGetLastError();
        grid = cus;
    }
    if (grid < 0) return;
    if (hipMemsetAsync((char*)d_ws, 0, ZERO_BYTES, stream) != hipSuccess) return;
    Args a{};
    a.x = (const float*)d_in[0]; a.p = (const float*)d_in[1]; a.pos = (const int*)d_in[2];
    a.in_norm_g = (const float*)d_in[3]; a.w_in = (const float*)d_in[4]; a.b_in = (const float*)d_in[5]; a.mlstm_f_bias = (const float*)d_in[6]; a.conv_w = (const float*)d_in[7]; a.conv_b = (const float*)d_in[8];
    a.mlstm_norm_g = (const float*)d_in[9]; a.hgrn_lb_logits = (const float*)d_in[10]; a.hgrn_norm_g = (const float*)d_in[11]; a.swa_q_g = (const float*)d_in[12]; a.swa_k_g = (const float*)d_in[13]; a.swa_sinks = (const float*)d_in[14];
    a.w_out = (const float*)d_in[15]; a.mlp_norm_g = (const float*)d_in[16]; a.w_up = (const float*)d_in[17]; a.w_down = (const float*)d_in[18]; a.ple_norm_g = (const float*)d_in[19]; a.w_ple_gate = (const float*)d_in[20];
    a.w_ple_proj = (const float*)d_in[21]; a.ple_post_g = (const float*)d_in[22];
    a.out = (float*)d_out; a.ws = (unsigned char*)d_ws;
    for (int i = 0; i < 8; ++i) a.rope_rev[i] = pow(500000.0, -(double)i / 8.0) / 6.283185307179586476925286766559;
#if MK_N_LAUNCHES == 1
    a.ph_lo = 0; a.ph_hi = N_PHASES;
    hipLaunchKernelGGL(trunk_fwd, dim3(grid), dim3(NWAVES * 64), LDS_BYTES, stream, a);
#else
    for (int ph = 0; ph < N_PHASES; ++ph) { a.ph_lo = ph; a.ph_hi = ph + 1; hipLaunchKernelGGL(trunk_fwd, dim3(grid), dim3(NWAVES * 64), LDS_BYTES, stream, a); }
#endif
}
```

```cpp
#include <hip/hip_runtime.h>
#include <cstdio>
#include <cstdint>
#include <cmath>
namespace pg8 {
#define PG8_LAS __attribute__((address_space(3)))
typedef unsigned short bf16_t;
typedef short bf16x8 __attribute__((ext_vector_type(8)));
typedef float f32x4 __attribute__((ext_vector_type(4)));
typedef unsigned u32x4 __attribute__((ext_vector_type(4)));
constexpr int BM = 256, BK = 64, HALF = 128, HTB = HALF * BK * 2  , STAGE_BYTES = 8 * HTB, NXCD = 8, WGM = 8;

__host__ __device__ __forceinline__ int lds_byte(int r, int c) { const int st = (r >> 4) * 2 + (c >> 5), rr = r & 15, cc = c & 31, ob = rr * 64 + cc * 2; return st * 1024 + (ob ^ (((ob >> 9) & 1) << 5)); }
__host__ __device__ __forceinline__ void stage_rc(int b, int& R, int& C) { const int st = b / 1024, sb = b % 1024, swz = sb ^ (((sb >> 9) & 1) << 5); R = (st >> 1) * 16 + swz / 64; C = (st & 1) * 32 + (swz % 64) / 2; }
__host__ __device__ __forceinline__ int perm32(int rho) { const int n = rho >> 4, i = rho & 15; return 8 * (i >> 2) + 4 * n + (i & 3); }

struct Unit { int pm, pn; };
struct Gemm { const bf16_t* A; const bf16_t* Bt; int M, N, K, lda; size_t a_blk; };

struct StaticOrder {
    int nM, nN, nwg, G, c;
    __host__ __device__ void init(int M, int N, int G_, int c_) { nM = M / BM; nN = N / BM; nwg = nM * nN; G = G_; c = c_; }
    __host__ __device__ bool next(int i, Unit& u) const {
        const long L = (long)i * G + c; if (L >= nwg) return false;
        int wgid = (int)L; { const int q = nwg / NXCD, r = nwg % NXCD, xcd = wgid % NXCD, off = wgid / NXCD; wgid = (xcd < r ? xcd * (q + 1) : r * (q + 1) + (xcd - r) * q) + off; }
        const int nig = WGM * nN, gid = wgid / nig, fm = gid * WGM, gsz = (nM - fm) < WGM ? (nM - fm) : WGM;
        u.pm = fm + ((wgid % nig) % gsz); u.pn = (wgid % nig) / gsz; return true;
    }
    __device__ __forceinline__ void a_ready(const Unit&) const {}
    __device__ __forceinline__ void done(const Unit&) const {}
};
typedef __bf16 bf16x2v_t __attribute__((ext_vector_type(2))); typedef float f32x2v_t __attribute__((ext_vector_type(2)));
__device__ __forceinline__ unsigned cvt_pk_bf16(float lo, float hi) { const f32x2v_t v = {lo, hi}; return __builtin_bit_cast(unsigned, __builtin_convertvector(v, bf16x2v_t)); }
typedef float f32x2 __attribute__((ext_vector_type(2)));
template <class Epi, class Sched, bool ALIGN_EPI = false, bool SP2 = false>
__device__ __forceinline__ void gemm_phase(PG8_LAS unsigned char* lds, const Gemm g, const Sched& S, const Epi& E, const int wave_id) {
    int lid_; asm volatile("v_mbcnt_lo_u32_b32 %0, -1, 0\n\tv_mbcnt_hi_u32_b32 %0, -1, %0" : "=v"(lid_)); const int tid_ = __builtin_amdgcn_readfirstlane(wave_id) * 64 + lid_;
    const int tid = tid_, wid = __builtin_amdgcn_readfirstlane(tid >> 6), lane = tid & 63, wr = wid >> 2, wc = wid & 3, fr = lane & 15, fq = lane >> 4;
    int K_ = g.K; asm volatile("" : "+s"(K_));
    const int K = K_, nt = K / BK;
    unsigned voffA[2], voffB[2];
#pragma unroll
    for (int i = 0; i < 2; ++i) { int R, C; stage_rc(tid * 16 + i * 8192, R, C); const int Rb = Epi::PERM ? ((R & ~31) + perm32(R & 31)) : R;
        voffA[i] = (unsigned)(R * g.lda + C) * 2u; voffB[i] = (unsigned)(Rb * K + C) * 2u; }
    const size_t kstep = (size_t)(BK * 2);
    const size_t hstepB = (size_t)HALF * K * 2, hstepA = (size_t)HALF * g.lda * 2;
    const size_t tstepB = 2 * hstepB, tstepA = 2 * hstepA;
    const unsigned ldsw = (unsigned)wid * 1024u;
    const int aoff = lds_byte(wr * 64 + fr, fq * 8), boff = lds_byte(wc * 32 + fr, fq * 8);
#define PG8_SA(b, h) (((b) * 2 + (h)) * HTB)
#define PG8_SB(b, h) ((4 + (b) * 2 + (h)) * HTB)
#define PG8_STAGE(bufoff, gbase, voff) do { _Pragma("unroll") for (int _i = 0; _i < 2; ++_i) \
        __builtin_amdgcn_global_load_lds((const unsigned*)((const char*)(gbase) + (voff)[_i]), (PG8_LAS unsigned*)(lds + (bufoff) + ldsw + _i * 8192), 16, 0, 0); } while (0)
#define PG8_LDA(dst, b, h) do { _Pragma("unroll") for (int m = 0; m < 4; ++m) _Pragma("unroll") for (int k = 0; k < 2; ++k) dst[m][k] = *(const PG8_LAS bf16x8*)(lds + PG8_SA(b, h) + aoff + m * 2048 + k * 1024); } while (0)
#define PG8_LDB(dst, b, h) do { _Pragma("unroll") for (int n = 0; n < 2; ++n) _Pragma("unroll") for (int k = 0; k < 2; ++k) dst[n][k] = *(const PG8_LAS bf16x8*)(lds + PG8_SB(b, h) + boff + n * 2048 + k * 1024); } while (0)
#define PG8_MMA(ai, bj, At, Bt) do { __builtin_amdgcn_s_setprio(1); _Pragma("unroll") for (int m = 0; m < 4; ++m) _Pragma("unroll") for (int n = 0; n < 2; ++n) _Pragma("unroll") for (int k = 0; k < 2; ++k) \
        acc[ai][bj][m][n] = __builtin_amdgcn_mfma_f32_16x16x32_bf16(Bt[n][k], At[m][k], acc[ai][bj][m][n], 0, 0, 0); __builtin_amdgcn_s_setprio(0); } while (0)
#define PG8_WAIT_V(n) asm volatile("s_waitcnt vmcnt(" #n ")" ::: "memory")
#define PG8_WAIT_L(n) asm volatile("s_waitcnt lgkmcnt(" #n ")" ::: "memory")
#define PG8_BAR __builtin_amdgcn_s_barrier()
#define PG8_SCHED __builtin_amdgcn_sched_barrier(0)
    Unit cur, nxt; int ui = 0;
    if (!S.next(0, cur)) return;
    f32x4 acc[2][2][4][2];
#pragma unroll
    for (int a = 0; a < 2; ++a)
#pragma unroll
        for (int b = 0; b < 2; ++b)
#pragma unroll
            for (int m = 0; m < 4; ++m)
#pragma unroll
                for (int n = 0; n < 2; ++n) acc[a][b][m][n] = (f32x4){0.f, 0.f, 0.f, 0.f};
    bf16x8 At[4][2], B0[2][2], B1[2][2];
    const char* cA = (const char*)g.A + (size_t)cur.pm * tstepA + (size_t)(cur.pm >> 3) * g.a_blk; const char* cB = (const char*)g.Bt + (size_t)cur.pn * tstepB;
    S.a_ready(cur);
    if constexpr (SP2) {
        PG8_STAGE(PG8_SB(0, 0), cB, voffB); PG8_STAGE(PG8_SB(0, 1), cB + hstepB, voffB); PG8_STAGE(PG8_SA(0, 0), cA, voffA); PG8_STAGE(PG8_SA(0, 1), cA + hstepA, voffA);
        if (wr == 1) PG8_BAR;
        PG8_WAIT_V(2); PG8_BAR;
        PG8_STAGE(PG8_SB(1, 0), cB + kstep, voffB); PG8_STAGE(PG8_SA(1, 0), cA + kstep, voffA); PG8_STAGE(PG8_SB(1, 1), cB + hstepB + kstep, voffB);
        PG8_WAIT_V(6); PG8_BAR;
    } else {
        PG8_STAGE(PG8_SB(0, 0), cB, voffB); PG8_STAGE(PG8_SA(0, 0), cA, voffA); PG8_STAGE(PG8_SB(0, 1), cB + hstepB, voffB); PG8_STAGE(PG8_SA(0, 1), cA + hstepA, voffA);
        if (wr == 1) PG8_BAR;
        PG8_WAIT_V(4); PG8_BAR;
        PG8_STAGE(PG8_SB(1, 0), cB + kstep, voffB); PG8_STAGE(PG8_SA(1, 0), cA + kstep, voffA); PG8_STAGE(PG8_SB(1, 1), cB + hstepB + kstep, voffB);
        PG8_WAIT_V(6); PG8_BAR;
    }
    for (;;) {
        const bool has_next = S.next(ui + 1, nxt);
        const char* nA = has_next ? (const char*)g.A + (size_t)nxt.pm * tstepA + (size_t)(nxt.pm >> 3) * g.a_blk : cA; const char* nB = has_next ? (const char*)g.Bt + (size_t)nxt.pn * tstepB : cB;
        for (int t = 0; t < nt; t += 2) {
            const bool last = (t == nt - 2);
            const char* a1 = cA + (size_t)(t + 1) * kstep;
            const char* a2 = last ? nA : cA + (size_t)(t + 2) * kstep; const char* b2 = last ? nB : cB + (size_t)(t + 2) * kstep;
            const char* a3 = a2 + kstep; const char* b3 = b2 + kstep;
            if (last && has_next) S.a_ready(nxt);
            if constexpr (SP2) {
            PG8_LDB(B0, 0, 0); PG8_LDB(B1, 0, 1); PG8_SCHED; PG8_LDA(At, 0, 0); PG8_STAGE(PG8_SA(1, 1), a1 + hstepA, voffA);
            PG8_WAIT_V(8); PG8_WAIT_L(0); PG8_BAR; PG8_MMA(0, 0, At, B0); PG8_MMA(0, 1, At, B1); PG8_BAR; PG8_SCHED;
            PG8_LDA(At, 0, 1); PG8_STAGE(PG8_SB(0, 0), b2, voffB); PG8_STAGE(PG8_SB(0, 1), b2 + hstepB, voffB); PG8_STAGE(PG8_SA(0, 0), a2, voffA);
            PG8_WAIT_V(8); PG8_WAIT_L(0); PG8_BAR; PG8_MMA(1, 0, At, B0); PG8_MMA(1, 1, At, B1); PG8_BAR; PG8_SCHED;
            PG8_LDB(B0, 1, 0); PG8_LDB(B1, 1, 1); PG8_SCHED; PG8_LDA(At, 1, 0); PG8_STAGE(PG8_SA(0, 1), a2 + hstepA, voffA);
            PG8_WAIT_V(8); PG8_WAIT_L(0); PG8_BAR; PG8_MMA(0, 0, At, B0); PG8_MMA(0, 1, At, B1); PG8_BAR; PG8_SCHED;
            PG8_LDA(At, 1, 1); PG8_STAGE(PG8_SB(1, 0), b3, voffB); PG8_STAGE(PG8_SB(1, 1), b3 + hstepB, voffB); PG8_STAGE(PG8_SA(1, 0), a3, voffA);
            PG8_WAIT_V(8); PG8_WAIT_L(0); PG8_BAR; PG8_MMA(1, 0, At, B0); PG8_MMA(1, 1, At, B1); PG8_BAR; PG8_SCHED;
            } else {
            PG8_LDB(B0, 0, 0); PG8_SCHED; PG8_LDA(At, 0, 0); PG8_STAGE(PG8_SA(1, 1), a1 + hstepA, voffA);
            PG8_WAIT_L(8); PG8_BAR; PG8_WAIT_L(0); PG8_MMA(0, 0, At, B0); PG8_BAR; PG8_SCHED;
            PG8_LDB(B1, 0, 1); PG8_STAGE(PG8_SB(0, 0), b2, voffB);
            PG8_BAR; PG8_WAIT_L(0); PG8_MMA(0, 1, At, B1); PG8_BAR;
            PG8_LDA(At, 0, 1); PG8_STAGE(PG8_SA(0, 0), a2, voffA);
            PG8_BAR; PG8_WAIT_L(0); PG8_MMA(1, 0, At, B0); PG8_BAR; PG8_SCHED;
            PG8_STAGE(PG8_SB(0, 1), b2 + hstepB, voffB);
            PG8_WAIT_V(6); PG8_BAR; PG8_MMA(1, 1, At, B1); PG8_BAR;
            PG8_LDB(B0, 1, 0); PG8_SCHED; PG8_LDA(At, 1, 0); PG8_STAGE(PG8_SA(0, 1), a2 + hstepA, voffA);
            PG8_WAIT_L(8); PG8_BAR; PG8_WAIT_L(0); PG8_MMA(0, 0, At, B0); PG8_BAR; PG8_SCHED;
            PG8_LDB(B1, 1, 1); PG8_STAGE(PG8_SB(1, 0), b3, voffB);
            PG8_BAR; PG8_WAIT_L(0); PG8_MMA(0, 1, At, B1); PG8_BAR;
            PG8_LDA(At, 1, 1); PG8_STAGE(PG8_SA(1, 0), a3, voffA);
            PG8_BAR; PG8_WAIT_L(0); PG8_MMA(1, 0, At, B0); PG8_BAR; PG8_SCHED;
            PG8_STAGE(PG8_SB(1, 1), b3 + hstepB, voffB);
            PG8_WAIT_V(6); PG8_BAR; PG8_MMA(1, 1, At, B1); PG8_BAR;
            }
        }
        if constexpr (ALIGN_EPI) { if (wr == 0) PG8_BAR; }
        if constexpr (!Epi::AFTER_DRAIN) { E(acc, cur, wr, wc, fr, fq); S.done(cur); }
        if (!has_next) break;
#pragma unroll
        for (int a = 0; a < 2; ++a)
#pragma unroll
            for (int b = 0; b < 2; ++b)
#pragma unroll
                for (int m = 0; m < 4; ++m)
#pragma unroll
                    for (int n = 0; n < 2; ++n) acc[a][b][m][n] = (f32x4){0.f, 0.f, 0.f, 0.f};
        cur = nxt; cA = nA; cB = nB; ++ui;
        if constexpr (ALIGN_EPI) { if (wr == 1) PG8_BAR; }
    }
    PG8_WAIT_V(0);
    if constexpr (!ALIGN_EPI) { if (wr == 0) PG8_BAR; }
    PG8_BAR;
    if constexpr (Epi::AFTER_DRAIN) { E.fused(acc, cur, wr, wc, fr, fq, lds, wid, lane); S.done(cur); }
#undef PG8_SA
#undef PG8_SB
#undef PG8_STAGE
#undef PG8_LDA
#undef PG8_LDB
#undef PG8_MMA
#undef PG8_WAIT_V
#undef PG8_WAIT_L
#undef PG8_BAR
#undef PG8_SCHED
}
}

namespace pg8 {
struct GroupOrder {
    int nM, nN, nwg, G, c, pm_base, remap;
    __device__ __forceinline__ void init(int nM_, int pm_base_, int N, int G_, int c_, int remap_) { nM = nM_; nN = N / BM; nwg = nM * nN; G = G_; c = c_; pm_base = pm_base_; remap = remap_; }
    __device__ __forceinline__ bool next(int i, Unit& u) const {
        const long L = (long)i * G + c; if (L >= nwg) return false;
        int wgid = (int)L; if (remap) { const int q = nwg / NXCD, r = nwg % NXCD, xcd = wgid % NXCD, off = wgid / NXCD; wgid = (xcd < r ? xcd * (q + 1) : r * (q + 1) + (xcd - r) * q) + off; }
        const int nig = WGM * nN, gid = wgid / nig, fm = gid * WGM, gsz = (nM - fm) < WGM ? (nM - fm) : WGM;
        u.pm = pm_base + fm + ((wgid % nig) % gsz); u.pn = (wgid % nig) / gsz; return true;
    }
    __device__ __forceinline__ void a_ready(const Unit&) const {}
    __device__ __forceinline__ void done(const Unit&) const {}
};
}
constexpr int NWAVES = 8;
constexpr int BATCH = 32, SEQ = 2048, DM = 1024, DEPTH = 4, M = BATCH * SEQ, NY = 3072, FF = 4096, PLE = 256, INW = 2824;
constexpr float EPS = 1e-6f;
constexpr int YC_MQ = 0, YC_MK = 256, YC_MV = 512, YC_MO = 768, YC_HQ = 1024, YC_HF = 1280, YC_HI = 1536, YC_HG = 1792, YC_SQ = 2048, YC_SK = 2560, YC_SV = 2688, YC_MI = 2816, YC_MF = 2820;

constexpr size_t MiB = 1u << 20;
constexpr size_t WS_CTL = 0, WS_STATS = 1 * MiB, ZERO_BYTES = 9 * MiB;
constexpr size_t WS_ROPE = 9 * MiB;
constexpr size_t WS_BIASY = 13 * MiB;
constexpr size_t WS_WIN = 14 * MiB, WS_WOUT = 38 * MiB, WS_WUP = 46 * MiB, WS_WDN = 78 * MiB, WS_WG = 110 * MiB, WS_WP = 118 * MiB;
constexpr size_t WS_XB0 = 120 * MiB, WS_XB1 = 248 * MiB;
constexpr size_t WS_BIG = 376 * MiB;
constexpr size_t WS_MIX = WS_BIG + 12 * MiB;
constexpr size_t Y_BLK = 4 * MiB, MIX_BLK = 12 * MiB;
constexpr size_t WS_ERAW = 888 * MiB;
constexpr size_t WS_END = 1016 * MiB;
constexpr int SS_IN = 0, SS_MLP = 4, SS_PLE = 8, SS_E = 12;
constexpr int CW_BAR = 4096, CW_QUEUE = 16384, CW_LBAR = 32768, CW_QBAR = 65536;

constexpr int SCR_BYTES = 159744;
constexpr int LDSCTL_OFF = SCR_BYTES, MISC_OFF = LDSCTL_OFF + 320;
constexpr int LDS_BYTES = 163840;

#define GAS __attribute__((address_space(1)))
#define LAS __attribute__((address_space(3)))
typedef unsigned short bf16;
typedef unsigned v4u __attribute__((ext_vector_type(4)));
typedef float f32x4 __attribute__((ext_vector_type(4)));
typedef short bf16x8 __attribute__((ext_vector_type(8)));
typedef GAS unsigned gu32;
typedef GAS unsigned long long gu64;
#define RLX_AGENT __ATOMIC_RELAXED, __HIP_MEMORY_SCOPE_AGENT
#define LDS_WAIT() asm volatile("s_waitcnt lgkmcnt(0)" ::: "memory")
#define VM_WAIT() asm volatile("s_waitcnt vmcnt(0)" ::: "memory")
__device__ __forceinline__ unsigned long long rt() { return __builtin_amdgcn_s_memrealtime(); }
__device__ __forceinline__ unsigned f2bf(float f) { unsigned u = __builtin_bit_cast(unsigned, f); return (u + 0x7fffu + ((u >> 16) & 1u)) >> 16; }
__device__ __forceinline__ unsigned pk2(float lo, float hi) { return f2bf(lo) | (f2bf(hi) << 16); }
typedef unsigned u32x4 __attribute__((ext_vector_type(4)));
typedef unsigned u32x2 __attribute__((ext_vector_type(2)));
#define XB_TMO      128
#define XB_XCNT(j)  (256  + 64 * (j))
#define XB_XSUB(j)  (1280 + 64 * (j))
#define XB_XGEN(j)  (2304 + 64 * (j))
#define XB_TOP      3328
#define XB_TOPGEN   3392
#define XCD_BAR_WORDS 3456
#define XB_SPIN_CAP (1u << 18)

__device__ __forceinline__ unsigned xb_ld(unsigned* p)              { return __hip_atomic_load(p, __ATOMIC_RELAXED, __HIP_MEMORY_SCOPE_AGENT); }
__device__ __forceinline__ unsigned xb_add(unsigned* p, unsigned v) { return __hip_atomic_fetch_add(p, v, __ATOMIC_RELAXED, __HIP_MEMORY_SCOPE_AGENT); }
__device__ __forceinline__ unsigned xb_xcc_id() { return (unsigned)__builtin_amdgcn_s_getreg((3 << 11) | 20) & 0xFu; }
#define XB_SPIN(cond, bar) do { unsigned _sp = 0; while (cond) { __builtin_amdgcn_s_sleep(1); \
    if ((++_sp & 255u) == 0u) { if (xb_ld(&(bar)[XB_TMO])) break; if (_sp > XB_SPIN_CAP) { atomicAdd(&(bar)[XB_TMO], 1u); break; } } } } while (0)

struct XcdBarrier {
    unsigned* bar; unsigned x;
    volatile LAS unsigned* st;
};

__device__ __forceinline__ XcdBarrier xcd_barrier_post(unsigned* bar, volatile LAS unsigned* st) {
    XcdBarrier b; b.bar = bar; b.x = xb_xcc_id(); b.st = st;
    if (threadIdx.x == 0) (void)xb_add(&bar[XB_XCNT(b.x)], 1u);
    return b;
}
__device__ __forceinline__ void xcd_barrier_complete(unsigned* bar, unsigned x, unsigned& nloc, unsigned& nx) {
    const unsigned G = gridDim.x * gridDim.y * gridDim.z;
    unsigned sum, cnt, mine, sp = 0u;
    for (;;) {
        sum = 0u; cnt = 0u; mine = 0u;
#pragma unroll
        for (unsigned j = 0; j < 16; ++j) { const unsigned c = xb_ld(&bar[XB_XCNT(j)]); sum += c; cnt += (c > 0u) ? 1u : 0u; mine = (j == x) ? c : mine; }
        if (sum == G) break;
        __builtin_amdgcn_s_sleep(1);
        if ((++sp & 255u) == 0u) { if (xb_ld(&bar[XB_TMO])) break; if (sp > XB_SPIN_CAP) { atomicAdd(&bar[XB_TMO], 1u); break; } }
    }
    nloc = mine > 0u ? mine : 1u; nx = cnt > 0u ? cnt : 1u;
}

__device__ __forceinline__ void xcd_barrier(const XcdBarrier& b) {
    asm volatile("s_waitcnt vmcnt(0)" ::: "memory");
    __syncthreads();
    if (threadIdx.x == 0) {
        unsigned* bar = b.bar;
        __builtin_amdgcn_s_waitcnt(0);
        unsigned nloc = b.st[0], nx = b.st[1];
        if (nloc == 0u) { xcd_barrier_complete(bar, b.x, nloc, nx); b.st[0] = nloc; b.st[1] = nx; }
        const unsigned old = xb_add(&bar[XB_XSUB(b.x)], 1u);
        const unsigned gen = old / nloc;
        if (old + 1u == (gen + 1u) * nloc) {
            __builtin_amdgcn_fence(__ATOMIC_RELEASE, "agent");
            asm volatile("s_waitcnt vmcnt(0)" ::: "memory");
            const unsigned og = xb_add(&bar[XB_TOP], 1u);
            const unsigned tg = og / nx;
            if (og + 1u == (tg + 1u) * nx) xb_add(&bar[XB_TOPGEN], 1u);
            else XB_SPIN(xb_ld(&bar[XB_TOPGEN]) == tg, bar);
            __builtin_amdgcn_fence(__ATOMIC_ACQUIRE, "agent");
            xb_add(&bar[XB_XGEN(b.x)], 1u);
            asm volatile("s_waitcnt vmcnt(0)" ::: "memory");
        } else {
            XB_SPIN(xb_ld(&bar[XB_XGEN(b.x)]) == gen, bar);
            __builtin_amdgcn_fence(__ATOMIC_ACQUIRE, "agent");
            asm volatile("s_waitcnt vmcnt(0)" ::: "memory");
        }
    }
    __syncthreads();
}

__device__ __forceinline__ float bf2f(unsigned short b) { return __uint_as_float((unsigned)b << 16); }
__device__ __forceinline__ float bflo(unsigned w) { return __uint_as_float(w << 16); }
__device__ __forceinline__ float bfhi(unsigned w) { return __uint_as_float(w & 0xffff0000u); }
__device__ __forceinline__ unsigned short f2bf16(float f) { return (unsigned short)f2bf(f); }
__device__ __forceinline__ float sigmoid_f(float x) { return 1.f / (1.f + __expf(-x)); }
__device__ __forceinline__ float silu_f(float x) { return x * sigmoid_f(x); }
__device__ __forceinline__ float logsigmoid_f(float x) { return fminf(x, 0.f) - log1pf(__expf(-fabsf(x))); }
__device__ __forceinline__ float wave_sum(float v) {
#pragma unroll
    for (int o = 1; o < 64; o <<= 1) v += __shfl_xor(v, o);
    return v;
}
typedef unsigned long long ss_t;
__device__ __forceinline__ void atomic_add_ss(ss_t* p, float v) { atomicAdd(p, (ss_t)(v * 16777216.0f)); }
__device__ __forceinline__ float ss_rstd_v(ss_t v, float inv_n) { const u32x2 hl_ = __builtin_bit_cast(u32x2, v); const float f = __builtin_fmaf((float)hl_.y, 4294967296.0f, (float)hl_.x); return __builtin_amdgcn_rsqf(f * (inv_n * (1.0f / 16777216.0f)) + 1e-6f); }
__device__ __forceinline__ float ss_rstd(const ss_t* p, float inv_n) { return rsqrtf((float)(*p) * (inv_n * (1.0f / 16777216.0f)) + 1e-6f); }

namespace pg8 {
__device__ __forceinline__ int epi_lane() { int x; asm volatile("v_mbcnt_lo_u32_b32 %0, -1, 0\n\tv_mbcnt_hi_u32_b32 %0, -1, %0" : "=v"(x)); return x; }
#define EPI_ROWCOL const int ln_ = epi_lane(); fr = ln_ & 15; fq = ln_ >> 4; const int row0 = u.pm * BM + wr * 64 + fr; const int col0 = u.pn * BM + wc * 32 + 8 * fq;
__device__ __forceinline__ float sum_x16x32(float x) { auto r = __builtin_amdgcn_permlane16_swap(__float_as_uint(x), __float_as_uint(x), false, false); x = __uint_as_float(r[0]) + __uint_as_float(r[1]);
    auto q = __builtin_amdgcn_permlane32_swap(__float_as_uint(x), __float_as_uint(x), false, false); return __uint_as_float(q[0]) + __uint_as_float(q[1]); }
__device__ __forceinline__ u32x4 pack8(const f32x4 v0, const f32x4 v1) { u32x4 w; w.x = cvt_pk_bf16(v0[0], v0[1]); w.y = cvt_pk_bf16(v0[2], v0[3]); w.z = cvt_pk_bf16(v1[0], v1[1]); w.w = cvt_pk_bf16(v1[2], v1[3]); return w; }
__device__ __forceinline__ float sq8(const u32x4 w) { float s = 0.f;
    { float a = __uint_as_float(w.x << 16), b = __uint_as_float(w.x & 0xffff0000u); s += a * a + b * b; }
    { float a = __uint_as_float(w.y << 16), b = __uint_as_float(w.y & 0xffff0000u); s += a * a + b * b; }
    { float a = __uint_as_float(w.z << 16), b = __uint_as_float(w.z & 0xffff0000u); s += a * a + b * b; }
    { float a = __uint_as_float(w.w << 16), b = __uint_as_float(w.w & 0xffff0000u); s += a * a + b * b; } return s; }
typedef __bf16 bf16x2v __attribute__((ext_vector_type(2)));
__device__ __forceinline__ float dot2sq(unsigned w, float s) { const bf16x2v v = __builtin_bit_cast(bf16x2v, w); return __builtin_amdgcn_fdot2_f32_bf16(v, v, s, false); }
__device__ __forceinline__ void sqacc8(const u32x4 w, float& s0, float& s1) { s0 = dot2sq(w.x, s0); s1 = dot2sq(w.y, s1); s0 = dot2sq(w.z, s0); s1 = dot2sq(w.w, s1); }
__device__ __forceinline__ float rs4(float q0, float q1, float q2, float q3) {
    auto r = __builtin_amdgcn_permlane32_swap(__float_as_uint(q0), __float_as_uint(q2), false, false); const float a = __uint_as_float(r[0]) + __uint_as_float(r[1]);
    auto t = __builtin_amdgcn_permlane32_swap(__float_as_uint(q1), __float_as_uint(q3), false, false); const float c = __uint_as_float(t[0]) + __uint_as_float(t[1]);
    auto z = __builtin_amdgcn_permlane16_swap(__float_as_uint(a), __float_as_uint(c), false, false); return __uint_as_float(z[0]) + __uint_as_float(z[1]); }
__device__ __forceinline__ float ssq8(const f32x4 a, const f32x4 b) { return ((a[0] * a[0] + a[1] * a[1]) + (a[2] * a[2] + a[3] * a[3])) + ((b[0] * b[0] + b[1] * b[1]) + (b[2] * b[2] + b[3] * b[3])); }
__device__ __forceinline__ void unpack8(const u32x4 w, f32x4& v0, f32x4& v1) {
    v0 = (f32x4){__uint_as_float(w.x << 16), __uint_as_float(w.x & 0xffff0000u), __uint_as_float(w.y << 16), __uint_as_float(w.y & 0xffff0000u)};
    v1 = (f32x4){__uint_as_float(w.z << 16), __uint_as_float(w.z & 0xffff0000u), __uint_as_float(w.w << 16), __uint_as_float(w.w & 0xffff0000u)}; }

struct EpiIn {
    static constexpr bool PERM = true, AFTER_DRAIN = false;
    bf16_t* O; int ldc; const float* bias; const ss_t* ss; size_t oblk;
    __device__ __forceinline__ void operator()(const f32x4 (&acc)[2][2][4][2], const Unit& u, int wr, int wc, int fr, int fq) const {
        EPI_ROWCOL
        f32x4 bv[2][2]; ss_t sv[2][4];
#pragma unroll
        for (int ai = 0; ai < 2; ++ai)
#pragma unroll
            for (int m = 0; m < 4; ++m) sv[ai][m] = ss[row0 + ai * HALF + m * 16];
#pragma unroll
        for (int bj = 0; bj < 2; ++bj)
#pragma unroll
            for (int n = 0; n < 2; ++n) bv[bj][n] = *(const f32x4*)(bias + col0 + bj * HALF + 4 * n);
#pragma unroll
        for (int ai = 0; ai < 2; ++ai)
#pragma unroll
            for (int m = 0; m < 4; ++m) { const int row = row0 + ai * HALF + m * 16; const float rs = ss_rstd_v(sv[ai][m], 1.0f / 1024.0f); bf16_t* rowp = O + (size_t)(u.pm >> 3) * oblk + (size_t)row * ldc + col0;
#pragma unroll
                for (int bj = 0; bj < 2; ++bj) { const f32x4 v0 = acc[ai][bj][m][0] * rs + bv[bj][0], v1 = acc[ai][bj][m][1] * rs + bv[bj][1]; *(u32x4*)(rowp + bj * HALF) = pack8(v0, v1); } }
    }
};
struct EpiRes {
    static constexpr bool PERM = true, AFTER_DRAIN = false;
    bf16_t* X; bf16_t* Xo; int ldc; ss_t* ss_out;
    __device__ __forceinline__ void operator()(const f32x4 (&acc)[2][2][4][2], const Unit& u, int wr, int wc, int fr, int fq) const {
        EPI_ROWCOL
        u32x4 old[2][4][2];
#pragma unroll
        for (int ai = 0; ai < 2; ++ai)
#pragma unroll
            for (int m = 0; m < 4; ++m)
#pragma unroll
                for (int bj = 0; bj < 2; ++bj) old[ai][m][bj] = *(const u32x4*)(X + (size_t)(row0 + ai * HALF + m * 16) * ldc + col0 + bj * HALF);
        asm volatile("" ::: "memory");
#pragma unroll
        for (int ai = 0; ai < 2; ++ai)
        { float q[4];
#pragma unroll
            for (int m = 0; m < 4; ++m) { const int row = row0 + ai * HALF + m * 16; bf16_t* rowp = Xo + (size_t)row * ldc + col0; float s0 = 0.f, s1 = 0.f;
#pragma unroll
                for (int bj = 0; bj < 2; ++bj) { f32x4 o0, o1; unpack8(old[ai][m][bj], o0, o1);
                    const f32x4 n0 = o0 + acc[ai][bj][m][0], n1 = o1 + acc[ai][bj][m][1]; const u32x4 w = pack8(n0, n1); *(u32x4*)(rowp + bj * HALF) = w; sqacc8(w, s0, s1); }
                q[m] = s0 + s1; }
            atomic_add_ss(ss_out + row0 + ai * HALF + 16 * fq, rs4(q[0], q[1], q[2], q[3])); }
    }
};
struct EpiUp {
    static constexpr bool PERM = true, AFTER_DRAIN = false;
    bf16_t* O; int ldc; const ss_t* ss;
    __device__ __forceinline__ void operator()(const f32x4 (&acc)[2][2][4][2], const Unit& u, int wr, int wc, int fr, int fq) const {
        EPI_ROWCOL
        ss_t sv[2][4];
#pragma unroll
        for (int ai = 0; ai < 2; ++ai)
#pragma unroll
            for (int m = 0; m < 4; ++m) sv[ai][m] = ss[row0 + ai * HALF + m * 16];
#pragma unroll
        for (int ai = 0; ai < 2; ++ai)
#pragma unroll
            for (int m = 0; m < 4; ++m) { const int row = row0 + ai * HALF + m * 16; const float rs = ss_rstd_v(sv[ai][m], 1.0f / 1024.0f); bf16_t* rowp = O + (size_t)row * ldc + col0;
#pragma unroll
                for (int bj = 0; bj < 2; ++bj) { f32x4 v0 = acc[ai][bj][m][0] * rs, v1 = acc[ai][bj][m][1] * rs;
#pragma unroll
                    for (int j = 0; j < 4; ++j) { const float a = fmaxf(v0[j], 0.f), b = fmaxf(v1[j], 0.f); v0[j] = a * a; v1[j] = b * b; }
                    *(u32x4*)(rowp + bj * HALF) = pack8(v0, v1); } }
    }
};
struct EpiPle {
    static constexpr bool PERM = true, AFTER_DRAIN = false;
    bf16_t* O; int ldc; ss_t* ss_out; const float* gpost;
    __device__ __forceinline__ void operator()(const f32x4 (&acc)[2][2][4][2], const Unit& u, int wr, int wc, int fr, int fq) const {
        EPI_ROWCOL
        f32x4 gp[2][2];
#pragma unroll
        for (int bj = 0; bj < 2; ++bj)
#pragma unroll
            for (int n = 0; n < 2; ++n) gp[bj][n] = *(const f32x4*)(gpost + col0 + bj * HALF + 4 * n);
#pragma unroll
        for (int ai = 0; ai < 2; ++ai)
        { float q[4];
#pragma unroll
            for (int m = 0; m < 4; ++m) { const int row = row0 + ai * HALF + m * 16; bf16_t* rowp = O + (size_t)row * ldc + col0; f32x4 sv = {0.f, 0.f, 0.f, 0.f};
#pragma unroll
                for (int bj = 0; bj < 2; ++bj) { const f32x4 a0 = acc[ai][bj][m][0], a1 = acc[ai][bj][m][1]; *(u32x4*)(rowp + bj * HALF) = pack8(a0 * gp[bj][0], a1 * gp[bj][1]);
                    sv += a0 * a0; sv += a1 * a1; }
                q[m] = (sv[0] + sv[1]) + (sv[2] + sv[3]); }
            atomic_add_ss(ss_out + row0 + ai * HALF + 16 * fq, rs4(q[0], q[1], q[2], q[3])); }
    }
};
template <bool LAST> struct EpiGate {
    static constexpr bool PERM = true, AFTER_DRAIN = false;
    const bf16_t* Xin; bf16_t* Xout; float* Fout; const bf16_t* E; int ldc; const ss_t* ss_x; const ss_t* ss_e; ss_t* ss_out;
    __device__ __forceinline__ void operator()(const f32x4 (&acc)[2][2][4][2], const Unit& u, int wr, int wc, int fr, int fq) const {
        EPI_ROWCOL
        u32x4 xo[2][2][2], ev[2][2][2]; ss_t sx[2][2], se[2][2];
#define GATE_LOAD(q_, b_) do { const int ai_ = (q_) >> 1, m0_ = ((q_) & 1) * 2; \
            _Pragma("unroll") for (int mm = 0; mm < 2; ++mm) { const int row_ = row0 + ai_ * HALF + (m0_ + mm) * 16; sx[b_][mm] = ss_x[row_]; se[b_][mm] = ss_e[row_]; \
                _Pragma("unroll") for (int bj = 0; bj < 2; ++bj) { const size_t off_ = (size_t)row_ * ldc + col0 + bj * HALF; xo[b_][mm][bj] = *(const u32x4*)(Xin + off_); ev[b_][mm][bj] = *(const u32x4*)(E + off_); } } } while (0)
        GATE_LOAD(0, 0);
        float q[4] = {0.f, 0.f, 0.f, 0.f};
#pragma unroll
        for (int qtr = 0; qtr < 4; ++qtr) {
            const int ai = qtr >> 1, m0 = (qtr & 1) * 2, cb = qtr & 1;
            if (qtr < 3) GATE_LOAD(qtr + 1, cb ^ 1);
            asm volatile("" ::: "memory");
#pragma unroll
            for (int mm = 0; mm < 2; ++mm) { const int m = m0 + mm; const int row = row0 + ai * HALF + m * 16; const size_t off = (size_t)row * ldc + col0; float s0 = 0.f, s1 = 0.f;
                const float nrsx2 = -1.4426950408889634f * ss_rstd_v(sx[cb][mm], 1.0f / 1024.0f), rse = ss_rstd_v(se[cb][mm], 1.0f / 1024.0f);
#pragma unroll
                for (int bj = 0; bj < 2; ++bj) { f32x4 x0, x1, e0, e1; unpack8(xo[cb][mm][bj], x0, x1); unpack8(ev[cb][mm][bj], e0, e1);
                    f32x4 d0 = acc[ai][bj][m][0] * nrsx2, d1 = acc[ai][bj][m][1] * nrsx2;
#pragma unroll
                    for (int j = 0; j < 4; ++j) { d0[j] = __builtin_amdgcn_exp2f(d0[j]); d1[j] = __builtin_amdgcn_exp2f(d1[j]); }
                    d0 = d0 + 1.f; d1 = d1 + 1.f;
#pragma unroll
                    for (int j = 0; j < 4; ++j) { d0[j] = __builtin_amdgcn_rcpf(d0[j]); d1[j] = __builtin_amdgcn_rcpf(d1[j]); }
                    const f32x4 r0 = x0 + d0 * (e0 * rse), r1 = x1 + d1 * (e1 * rse);
                    if constexpr (LAST) { *(f32x4*)(Fout + off + bj * HALF) = r0; *(f32x4*)(Fout + off + bj * HALF + 4) = r1; }
                    else { const u32x4 w = pack8(r0, r1); *(u32x4*)(Xout + off + bj * HALF) = w; sqacc8(w, s0, s1); } }
                q[m] = s0 + s1; }
            if constexpr (!LAST) { if (qtr & 1) atomic_add_ss(ss_out + row0 + ai * HALF + 16 * fq, rs4(q[0], q[1], q[2], q[3])); } }
#undef GATE_LOAD
    }
};
}

struct Args {
    const float* x; const float* p; const int* pos;
    const float *in_norm_g, *w_in, *b_in, *mlstm_f_bias, *conv_w, *conv_b, *mlstm_norm_g, *hgrn_lb_logits, *hgrn_norm_g, *swa_q_g, *swa_k_g, *swa_sinks, *w_out, *mlp_norm_g, *w_up, *w_down,
        *ple_norm_g, *w_ple_gate, *w_ple_proj, *ple_post_g;
    float* out; unsigned char* ws;
    double rope_rev[8];
    int ph_lo, ph_hi;
};
struct Frame {
    LAS unsigned char* lds; int wave, G, gw, NGW;
    int local, grp, gsz, ceff;
};
typedef const __attribute__((address_space(4))) Args* ArgsP;
__device__ __forceinline__ ArgsP get_args() { ArgsP p = (ArgsP)__builtin_amdgcn_kernarg_segment_ptr(); asm volatile("" : "+s"(p)); return p; }
__device__ __forceinline__ int lane_id() { int x; asm volatile("v_mbcnt_lo_u32_b32 %0, -1, 0\n\tv_mbcnt_hi_u32_b32 %0, -1, %0" : "=v"(x)); return x; }

template <class ColMap>
__device__ __forceinline__ void transpose_item(const float* W, int K, int N, const float* gain, bf16* WT, int nblk, LAS float* scr, int item, int lane, ColMap cm) {
    const int kb = item / nblk, nb = item % nblk, k0 = 64 * kb, n0 = 32 * nb;
    const int src = cm(n0 + (lane & 31));
    float tv[32];
#pragma unroll
    for (int i = 0; i < 32; ++i) { const int kk = 2 * i + (lane >> 5); tv[i] = (src >= 0) ? W[(size_t)(k0 + kk) * N + src] : 0.f; }
#pragma unroll
    for (int i = 0; i < 32; ++i) { const int kk = 2 * i + (lane >> 5); float v = tv[i]; if (gain) v *= gain[k0 + kk]; scr[kk * 33 + (lane & 31)] = v; }
    LDS_WAIT(); asm volatile("" ::: "memory");
    const int c = lane & 7;
#pragma unroll
    for (int j = 0; j < 4; ++j) { const int n = (lane >> 3) + 8 * j; const LAS float* s = scr + (8 * c) * 33 + n;
        v4u o; o.x = pk2(s[0 * 33], s[1 * 33]); o.y = pk2(s[2 * 33], s[3 * 33]); o.z = pk2(s[4 * 33], s[5 * 33]); o.w = pk2(s[6 * 33], s[7 * 33]);
        *(GAS v4u*)(WT + (size_t)(n0 + n) * K + k0 + 8 * c) = o; }
    LDS_WAIT(); asm volatile("" ::: "memory");
}
struct IdMap { __device__ __forceinline__ int operator()(int n) const { return n; } };
struct YMap { __device__ __forceinline__ int operator()(int n) const { return n < 1024 ? n : (n < 2816 ? n + 8 : (n < 2824 ? n - 2816 + 1024 : -1)); } };

__device__ __forceinline__ void p0_prologue(const Frame& F, ArgsP a) {
    unsigned char* ws = a->ws; const int lane = lane_id();
    LAS float* scr = (LAS float*)(F.lds + F.wave * 16384);
    const int gw = F.gw, NGW = F.NGW;
    constexpr int I_IN = 16 * (NY / 32), I_OUT = 16 * 32, I_UP = 16 * (FF / 32), I_DN = 64 * 32, I_G = 16 * 32, I_P = 4 * 32, I_LAYER = I_IN + I_OUT + I_UP + I_DN + I_G + I_P;
    for (int it = gw; it < DEPTH * I_LAYER; it += NGW) {
        const int l = it / I_LAYER; int r = it % I_LAYER;
        if (r < I_IN) { transpose_item(a->w_in + (size_t)l * DM * INW, DM, INW, a->in_norm_g + l * DM, (bf16*)(ws + WS_WIN) + (size_t)l * NY * DM, NY / 32, scr, r, lane, YMap()); continue; } r -= I_IN;
        if (r < I_OUT) { transpose_item(a->w_out + (size_t)l * DM * DM, DM, DM, nullptr, (bf16*)(ws + WS_WOUT) + (size_t)l * DM * DM, DM / 32, scr, r, lane, IdMap()); continue; } r -= I_OUT;
        if (r < I_UP) { transpose_item(a->w_up + (size_t)l * DM * FF, DM, FF, a->mlp_norm_g + l * DM, (bf16*)(ws + WS_WUP) + (size_t)l * FF * DM, FF / 32, scr, r, lane, IdMap()); continue; } r -= I_UP;
        if (r < I_DN) { transpose_item(a->w_down + (size_t)l * FF * DM, FF, DM, nullptr, (bf16*)(ws + WS_WDN) + (size_t)l * DM * FF, DM / 32, scr, r, lane, IdMap()); continue; } r -= I_DN;
        if (r < I_G) { transpose_item(a->w_ple_gate + (size_t)l * DM * DM, DM, DM, a->ple_norm_g + l * DM, (bf16*)(ws + WS_WG) + (size_t)l * DM * DM, DM / 32, scr, r, lane, IdMap()); continue; } r -= I_G;
        transpose_item(a->w_ple_proj + (size_t)l * PLE * DM, PLE, DM, nullptr, (bf16*)(ws + WS_WP) + (size_t)l * DM * PLE, DM / 32, scr, r, lane, IdMap());
    }
    { bf16* XB = (bf16*)(ws + WS_XB0); ss_t* ss = (ss_t*)(ws + WS_STATS) + (size_t)SS_IN * M;
      for (int m0 = gw; m0 < M; m0 += 2 * NGW) { f32x4 v[2][4];
#pragma unroll
          for (int u = 0; u < 2; ++u) { const int mr = m0 + u * NGW; if (mr < M) { const GAS f32x4* xr = (const GAS f32x4*)(a->x + (size_t)mr * DM) + lane;
#pragma unroll
              for (int j = 0; j < 4; ++j) v[u][j] = xr[64 * j]; } }
#pragma unroll
          for (int u = 0; u < 2; ++u) { const int mr = m0 + u * NGW; if (mr < M) { GAS u32x2* o8 = (GAS u32x2*)(XB + (size_t)mr * DM) + lane; float s = 0.f;
#pragma unroll
              for (int j = 0; j < 4; ++j) { u32x2 w; w.x = pk2(v[u][j].x, v[u][j].y); w.y = pk2(v[u][j].z, v[u][j].w); o8[64 * j] = w;
                  const float a0 = bflo(w.x), a1 = bfhi(w.x), a2 = bflo(w.y), a3 = bfhi(w.y); s += (a0 * a0 + a1 * a1) + (a2 * a2 + a3 * a3); }
              s = wave_sum(s); if (lane == 0) ss[mr] = (ss_t)(long long)(s * 16777216.0f); } } } }
    { const size_t n8 = (size_t)DEPTH * M * PLE / 8; bf16* PB = (bf16*)a->out;
      for (size_t i0 = (size_t)gw * 64 + lane; i0 < n8; i0 += (size_t)NGW * 64 * 4) { f32x4 v0[4], v1[4];
#pragma unroll
          for (int u = 0; u < 4; ++u) { const size_t i = i0 + (size_t)u * NGW * 64; if (i < n8) { v0[u] = *(const GAS f32x4*)(a->p + i * 8); v1[u] = *(const GAS f32x4*)(a->p + i * 8 + 4); } }
#pragma unroll
          for (int u = 0; u < 4; ++u) { const size_t i = i0 + (size_t)u * NGW * 64; if (i < n8) { v4u w; w.x = pk2(v0[u].x, v0[u].y); w.y = pk2(v0[u].z, v0[u].w); w.z = pk2(v1[u].x, v1[u].y); w.w = pk2(v1[u].z, v1[u].w);
              const size_t l_ = i / ((size_t)M * 32), rem_ = i % ((size_t)M * 32), m_ = rem_ >> 5, k8_ = rem_ & 31; *(GAS v4u*)(PB + m_ * 2048 + l_ * 256 + k8_ * 8) = w; } } } }
    { float* rope = (float*)(ws + WS_ROPE);
      for (int i = gw * 64 + lane; i < M * 8; i += NGW * 64) { const int m = i >> 3, f = i & 7; double rev = (double)a->pos[m] * a->rope_rev[f]; rev -= __builtin_floor(rev); const float fr = (float)rev;
          rope[2 * i] = __builtin_amdgcn_cosf(fr); rope[2 * i + 1] = __builtin_amdgcn_sinf(fr); } }
    { float* by = (float*)(ws + WS_BIASY); YMap ym;
      for (int i = gw * 64 + lane; i < DEPTH * NY; i += NGW * 64) { const int l = i / NY, c = i % NY, s = ym(c); by[i] = s >= 0 ? a->b_in[l * INW + s] : 0.f; } }
}

__device__ __forceinline__ bf16x8 ld_frag(const LAS bf16* tile, int ld, int r0, int k0, int lane) { return *(const LAS bf16x8*)(tile + (r0 + (lane & 15)) * ld + k0 + 8 * (lane >> 4)); }
template <int K>
__device__ __forceinline__ f32x4 mma_tile(f32x4 acc, const LAS bf16* A, int lda, int r0, const LAS bf16* Bt, int ldb, int c0, int lane) {
#pragma unroll
    for (int k0 = 0; k0 < K; k0 += 32) acc = __builtin_amdgcn_mfma_f32_16x16x32_bf16(ld_frag(A, lda, r0, k0, lane), ld_frag(Bt, ldb, c0, k0, lane), acc, 0, 0, 0);
    return acc;
}
typedef short v4i16_t __attribute__((ext_vector_type(4)));
__device__ __forceinline__ bf16x8 ld_frag_tr(const LAS bf16* tile, int ld, int k0, int c0, int lane) {
    const int g = lane >> 4, q = (lane >> 2) & 3, p = lane & 3;
    const LAS bf16* p0 = tile + (k0 + 8 * g + q) * ld + c0 + 4 * p;
    const v4i16_t lo = __builtin_amdgcn_ds_read_tr16_b64_v4i16((LAS v4i16_t*)p0), hi = __builtin_amdgcn_ds_read_tr16_b64_v4i16((LAS v4i16_t*)(p0 + 4 * ld));
    return (bf16x8){lo[0], lo[1], lo[2], lo[3], hi[0], hi[1], hi[2], hi[3]};
}
template <int K>
__device__ __forceinline__ f32x4 mma_tile_nt(f32x4 acc, const LAS bf16* A, int lda, int r0, const LAS bf16* T, int ldt, int c0, int lane) {
#pragma unroll
    for (int k0 = 0; k0 < K; k0 += 32) acc = __builtin_amdgcn_mfma_f32_16x16x32_bf16(ld_frag(A, lda, r0, k0, lane), ld_frag_tr(T, ldt, k0, c0, lane), acc, 0, 0, 0);
    return acc;
}
template <int K>
__device__ __forceinline__ f32x4 mma_tile_tt(f32x4 acc, const LAS bf16* TA, int lda, int r0, const LAS bf16* TB, int ldb, int c0, int lane) {
#pragma unroll
    for (int k0 = 0; k0 < K; k0 += 32) acc = __builtin_amdgcn_mfma_f32_16x16x32_bf16(ld_frag_tr(TA, lda, k0, r0, lane), ld_frag_tr(TB, ldb, k0, c0, lane), acc, 0, 0, 0);
    return acc;
}
typedef float f32x2_t __attribute__((ext_vector_type(2))); typedef __bf16 bf16x2_t __attribute__((ext_vector_type(2)));
__device__ __forceinline__ unsigned cvtpk(float lo, float hi) { const f32x2_t v = {lo, hi}; return __builtin_bit_cast(unsigned, __builtin_convertvector(v, bf16x2_t)); }
__device__ __forceinline__ bf16 hbf(float x) { return (bf16)cvtpk(x, x); }
template <int CTRL> __device__ __forceinline__ float dpp_f(float v) { return __builtin_bit_cast(float, __builtin_amdgcn_mov_dpp(__builtin_bit_cast(int, v), CTRL, 0xF, 0xF, true)); }
template <int CTRL, int ROWMASK> __device__ __forceinline__ float dpp_id(float v, float ident) { return __builtin_bit_cast(float, __builtin_amdgcn_update_dpp(__builtin_bit_cast(int, ident), __builtin_bit_cast(int, v), CTRL, ROWMASK, 0xF, false)); }
__device__ __forceinline__ float red8_sum(float v) { v += dpp_f<0xB1>(v); v += dpp_f<0x4E>(v); v += dpp_f<0x141>(v); return v; }
__device__ __forceinline__ float red16_sum(float v) { v = red8_sum(v); v += dpp_f<0x140>(v); return v; }
__device__ __forceinline__ float red16_max(float v) { v = fmaxf(v, dpp_f<0xB1>(v)); v = fmaxf(v, dpp_f<0x4E>(v)); v = fmaxf(v, dpp_f<0x141>(v)); v = fmaxf(v, dpp_f<0x140>(v)); return v; }
__device__ __forceinline__ float xor16_partner(float x, int lane) { auto r = __builtin_amdgcn_permlane16_swap(__float_as_uint(x), __float_as_uint(x), false, false); return __uint_as_float((lane & 16) ? r[0] : r[1]); }
__device__ __forceinline__ float red_x16x32_sum(float x) { auto r = __builtin_amdgcn_permlane16_swap(__float_as_uint(x), __float_as_uint(x), false, false); x = __uint_as_float(r[0]) + __uint_as_float(r[1]);
    auto q = __builtin_amdgcn_permlane32_swap(__float_as_uint(x), __float_as_uint(x), false, false); return __uint_as_float(q[0]) + __uint_as_float(q[1]); }
__device__ __forceinline__ float scan_add(float v, int) { v += dpp_id<0x111, 0xF>(v, 0.f); v += dpp_id<0x112, 0xF>(v, 0.f); v += dpp_id<0x114, 0xF>(v, 0.f); v += dpp_id<0x118, 0xF>(v, 0.f); v += dpp_id<0x142, 0xA>(v, 0.f); v += dpp_id<0x143, 0xC>(v, 0.f); return v; }
__device__ __forceinline__ float scan_max(float v, int) { const float ni = -INFINITY; v = fmaxf(v, dpp_id<0x111, 0xF>(v, ni)); v = fmaxf(v, dpp_id<0x112, 0xF>(v, ni)); v = fmaxf(v, dpp_id<0x114, 0xF>(v, ni)); v = fmaxf(v, dpp_id<0x118, 0xF>(v, ni));
    v = fmaxf(v, dpp_id<0x142, 0xA>(v, ni)); v = fmaxf(v, dpp_id<0x143, 0xC>(v, ni)); return v; }
#define LBAR() asm volatile("s_waitcnt lgkmcnt(0)\n\ts_barrier" ::: "memory")
__device__ __forceinline__ float fexp(float x) { return __builtin_amdgcn_exp2f(x * 1.4426950408889634f); }
__device__ __forceinline__ float frcp(float x) { return __builtin_amdgcn_rcpf(x); }
__device__ __forceinline__ float fsig(float x) { return frcp(1.f + fexp(-x)); }

__device__ __forceinline__ void mlstm_task(const Frame& F, ArgsP a, int layer, int bh) {
    const int tid_ = F.wave * 64 + lane_id(); const int b = bh >> 2, h = bh & 3, tid = tid_, lane = tid & 63, w = F.wave;
    const bf16* Y = (const bf16*)(a->ws + WS_BIG) + (size_t)b * (Y_BLK / 2); bf16* MIX = (bf16*)(a->ws + WS_MIX) + (size_t)b * (MIX_BLK / 2);
    constexpr int LD = 72, TILE = 64 * LD, CTSZ = 80 * LD;
    LAS bf16* tiles = (LAS bf16*)(F.lds);
    LAS bf16* ctsb = tiles + 8 * TILE;
    LAS float* arr = (LAS float*)(ctsb + 2 * CTSZ);
    LAS float* cw = arr + 3 * 400;
#define MT(p_, k_) (tiles + ((p_) * 4 + (k_)) * TILE)
    const int j = tid >> 3, d8 = (tid & 7) * 8;
    for (int i = tid; i < 2 * CTSZ; i += 512) ctsb[i] = 0;
    if (tid < 64) { cw[512 + tid] = a->conv_b[layer * 512 + h * 64 + tid]; cw[576 + tid] = a->conv_b[layer * 512 + 256 + h * 64 + tid]; }
    if (tid < 256) { const int tap = tid >> 6, d = tid & 63; cw[tap * 64 + d] = a->conv_w[(layer * 4 + tap) * 512 + h * 64 + d]; cw[256 + tap * 64 + d] = a->conv_w[(layer * 4 + tap) * 512 + 256 + h * 64 + d]; }
    const float fbias = a->mlstm_f_bias[layer * 4 + h];
    const int cl = lane & 15, g = lane >> 4;
    float gnr[16];
#pragma unroll
    for (int et = 0; et < 4; ++et)
#pragma unroll
        for (int i = 0; i < 4; ++i) gnr[et * 4 + i] = a->mlstm_norm_g[layer * 256 + h * 64 + 16 * et + 4 * g + i];
    f32x4 Ct[5];
#pragma unroll
    for (int et = 0; et < 5; ++et) Ct[et] = (f32x4){0.f, 0.f, 0.f, 0.f};
    float mcar = 0.f;
    u32x4 rq[4], rk[4], rv; u32x2 rog[4]; unsigned short rgi = 0, rgf = 0;
    const u32x4 zero4 = {0u, 0u, 0u, 0u};
#define MLSTM_LOAD(c_) do { const int t_ = (c_) * 64 + j; const bf16* yr_ = Y + ((size_t)b * SEQ + t_) * NY; \
        _Pragma("unroll") for (int tap = 0; tap < 4; ++tap) { if (t_ - 3 + tap >= 0) { rq[tap] = *(const u32x4*)(yr_ + (tap - 3) * NY + YC_MQ + h * 64 + d8); rk[tap] = *(const u32x4*)(yr_ + (tap - 3) * NY + YC_MK + h * 64 + d8); } else { rq[tap] = zero4; rk[tap] = zero4; } } \
        rv = *(const u32x4*)(yr_ + YC_MV + h * 64 + d8); } while (0)
#define MLSTM_LOAD_OG(c_) do { const bf16* yo_ = Y + ((size_t)b * SEQ + (c_) * 64 + 16 * w + cl) * NY + YC_MO + h * 64 + 4 * g; \
        _Pragma("unroll") for (int et = 0; et < 4; ++et) rog[et] = *(const u32x2*)(yo_ + 16 * et); } while (0)
#define MLSTM_LOAD_G(c_) do { const bf16* yl_ = Y + ((size_t)b * SEQ + (c_) * 64 + lane) * NY; rgi = yl_[YC_MI + h]; rgf = yl_[YC_MF + h]; } while (0)
#define MLSTM_SCAN(c_) do { LAS float* A_ = arr + ((c_) % 3) * 400; const float ip_ = bf2f(rgi), lf_ = logsigmoid_f(bf2f(rgf) + fbias); const float bc_ = scan_add(lf_, lane), g_ = ip_ - bc_, cm_ = scan_max(g_, lane), av_ = fmaxf(mcar, cm_); \
        const float a63_ = __builtin_bit_cast(float, __builtin_amdgcn_readlane(__builtin_bit_cast(int, av_), 63)), b63_ = __builtin_bit_cast(float, __builtin_amdgcn_readlane(__builtin_bit_cast(int, bc_), 63)); \
        A_[lane] = av_; A_[64 + lane] = g_; A_[128 + lane] = fexp(mcar - av_); A_[192 + lane] = fexp(-(bc_ + av_)); A_[256 + lane] = fexp(g_ - a63_); if (lane == 0) A_[320] = fexp(mcar - a63_); mcar = b63_ + a63_; } while (0)
#define MLSTM_BUILD(c_, p_) do { const LAS float* A_ = arr + ((c_) % 3) * 400; float qa[8], ka[8]; \
        _Pragma("unroll") for (int i = 0; i < 8; ++i) { qa[i] = cw[512 + d8 + i]; ka[i] = cw[576 + d8 + i]; } \
        _Pragma("unroll") for (int tap = 0; tap < 4; ++tap) { f32x4 q0, q1, k0, k1; pg8::unpack8(rq[tap], q0, q1); pg8::unpack8(rk[tap], k0, k1); \
            _Pragma("unroll") for (int i = 0; i < 4; ++i) { qa[i] += cw[tap * 64 + d8 + i] * q0[i]; qa[4 + i] += cw[tap * 64 + d8 + 4 + i] * q1[i]; ka[i] += cw[256 + tap * 64 + d8 + i] * k0[i]; ka[4 + i] += cw[256 + tap * 64 + d8 + 4 + i] * k1[i]; } } \
        f32x4 q0, q1, k0, k1, kw0, kw1; const float wsj = A_[256 + j]; \
        _Pragma("unroll") for (int i = 0; i < 4; ++i) { q0[i] = qa[i] * fsig(qa[i]); q1[i] = qa[4 + i] * fsig(qa[4 + i]); k0[i] = ka[i] * fsig(ka[i]) * 0.125f; k1[i] = ka[4 + i] * fsig(ka[4 + i]) * 0.125f; kw0[i] = k0[i] * wsj; kw1[i] = k1[i] * wsj; } \
        *(LAS u32x4*)(MT(p_, 0) + j * LD + d8) = pg8::pack8(q0, q1); *(LAS u32x4*)(MT(p_, 1) + j * LD + d8) = pg8::pack8(k0, k1); *(LAS u32x4*)(MT(p_, 2) + j * LD + d8) = pg8::pack8(kw0, kw1); *(LAS u32x4*)(MT(p_, 3) + j * LD + d8) = rv; } while (0)
    MLSTM_LOAD(0);
    if (w == 4) { MLSTM_LOAD_G(0); MLSTM_SCAN(0); MLSTM_LOAD_G(1); MLSTM_SCAN(1); MLSTM_LOAD_G(2); }
    if (w < 4) MLSTM_LOAD_OG(0);
    LBAR();
    MLSTM_BUILD(0, 0);
    MLSTM_LOAD(1);
    LBAR();
    for (int c = 0; c < SEQ / 64; ++c) {
        const int p = c & 1;
        if (c + 1 < SEQ / 64) { MLSTM_BUILD(c + 1, p ^ 1); if (c + 2 < SEQ / 64) MLSTM_LOAD(c + 2); }
        const LAS float* A3 = arr + (c % 3) * 400;
        if (w < 4) {
            const int jt = w, jq = 16 * jt + cl; const LAS bf16* Qp = MT(p, 0); const LAS bf16* Kp = MT(p, 1); const LAS bf16* Vp = MT(p, 3); const LAS bf16* Cp = ctsb + p * CTSZ;
            const float aj = A3[jq], wj = A3[128 + jq], ej = A3[192 + jq];
            const bf16x8 qb0 = ld_frag(Qp, LD, 16 * jt, 0, lane), qb1 = ld_frag(Qp, LD, 16 * jt, 32, lane);
            f32x4 pt[4]; float dsum = 0.f;
#pragma unroll
            for (int st = 0; st < 4; ++st) { pt[st] = (f32x4){0.f, 0.f, 0.f, 0.f};
                if (st <= jt) { f32x4 s_ = (f32x4){0.f, 0.f, 0.f, 0.f};
                    s_ = __builtin_amdgcn_mfma_f32_16x16x32_bf16(ld_frag(Kp, LD, 16 * st, 0, lane), qb0, s_, 0, 0, 0); s_ = __builtin_amdgcn_mfma_f32_16x16x32_bf16(ld_frag(Kp, LD, 16 * st, 32, lane), qb1, s_, 0, 0, 0);
                    const f32x4 gs = *(const LAS f32x4*)(A3 + 64 + 16 * st + 4 * g);
#pragma unroll
                    for (int i = 0; i < 4; ++i) { const bool ok = (st < jt) || (4 * g + i <= cl); const float pv = ok ? s_[i] * fexp(gs[i] - aj) : 0.f; pt[st][i] = pv; dsum += pv; } } }
            bf16x8 pf[2];
#pragma unroll
            for (int t = 0; t < 2; ++t) { u32x4 pw; pw.x = cvtpk(pt[2 * t][0], pt[2 * t][1]); pw.y = cvtpk(pt[2 * t][2], pt[2 * t][3]); pw.z = cvtpk(pt[2 * t + 1][0], pt[2 * t + 1][1]); pw.w = cvtpk(pt[2 * t + 1][2], pt[2 * t + 1][3]); pf[t] = __builtin_bit_cast(bf16x8, pw); }
            f32x4 acc[5];
#pragma unroll
            for (int et = 0; et < 5; ++et) { acc[et] = (f32x4){0.f, 0.f, 0.f, 0.f}; acc[et] = __builtin_amdgcn_mfma_f32_16x16x32_bf16(ld_frag(Cp, LD, 16 * et, 0, lane), qb0, acc[et], 0, 0, 0); acc[et] = __builtin_amdgcn_mfma_f32_16x16x32_bf16(ld_frag(Cp, LD, 16 * et, 32, lane), qb1, acc[et], 0, 0, 0); }
            const float qn = red_x16x32_sum(acc[4][0]);
#pragma unroll
            for (int et = 0; et < 4; ++et) acc[et] = acc[et] * wj;
            { const int tq = (lane >> 2) & 3, tp = lane & 3;
#pragma unroll
              for (int t = 0; t < 2; ++t) { if (2 * t <= jt) { const LAS bf16* vb = Vp + (32 * t + 4 * g + tq) * LD + 4 * tp;
#pragma unroll
                  for (int et = 0; et < 4; ++et) { const v4i16_t lo = __builtin_amdgcn_ds_read_tr16_b64_v4i16((LAS v4i16_t*)(vb + 16 * et)), hi = __builtin_amdgcn_ds_read_tr16_b64_v4i16((LAS v4i16_t*)(vb + 16 * LD + 16 * et));
                      const bf16x8 vf = {lo[0], lo[1], lo[2], lo[3], hi[0], hi[1], hi[2], hi[3]}; acc[et] = __builtin_amdgcn_mfma_f32_16x16x32_bf16(vf, pf[t], acc[et], 0, 0, 0); } } } }
            const float den = red_x16x32_sum(dsum) + wj * qn; const float rinv = frcp(fmaxf(fabsf(den), ej));
            float ss = 0.f;
#pragma unroll
            for (int et = 0; et < 4; ++et) { acc[et] = acc[et] * rinv; ss += (acc[et][0] * acc[et][0] + acc[et][1] * acc[et][1]) + (acc[et][2] * acc[et][2] + acc[et][3] * acc[et][3]); }
            ss = red_x16x32_sum(ss); const float rs = rsqrtf(ss * (1.0f / 64.0f) + EPS);
            bf16* orow = MIX + ((size_t)b * SEQ + c * 64 + jq) * DM + h * 64 + 4 * g;
#pragma unroll
            for (int et = 0; et < 4; ++et) { const float o0 = bflo(rog[et].x), o1 = bfhi(rog[et].x), o2 = bflo(rog[et].y), o3 = bfhi(rog[et].y); u32x2 ov;
                ov.x = cvtpk(acc[et][0] * rs * gnr[4 * et] * fsig(o0), acc[et][1] * rs * gnr[4 * et + 1] * fsig(o1)); ov.y = cvtpk(acc[et][2] * rs * gnr[4 * et + 2] * fsig(o2), acc[et][3] * rs * gnr[4 * et + 3] * fsig(o3));
                *(u32x2*)(orow + 16 * et) = ov; }
            if (c + 1 < SEQ / 64) MLSTM_LOAD_OG(c + 1);
        } else {
            const int dt = w - 4; const LAS bf16* Vp = MT(p, 3); const LAS bf16* Kwp = MT(p, 2); const float decay = A3[320];
            const unsigned one8 = (cl == 0) ? 0x3f803f80u : 0u; const u32x4 onew = {one8, one8, one8, one8}; const bf16x8 onesf = __builtin_bit_cast(bf16x8, onew);
            const bf16x8 kb0 = ld_frag_tr(Kwp, LD, 0, 16 * dt, lane), kb1 = ld_frag_tr(Kwp, LD, 32, 16 * dt, lane);
#pragma unroll
            for (int et = 0; et < 5; ++et) { Ct[et] = Ct[et] * decay;
                const bf16x8 va0 = (et < 4) ? ld_frag_tr(Vp, LD, 0, 16 * et, lane) : onesf, va1 = (et < 4) ? ld_frag_tr(Vp, LD, 32, 16 * et, lane) : onesf;
                Ct[et] = __builtin_amdgcn_mfma_f32_16x16x32_bf16(va0, kb0, Ct[et], 0, 0, 0); Ct[et] = __builtin_amdgcn_mfma_f32_16x16x32_bf16(va1, kb1, Ct[et], 0, 0, 0); }
            { LAS bf16* Cn = ctsb + (p ^ 1) * CTSZ;
#pragma unroll
              for (int et = 0; et < 4; ++et)
#pragma unroll
                  for (int i = 0; i < 4; ++i) Cn[(16 * et + 4 * g + i) * LD + 16 * dt + cl] = hbf(Ct[et][i]);
              if (g == 0) Cn[64 * LD + 16 * dt + cl] = hbf(Ct[4][0]); }
            if (w == 4 && c + 2 < SEQ / 64) { MLSTM_SCAN(c + 2); if (c + 3 < SEQ / 64) MLSTM_LOAD_G(c + 3); }
        }
        LBAR();
    }
#undef MT
#undef MLSTM_LOAD
#undef MLSTM_LOAD_OG
#undef MLSTM_LOAD_G
#undef MLSTM_SCAN
#undef MLSTM_BUILD
}

__device__ __forceinline__ void hgrn_task(const Frame& F, ArgsP a, int layer, int bh) {
    const int tid_ = F.wave * 64 + lane_id(); const int b = bh >> 2, h = bh & 3, tid = tid_, lane = tid & 63, w = F.wave;
    const bf16* Y = (const bf16*)(a->ws + WS_BIG) + (size_t)b * (Y_BLK / 2); bf16* MIX = (bf16*)(a->ws + WS_MIX) + (size_t)b * (MIX_BLK / 2);
    constexpr int LD = 72, TILE = 64 * LD;
    LAS bf16* tiles = (LAS bf16*)(F.lds);
    LAS bf16* stb = tiles + 12 * TILE;
    LAS float* part = (LAS float*)(stb + 2 * TILE);
    LAS float* egb = part + 2 * 1024;
#define HT(p_, k_) (tiles + ((p_) * 6 + (k_)) * TILE)
    const int dp = tid & 31, d0 = 2 * dp, rgrp = tid >> 5, cl = lane & 15, g = lane >> 4;
    float lbv[2], omlv[2];
#pragma unroll
    for (int ch = 0; ch < 2; ++ch) { const int cidx = h * 64 + d0 + ch; float z[4]; float zm = -INFINITY;
#pragma unroll
      for (int q = 0; q < 4; ++q) { z[q] = a->hgrn_lb_logits[q * 256 + cidx]; zm = fmaxf(zm, z[q]); }
      float e[4], es = 0.f;
#pragma unroll
      for (int q = 0; q < 4; ++q) { e[q] = expf(z[q] - zm); es += e[q]; }
      float cum = 0.f, lb = 0.f;
#pragma unroll
      for (int q = 0; q < 4; ++q) { cum += e[q] / es; if (q == layer) lb = cum; }
      lb -= e[0] / es; if (layer == 0) lb = 0.f;
      lbv[ch] = lb; omlv[ch] = 1.f - lb; }
    for (int i = tid; i < 2 * TILE; i += 512) stb[i] = 0;
    float gnr[16];
#pragma unroll
    for (int et = 0; et < 4; ++et)
#pragma unroll
        for (int i = 0; i < 4; ++i) gnr[et * 4 + i] = a->hgrn_norm_g[layer * 256 + h * 64 + 16 * et + 4 * g + i];
    f32x4 Sr[4];
#pragma unroll
    for (int et = 0; et < 4; ++et) Sr[et] = (f32x4){0.f, 0.f, 0.f, 0.f};
    unsigned rq[4], rf[4], rv[4]; u32x2 rgt[4];
    float qf[4][2], ky[4][2], cs[4][2]; unsigned vraw[4];
#define HGRN_LOAD(c_) do { const bf16* yb_ = Y + ((size_t)b * SEQ + (c_) * 64 + 4 * rgrp) * NY + h * 64 + d0; \
        _Pragma("unroll") for (int r = 0; r < 4; ++r) { rq[r] = *(const unsigned*)(yb_ + r * NY + YC_HQ); rf[r] = *(const unsigned*)(yb_ + r * NY + YC_HF); rv[r] = *(const unsigned*)(yb_ + r * NY + YC_HI); } } while (0)
#define HGRN_LOAD_GATE(c_) do { const bf16* yo_ = Y + ((size_t)b * SEQ + (c_) * 64 + 16 * w + cl) * NY + YC_HG + h * 64 + 4 * g; \
        _Pragma("unroll") for (int et = 0; et < 4; ++et) rgt[et] = *(const u32x2*)(yo_ + 16 * et); } while (0)
#define HGRN_A1(c_) do { float run0 = 0.f, run1 = 0.f; \
        _Pragma("unroll") for (int r = 0; r < 4; ++r) { vraw[r] = rv[r]; \
            { const float qv = bflo(rq[r]), fv = fmaxf(bflo(rf[r]), -80.f); qf[r][0] = qv * fsig(qv); const float t = fexp(-fv), sf = frcp(1.f + t); ky[r][0] = omlv[0] * t * sf; run0 += __builtin_amdgcn_logf(lbv[0] + omlv[0] * sf); cs[r][0] = run0; } \
            { const float qv = bfhi(rq[r]), fv = fmaxf(bfhi(rf[r]), -80.f); qf[r][1] = qv * fsig(qv); const float t = fexp(-fv), sf = frcp(1.f + t); ky[r][1] = omlv[1] * t * sf; run1 += __builtin_amdgcn_logf(lbv[1] + omlv[1] * sf); cs[r][1] = run1; } } \
        *(LAS f32x2_t*)(part + ((c_) & 1) * 1024 + rgrp * 64 + d0) = (f32x2_t){run0, run1}; } while (0)
#define HGRN_TILES(c_, p_) do { const LAS float* P_ = part + ((c_) & 1) * 1024 + d0; f32x2_t pco[8]; f32x2_t acc_ = {0.f, 0.f}, pre = {0.f, 0.f}; \
        _Pragma("unroll") for (int q = 0; q < 16; ++q) { if (q == rgrp) pre = acc_; acc_ += *(const LAS f32x2_t*)(P_ + q * 64); if (q & 1) pco[q >> 1] = acc_; }        \
        const f32x2_t g31 = pco[3], g63 = pco[7], gmid = (rgrp < 8) ? pco[1] : pco[5]; \
        _Pragma("unroll") for (int r = 0; r < 4; ++r) { const int l = 4 * rgrp + r; float vqt[2], vxa[2], vqc[2], vkc[2], vkr[2]; \
            _Pragma("unroll") for (int ch = 0; ch < 2; ++ch) { const float G = pre[ch] + cs[r][ch]; \
                vqt[ch] = qf[r][ch] * __builtin_amdgcn_exp2f(G); vkr[ch] = ky[r][ch] * __builtin_amdgcn_exp2f(g63[ch] - G); \
                vxa[ch] = (rgrp < 8) ? ky[r][ch] * __builtin_amdgcn_exp2f(g31[ch] - G) : qf[r][ch] * __builtin_amdgcn_exp2f(G - g31[ch]); \
                const float dm = fminf(fmaxf(G - gmid[ch], -86.f), 86.f); vqc[ch] = qf[r][ch] * __builtin_amdgcn_exp2f(dm); vkc[ch] = ky[r][ch] * __builtin_amdgcn_exp2f(-dm); } \
            *(LAS unsigned*)(HT(p_, 0) + l * LD + d0) = cvtpk(vqt[0], vqt[1]); *(LAS unsigned*)(HT(p_, 1) + l * LD + d0) = cvtpk(vxa[0], vxa[1]); *(LAS unsigned*)(HT(p_, 2) + l * LD + d0) = cvtpk(vqc[0], vqc[1]); \
            *(LAS unsigned*)(HT(p_, 3) + l * LD + d0) = cvtpk(vkc[0], vkc[1]); *(LAS unsigned*)(HT(p_, 4) + l * LD + d0) = cvtpk(vkr[0], vkr[1]); *(LAS unsigned*)(HT(p_, 5) + l * LD + d0) = vraw[r]; } \
        if (rgrp == 0) *(LAS f32x2_t*)(egb + ((c_) & 1) * 64 + d0) = (f32x2_t){__builtin_amdgcn_exp2f(g63[0]), __builtin_amdgcn_exp2f(g63[1])}; } while (0)
    HGRN_LOAD(0); HGRN_A1(0); HGRN_LOAD(1);
    if (w < 4) HGRN_LOAD_GATE(0);
    LBAR();
    HGRN_TILES(0, 0); HGRN_A1(1); HGRN_LOAD(2);
    LBAR();
    for (int c = 0; c < SEQ / 64; ++c) {
        const int p = c & 1;
        if (c + 1 < SEQ / 64) HGRN_TILES(c + 1, p ^ 1);
        if (c + 2 < SEQ / 64) { HGRN_A1(c + 2); if (c + 3 < SEQ / 64) HGRN_LOAD(c + 3); }
        if (w < 4) {
            const int rt = w; const LAS bf16* QTp = HT(p, 0); const LAS bf16* XAp = HT(p, 1); const LAS bf16* QCp = HT(p, 2); const LAS bf16* KCp = HT(p, 3); const LAS bf16* VRp = HT(p, 5); const LAS bf16* Sp = stb + p * TILE;
            f32x4 at[4];
#pragma unroll
            for (int st = 0; st < 4; ++st) { at[st] = (f32x4){0.f, 0.f, 0.f, 0.f};
                if (st <= rt) { const bool same = ((st >> 1) == (rt >> 1)); const LAS bf16* Aop = same ? KCp : XAp; const LAS bf16* Bop = same ? QCp : XAp;
                    f32x4 s_ = (f32x4){0.f, 0.f, 0.f, 0.f}; s_ = mma_tile<64>(s_, Aop, LD, 16 * st, Bop, LD, 16 * rt, lane);
#pragma unroll
                    for (int i = 0; i < 4; ++i) at[st][i] = ((st < rt) || (4 * g + i <= cl)) ? s_[i] : 0.f; } }
            bf16x8 pf[2];
#pragma unroll
            for (int t = 0; t < 2; ++t) { u32x4 pw; pw.x = cvtpk(at[2 * t][0], at[2 * t][1]); pw.y = cvtpk(at[2 * t][2], at[2 * t][3]); pw.z = cvtpk(at[2 * t + 1][0], at[2 * t + 1][1]); pw.w = cvtpk(at[2 * t + 1][2], at[2 * t + 1][3]); pf[t] = __builtin_bit_cast(bf16x8, pw); }
            f32x4 acc[4];
            { const bf16x8 qb0 = ld_frag(QTp, LD, 16 * rt, 0, lane), qb1 = ld_frag(QTp, LD, 16 * rt, 32, lane);
#pragma unroll
              for (int et = 0; et < 4; ++et) { acc[et] = (f32x4){0.f, 0.f, 0.f, 0.f}; acc[et] = __builtin_amdgcn_mfma_f32_16x16x32_bf16(ld_frag(Sp, LD, 16 * et, 0, lane), qb0, acc[et], 0, 0, 0); acc[et] = __builtin_amdgcn_mfma_f32_16x16x32_bf16(ld_frag(Sp, LD, 16 * et, 32, lane), qb1, acc[et], 0, 0, 0); } }
            { const int tq = (lane >> 2) & 3, tp = lane & 3;
#pragma unroll
              for (int t = 0; t < 2; ++t) { if (2 * t <= rt) { const LAS bf16* vb = VRp + (32 * t + 4 * g + tq) * LD + 4 * tp;
#pragma unroll
                  for (int et = 0; et < 4; ++et) { const v4i16_t lo = __builtin_amdgcn_ds_read_tr16_b64_v4i16((LAS v4i16_t*)(vb + 16 * et)), hi = __builtin_amdgcn_ds_read_tr16_b64_v4i16((LAS v4i16_t*)(vb + 16 * LD + 16 * et));
                      const bf16x8 vf = {lo[0], lo[1], lo[2], lo[3], hi[0], hi[1], hi[2], hi[3]}; acc[et] = __builtin_amdgcn_mfma_f32_16x16x32_bf16(vf, pf[t], acc[et], 0, 0, 0); } } } }
            float ss = 0.f;
#pragma unroll
            for (int et = 0; et < 4; ++et) ss += (acc[et][0] * acc[et][0] + acc[et][1] * acc[et][1]) + (acc[et][2] * acc[et][2] + acc[et][3] * acc[et][3]);
            ss = red_x16x32_sum(ss); const float rs = rsqrtf(ss * (1.0f / 64.0f) + EPS);
            bf16* orow = MIX + ((size_t)b * SEQ + c * 64 + 16 * rt + cl) * DM + 256 + h * 64 + 4 * g;
#pragma unroll
            for (int et = 0; et < 4; ++et) { const float g0 = bflo(rgt[et].x), g1 = bfhi(rgt[et].x), g2 = bflo(rgt[et].y), g3 = bfhi(rgt[et].y); u32x2 ov;
                ov.x = cvtpk(acc[et][0] * rs * gnr[4 * et] * (g0 * fsig(g0)), acc[et][1] * rs * gnr[4 * et + 1] * (g1 * fsig(g1))); ov.y = cvtpk(acc[et][2] * rs * gnr[4 * et + 2] * (g2 * fsig(g2)), acc[et][3] * rs * gnr[4 * et + 3] * (g3 * fsig(g3)));
                *(u32x2*)(orow + 16 * et) = ov; }
            if (c + 1 < SEQ / 64) HGRN_LOAD_GATE(c + 1);
        } else {
            const int dt = w - 4; const LAS bf16* KRp = HT(p, 4); const LAS bf16* VRp = HT(p, 5); const float egd = egb[p * 64 + 16 * dt + cl];
            const bf16x8 kb0 = ld_frag_tr(KRp, LD, 0, 16 * dt, lane), kb1 = ld_frag_tr(KRp, LD, 32, 16 * dt, lane);
            LAS bf16* Sn = stb + (p ^ 1) * TILE;
#pragma unroll
            for (int et = 0; et < 4; ++et) { Sr[et] = Sr[et] * egd; Sr[et] = __builtin_amdgcn_mfma_f32_16x16x32_bf16(ld_frag_tr(VRp, LD, 0, 16 * et, lane), kb0, Sr[et], 0, 0, 0); Sr[et] = __builtin_amdgcn_mfma_f32_16x16x32_bf16(ld_frag_tr(VRp, LD, 32, 16 * et, lane), kb1, Sr[et], 0, 0, 0);
#pragma unroll
                for (int i = 0; i < 4; ++i) Sn[(16 * et + 4 * g + i) * LD + 16 * dt + cl] = hbf(Sr[et][i]); }
        }
        LBAR();
    }
#undef HT
#undef HGRN_LOAD
#undef HGRN_LOAD_GATE
#undef HGRN_A1
#undef HGRN_TILES
}

typedef float f32x16 __attribute__((ext_vector_type(16)));
__device__ __forceinline__ float swap32_sum(float x) { auto q = __builtin_amdgcn_permlane32_swap(__float_as_uint(x), __float_as_uint(x), false, false); return __uint_as_float(q[0]) + __uint_as_float(q[1]); }
__device__ __forceinline__ float swap32_max(float x) { auto q = __builtin_amdgcn_permlane32_swap(__float_as_uint(x), __float_as_uint(x), false, false); return fmaxf(__uint_as_float(q[0]), __uint_as_float(q[1])); }
__device__ __forceinline__ float swap32_partner(float x, int lane) { auto q = __builtin_amdgcn_permlane32_swap(__float_as_uint(x), __float_as_uint(x), false, false); return __uint_as_float((lane & 32) ? q[0] : q[1]); }
__device__ __forceinline__ void swa_loop(const Frame& F, ArgsP a, int layer, gu32* qctr, int ubase, unsigned limit) {
    const int tid_ = F.wave * 64 + lane_id(); const int tid = tid_, lane = tid & 63, w = F.wave;
    const bf16* Y0 = (const bf16*)(a->ws + WS_BIG); bf16* MIX0 = (bf16*)(a->ws + WS_MIX); const float* rope = (const float*)(a->ws + WS_ROPE);
    constexpr int LDK = 72;
    LAS bf16* Ks = (LAS bf16*)(F.lds); LAS bf16* Vs = Ks + 256 * LDK; LAS bf16* St = Vs + 256 * LDK + w * 32 * LDK;
    volatile LAS unsigned* qslot = (volatile LAS unsigned*)(F.lds + MISC_OFF) + 12;
    const int qq = lane & 31, hh = lane >> 5, kk = tid >> 1, half = tid & 1;
    unsigned nxt_ = 0u;
    if (tid == 0) { *qslot = __hip_atomic_fetch_add(qctr, 1u, __ATOMIC_RELAXED, __HIP_MEMORY_SCOPE_AGENT); }
    __syncthreads(); unsigned cur_u = *qslot; __syncthreads();
    if (cur_u >= limit) return;
    if (tid == 0) nxt_ = __hip_atomic_fetch_add(qctr, 1u, __ATOMIC_RELAXED, __HIP_MEMORY_SCOPE_AGENT);
    u32x4 kraw[4], vraw[4];
#define SWA_PREFETCH(u_) do { const int un_ = ubase + (int)(u_); const int qb_ = un_ & 15, kvh_ = (un_ >> 4) & 1, b_ = un_ >> 5; const int tk_ = (qb_ - 1) * 128 + kk; \
        if (tk_ >= 0) { const bf16* yr_ = Y0 + (size_t)b_ * (Y_BLK / 2) + ((size_t)b_ * SEQ + tk_) * NY; \
            _Pragma("unroll") for (int q = 0; q < 4; ++q) { kraw[q] = *(const u32x4*)(yr_ + YC_SK + kvh_ * 64 + 32 * half + 8 * q); vraw[q] = *(const u32x4*)(yr_ + YC_SV + kvh_ * 64 + 32 * half + 8 * q); } } } while (0)
    SWA_PREFETCH(cur_u);
    for (;;) {
    const int unit = ubase + (int)cur_u; const int qb = unit & 15, kvh = (unit >> 4) & 1, b = unit >> 5;
    const bf16* Y = Y0 + (size_t)b * (Y_BLK / 2); bf16* MIX = MIX0 + (size_t)b * (MIX_BLK / 2);
    const int qh = kvh * 4 + (w >> 1);
    u32x4 qraw[4]; f32x4 qrope[4];
#define SWA_LOADQ(g_) do { const size_t row_ = (size_t)b * SEQ + qb * 128 + (w & 1) * 64 + (g_) * 32 + qq; const bf16* yr_ = Y + row_ * NY + YC_SQ + qh * 64 + 8 * hh; \
        _Pragma("unroll") for (int t = 0; t < 4; ++t) { qraw[t] = *(const u32x4*)(yr_ + 16 * t); qrope[t] = *(const f32x4*)(rope + row_ * 16 + 4 * t); } } while (0)
    SWA_LOADQ(0);
    { const int tk = (qb - 1) * 128 + kk;
      if (tk >= 0) { const size_t row = (size_t)b * SEQ + tk; float x[32];
#pragma unroll
          for (int q = 0; q < 4; ++q) { f32x4 v0, v1; pg8::unpack8(kraw[q], v0, v1);
#pragma unroll
              for (int i = 0; i < 4; ++i) { x[8 * q + i] = v0[i]; x[8 * q + 4 + i] = v1[i]; } }
#pragma unroll
          for (int q = 0; q < 4; ++q) *(LAS u32x4*)(Vs + kk * LDK + 32 * half + 8 * q) = vraw[q];
          float s = 0.f;
#pragma unroll
          for (int i = 0; i < 32; ++i) s += x[i] * x[i];
          s += dpp_f<0xB1>(s); const float rs = rsqrtf(s * (1.0f / 64.0f) + EPS);
#pragma unroll
          for (int q = 0; q < 8; ++q) { const f32x4 gk = *(const f32x4*)(a->swa_k_g + layer * 64 + 32 * half + 4 * q);
#pragma unroll
              for (int i = 0; i < 4; ++i) x[4 * q + i] = x[4 * q + i] * rs * gk[i]; }
          if (half == 0) {
#pragma unroll
              for (int q = 0; q < 4; ++q) { const f32x4 cs = *(const f32x4*)(rope + row * 16 + 4 * q);
#pragma unroll
                  for (int e = 0; e < 2; ++e) { const int i = 2 * q + e; const float c_ = cs[2 * e], s_ = cs[2 * e + 1]; const float x1 = x[i], x2 = x[8 + i]; x[i] = x1 * c_ - x2 * s_; x[8 + i] = x2 * c_ + x1 * s_; } } }
#pragma unroll
          for (int q = 0; q < 4; ++q) { const f32x4 v0 = {x[8 * q], x[8 * q + 1], x[8 * q + 2], x[8 * q + 3]}, v1 = {x[8 * q + 4], x[8 * q + 5], x[8 * q + 6], x[8 * q + 7]}; *(LAS u32x4*)(Ks + kk * LDK + 32 * half + 8 * q) = pg8::pack8(v0, v1); } }
      else { unsigned z0 = 0u; asm volatile("" : "+v"(z0)); const u32x4 z = {z0, z0, z0, z0};
#pragma unroll
          for (int q = 0; q < 4; ++q) { *(LAS u32x4*)(Ks + kk * LDK + 32 * half + 8 * q) = z; *(LAS u32x4*)(Vs + kk * LDK + 32 * half + 8 * q) = z; } } }
    if (tid == 0) *qslot = nxt_;
    __syncthreads();
    const unsigned nxt_u = *qslot;
    if (nxt_u < limit) { if (tid == 0) nxt_ = __hip_atomic_fetch_add(qctr, 1u, __ATOMIC_RELAXED, __HIP_MEMORY_SCOPE_AGENT); SWA_PREFETCH(nxt_u); }
    const float sink2 = a->swa_sinks[layer * 8 + qh] * 1.4426950408889634f;
    const float* gq = a->swa_q_g + layer * 64;
#pragma unroll
    for (int grp = 0; grp < 2; ++grp) {
        const int q0 = (w & 1) * 64 + grp * 32, T0 = q0 >> 5;
        bf16x8 qf[4];
        { f32x4 v[4][2]; float s = 0.f;
#pragma unroll
          for (int t = 0; t < 4; ++t) { pg8::unpack8(qraw[t], v[t][0], v[t][1]);
#pragma unroll
              for (int i = 0; i < 4; ++i) s += v[t][0][i] * v[t][0][i] + v[t][1][i] * v[t][1][i]; }
          s = swap32_sum(s); const float rs = rsqrtf(s * (1.0f / 64.0f) + EPS) * (0.125f * 1.4426950408889634f);
#pragma unroll
          for (int t = 0; t < 4; ++t) { const f32x4 g0 = *(const f32x4*)(gq + 16 * t + 8 * hh), g1 = *(const f32x4*)(gq + 16 * t + 8 * hh + 4);
#pragma unroll
              for (int i = 0; i < 4; ++i) { v[t][0][i] *= rs * g0[i]; v[t][1][i] *= rs * g1[i]; } }
          { const float cs_[8] = {qrope[0][0], qrope[0][2], qrope[1][0], qrope[1][2], qrope[2][0], qrope[2][2], qrope[3][0], qrope[3][2]};
            const float sn_[8] = {qrope[0][1], qrope[0][3], qrope[1][1], qrope[1][3], qrope[2][1], qrope[2][3], qrope[3][1], qrope[3][3]};
#pragma unroll
            for (int i = 0; i < 4; ++i) { const float p0 = swap32_partner(v[0][0][i], lane), p1 = swap32_partner(v[0][1][i], lane);
                if (hh == 0) { v[0][0][i] = v[0][0][i] * cs_[i] - p0 * sn_[i]; v[0][1][i] = v[0][1][i] * cs_[4 + i] - p1 * sn_[4 + i]; }
                else { v[0][0][i] = v[0][0][i] * cs_[i] + p0 * sn_[i]; v[0][1][i] = v[0][1][i] * cs_[4 + i] + p1 * sn_[4 + i]; } } }
#pragma unroll
          for (int t = 0; t < 4; ++t) qf[t] = __builtin_bit_cast(bf16x8, pg8::pack8(v[t][0], v[t][1])); }
        if (grp == 0) SWA_LOADQ(1);
        f32x16 x[5];
#pragma unroll
        for (int k = 0; k < 5; ++k) { f32x16 acc = {};
            if (!(qb == 0 && T0 + k < 4)) {
#pragma unroll
                for (int t = 0; t < 4; ++t) acc = __builtin_amdgcn_mfma_f32_32x32x16_bf16(*(const LAS bf16x8*)(Ks + (32 * (T0 + k) + qq) * LDK + 16 * t + 8 * hh), qf[t], acc, 0, 0, 0); }
            x[k] = acc; }
        float mx = sink2;
#pragma unroll
        for (int k = 0; k < 5; ++k) { const bool dead = (qb == 0 && T0 + k < 4);
#pragma unroll
            for (int i = 0; i < 16; ++i) { const int kr = (i & 3) + 8 * (i >> 2) + 4 * hh; bool ok = (k == 0) ? (kr > qq) : ((k == 4) ? (kr <= qq) : true); if (dead) ok = false; if (!ok) x[k][i] = -INFINITY; mx = fmaxf(mx, x[k][i]); } }
        mx = swap32_max(mx);
        float ls = 0.f; f32x16 o[2]; o[0] = (f32x16){}; o[1] = (f32x16){};
#pragma unroll
        for (int k = 0; k < 5; ++k) {
#pragma unroll
            for (int i = 0; i < 16; ++i) { x[k][i] = __builtin_amdgcn_exp2f(x[k][i] - mx); ls += x[k][i]; }
#pragma unroll
            for (int s = 0; s < 2; ++s) { u32x4 pw; pw.x = cvtpk(x[k][8 * s], x[k][8 * s + 1]); pw.y = cvtpk(x[k][8 * s + 2], x[k][8 * s + 3]); pw.z = cvtpk(x[k][8 * s + 4], x[k][8 * s + 5]); pw.w = cvtpk(x[k][8 * s + 6], x[k][8 * s + 7]);
                const bf16x8 pf = __builtin_bit_cast(bf16x8, pw);
                const int gg = lane >> 4, tq = (lane >> 2) & 3, tp = lane & 3; const LAS bf16* vb = Vs + (32 * (T0 + k) + 16 * s + 4 * (gg >> 1) + tq) * LDK + 16 * (gg & 1) + 4 * tp;
#pragma unroll
                for (int et = 0; et < 2; ++et) { const v4i16_t lo = __builtin_amdgcn_ds_read_tr16_b64_v4i16((LAS v4i16_t*)(vb + 32 * et)), hi = __builtin_amdgcn_ds_read_tr16_b64_v4i16((LAS v4i16_t*)(vb + 8 * LDK + 32 * et));
                    const bf16x8 vf = {lo[0], lo[1], lo[2], lo[3], hi[0], hi[1], hi[2], hi[3]};
                    o[et] = __builtin_amdgcn_mfma_f32_32x32x16_bf16(vf, pf, o[et], 0, 0, 0); } } }
        ls = swap32_sum(ls); const float inv = frcp(ls + __builtin_amdgcn_exp2f(sink2 - mx));
#pragma unroll
        for (int et = 0; et < 2; ++et)
#pragma unroll
            for (int blk = 0; blk < 4; ++blk) { u32x2 pv; pv.x = cvtpk(o[et][4 * blk] * inv, o[et][4 * blk + 1] * inv); pv.y = cvtpk(o[et][4 * blk + 2] * inv, o[et][4 * blk + 3] * inv); *(LAS u32x2*)(St + qq * LDK + 32 * et + 8 * blk + 4 * hh) = pv; }
        asm volatile("s_waitcnt lgkmcnt(0)" ::: "memory");
        { const size_t orow = (size_t)b * SEQ + qb * 128 + q0;
#pragma unroll
          for (int it = 0; it < 4; ++it) { const int r = it * 8 + (lane >> 3), ch = lane & 7; const u32x4 v = *(const LAS u32x4*)(St + r * LDK + ch * 8); *(u32x4*)(MIX + (orow + r) * DM + 512 + qh * 64 + ch * 8) = v; } }
        asm volatile("s_waitcnt lgkmcnt(0)" ::: "memory");
    }
    __syncthreads();
    if (nxt_u >= limit) break;
    cur_u = nxt_u;
    }
#undef SWA_PREFETCH
#undef SWA_LOADQ
}
constexpr int N_PHASES = 1 + 6 * DEPTH;
#ifndef REPEAT_PRO
#define REPEAT_PRO 1
#endif
#ifndef REPEAT_HGRN
#define REPEAT_HGRN 1
#endif
#ifndef REPEAT_MLSTM
#define REPEAT_MLSTM 1
#endif
#ifndef REPEAT_SWA
#define REPEAT_SWA 1
#endif
#ifndef EXTRA_BARRIERS
#define EXTRA_BARRIERS 0
#endif
#ifndef REP_IN
#define REP_IN 1
#endif
#ifndef REP_OUT
#define REP_OUT 1
#endif
#ifndef REP_UP
#define REP_UP 1
#endif
#ifndef REP_DOWN
#define REP_DOWN 1
#endif
#ifndef REP_PLE
#define REP_PLE 1
#endif
#ifndef REP_GATE
#define REP_GATE 1
#endif
__device__ __forceinline__ void grp_barrier(unsigned* base  , unsigned x, unsigned sh  ) {
    asm volatile("s_waitcnt vmcnt(0)" ::: "memory");
    __syncthreads();
    if (threadIdx.x == 0) {
        unsigned* ctr = base + CW_LBAR + 128 * x; unsigned* gen = ctr + 64; unsigned* tmo = base + CW_BAR + XB_TMO;
        __builtin_amdgcn_s_waitcnt(0);
        const unsigned old = xb_add(ctr, 1u); const unsigned g = old >> sh;
        if (((old + 1u) & ((1u << sh) - 1u)) == 0u) xb_add(gen, 1u);
        else XB_SPIN(xb_ld(gen) == g, base + CW_BAR);
        (void)tmo;
        __builtin_amdgcn_fence(__ATOMIC_ACQUIRE, "agent");
        asm volatile("s_waitcnt vmcnt(0)" ::: "memory");
    }
    __syncthreads();
}
__global__ void __launch_bounds__(NWAVES * 64, 2) trunk_fwd(Args args) {
    extern __shared__ __attribute__((aligned(16))) unsigned char lds_raw[];
    Frame F; F.lds = (LAS unsigned char*)lds_raw; F.wave = __builtin_amdgcn_readfirstlane((int)threadIdx.x >> 6); F.G = gridDim.x; F.gw = blockIdx.x * NWAVES + F.wave; F.NGW = F.G * NWAVES;
    for (int u = threadIdx.x; u < (LDS_BYTES - LDSCTL_OFF) / 4; u += NWAVES * 64) ((LAS unsigned*)(F.lds + LDSCTL_OFF))[u] = 0u;
    __syncthreads();
    const int lo = get_args()->ph_lo, hi = get_args()->ph_hi;
    volatile LAS unsigned* MISCW = (volatile LAS unsigned*)(F.lds + MISC_OFF);
    if (hi - lo > 1 && threadIdx.x == 0) { unsigned* barw = (unsigned*)((gu32*)(get_args()->ws + WS_CTL) + CW_BAR); const unsigned x_ = xb_xcc_id(); MISCW[11] = x_; MISCW[10] = xb_add(&barw[XB_XCNT(x_)], 1u); }
#ifndef REPEAT_MIX
#define REPEAT_MIX 1
#endif
#ifndef PHASE_MASK
#define PHASE_MASK 0xffff
#endif
#ifndef FORCE_GLOBAL
#define FORCE_GLOBAL 0
#endif
#ifndef GROUP_WGS
#define GROUP_WGS 32
#endif
#define PHM(b) ((PHASE_MASK >> (b)) & 1)
#define IN(k) (lo <= (k) && (k) < hi)
#define GLOBAL_BAR() do { XcdBarrier bar_; bar_.bar = (unsigned*)((gu32*)(get_args()->ws + WS_CTL) + CW_BAR); bar_.x = xb_xcc_id(); bar_.st = (volatile LAS unsigned*)(F.lds + MISC_OFF) + 8; xcd_barrier(bar_); } while (0)
#define SEAM(k) do { if (IN(k) && IN((k) + 1)) { if (F.local) grp_barrier((unsigned*)((gu32*)(get_args()->ws + WS_CTL)), (unsigned)F.grp, F.gsz == 8 ? 3u : 5u); else GLOBAL_BAR(); } } while (0)
#define SEAM_OWN(k) do { if (IN(k) && IN((k) + 1)) { if (F.local && F.gsz == 32) grp_barrier((unsigned*)((gu32*)(get_args()->ws + WS_CTL)) + (CW_QBAR - CW_LBAR), (unsigned)(8 * F.grp + (F.ceff & 7)), 2u); else if (!(F.local && F.gsz == 8)) SEAM(k); } } while (0)
#define PHASE_BEGIN ArgsP ap = get_args(); unsigned char* ws = ap->ws; ss_t* stats = (ss_t*)(ws + WS_STATS); bf16* Yb = (bf16*)(ws + WS_BIG); bf16* MIXb = (bf16*)(ws + WS_MIX); bf16* HID = (bf16*)(ws + WS_BIG); bf16* ERAW = (bf16*)(ws + WS_ERAW); \
        bf16* XBc = (bf16*)(ws + ((l & 1) ? WS_XB1 : WS_XB0)); bf16* XBn = (bf16*)(ws + ((l & 1) ? WS_XB0 : WS_XB1)); (void)stats; (void)Yb; (void)MIXb; (void)HID; (void)ERAW; (void)XBc; (void)XBn;
#define ORDER(N_) pg8::GroupOrder S; S.init(F.local ? F.gsz : M / 256, F.local ? F.gsz * F.grp : 0, (N_), F.gsz, F.ceff, F.local ? 0 : 1)

    F.local = 0; F.grp = 0; F.gsz = F.G; F.ceff = (int)blockIdx.x;
    if (PHM(6) && IN(0)) { for (int rp_ = 0; rp_ < REPEAT_PRO; ++rp_) p0_prologue(F, get_args()); }
    if (IN(0) && IN(1)) {
        GLOBAL_BAR();
        if (threadIdx.x == 0) { unsigned* barw = (unsigned*)((gu32*)(get_args()->ws + WS_CTL) + CW_BAR); unsigned ok = (gridDim.x == 256u) ? 1u : 0u;
#pragma unroll
            for (int j = 0; j < 16; ++j) { const unsigned c_ = xb_ld(&barw[XB_XCNT(j)]); if (c_ != (j < 8 ? 32u : 0u)) ok = 0u; }
            if (FORCE_GLOBAL) ok = 0u;
            MISCW[13] = ok; }
        __syncthreads();
        if (MISCW[13]) { const int x_ = (int)MISCW[11], r_ = (int)MISCW[10]; F.local = 1; F.gsz = GROUP_WGS; F.grp = x_ * (32 / GROUP_WGS) + r_ / GROUP_WGS; F.ceff = r_ % GROUP_WGS; }
        F.local = __builtin_amdgcn_readfirstlane(F.local); F.grp = __builtin_amdgcn_readfirstlane(F.grp); F.ceff = __builtin_amdgcn_readfirstlane(F.ceff); F.gsz = __builtin_amdgcn_readfirstlane(F.gsz);
    }

    for (int l = 0; l < DEPTH; ++l) {
        const int pb = 1 + 6 * l;
        if (PHM(0) && IN(pb)) { PHASE_BEGIN pg8::Gemm g{XBc, (const bf16*)(ws + WS_WIN) + (size_t)l * NY * DM, M, NY, DM, DM, 0}; ORDER(NY);
            pg8::EpiIn E{Yb, NY, (const float*)(ws + WS_BIASY) + l * NY, stats + (size_t)(SS_IN + l) * M, Y_BLK / 2};
            for (int rr_ = 0; rr_ < REP_IN; ++rr_) pg8::gemm_phase<pg8::EpiIn, pg8::GroupOrder, true, true>(F.lds, g, S, E, F.wave); }
        SEAM(pb);
        if (PHM(1) && IN(pb + 1)) { for (int rep_ = 0; rep_ < REPEAT_MIX; ++rep_) {
            const int ntask = F.local ? F.gsz : 256, half_ = ntask >> 1, bh0 = F.local ? half_ * F.grp : 0;
            for (int task = F.ceff; task < ntask; task += F.gsz) {
                if (task < half_) { for (int r1_ = 0; r1_ < REPEAT_MLSTM; ++r1_) mlstm_task(F, get_args(), l, bh0 + task); } else { for (int r2_ = 0; r2_ < REPEAT_HGRN; ++r2_) hgrn_task(F, get_args(), l, bh0 + task - half_); } }
            swa_loop(F, get_args(), l, (gu32*)(get_args()->ws + WS_CTL) + CW_QUEUE + 64 * (32 * l + F.grp) + 16 * rep_, F.local ? 4 * F.gsz * F.grp : 0, F.local ? (unsigned)(4 * F.gsz) : 1024u); } }
        SEAM(pb + 1);
        if (PHM(2) && IN(pb + 2)) { PHASE_BEGIN pg8::Gemm g{MIXb, (const bf16*)(ws + WS_WOUT) + (size_t)l * DM * DM, M, DM, DM, DM, MIX_BLK}; ORDER(DM);
            for (int rr_ = 0; rr_ < REP_OUT; ++rr_) { pg8::EpiRes E{XBc, rr_ ? XBn : XBc, DM, rr_ ? (ss_t*)(ws + WS_CTL + 512 * 1024) : stats + (size_t)(SS_MLP + l) * M};
            pg8::gemm_phase<pg8::EpiRes, pg8::GroupOrder, true, true>(F.lds, g, S, E, F.wave); } }
        SEAM(pb + 2);
        if (PHM(3) && IN(pb + 3)) { PHASE_BEGIN pg8::Gemm g{XBc, (const bf16*)(ws + WS_WUP) + (size_t)l * FF * DM, M, FF, DM, DM, 0}; ORDER(FF);
            pg8::EpiUp E{HID, FF, stats + (size_t)(SS_MLP + l) * M};
            for (int rr_ = 0; rr_ < REP_UP; ++rr_) pg8::gemm_phase<pg8::EpiUp, pg8::GroupOrder, true, true>(F.lds, g, S, E, F.wave); }
        SEAM_OWN(pb + 3);
        if (PHM(4) && IN(pb + 4)) {
            { PHASE_BEGIN pg8::Gemm g{HID, (const bf16*)(ws + WS_WDN) + (size_t)l * DM * FF, M, DM, FF, FF, 0}; ORDER(DM);
              for (int rr_ = 0; rr_ < REP_DOWN; ++rr_) { pg8::EpiRes E{XBc, rr_ ? XBn : XBc, DM, rr_ ? (ss_t*)(ws + WS_CTL + 512 * 1024) : stats + (size_t)(SS_PLE + l) * M};
              pg8::gemm_phase<pg8::EpiRes, pg8::GroupOrder, true, true>(F.lds, g, S, E, F.wave); } }
            int go2_ = 1; asm volatile("" : "+s"(go2_));
            if (go2_) { PHASE_BEGIN pg8::Gemm g{(const bf16*)ap->out + (size_t)l * PLE, (const bf16*)(ws + WS_WP) + (size_t)l * DM * PLE, M, DM, PLE, 2048, 0}; ORDER(DM);
              for (int rr_ = 0; rr_ < REP_PLE; ++rr_) { pg8::EpiPle E{ERAW, DM, rr_ ? (ss_t*)(ws + WS_CTL + 512 * 1024) : stats + (size_t)(SS_E + l) * M, ap->ple_post_g + l * DM};
              pg8::gemm_phase<pg8::EpiPle, pg8::GroupOrder, true, true>(F.lds, g, S, E, F.wave); } } }
        SEAM_OWN(pb + 4);
        if (PHM(5) && IN(pb + 5)) { PHASE_BEGIN pg8::Gemm g{XBc, (const bf16*)(ws + WS_WG) + (size_t)l * DM * DM, M, DM, DM, DM, 0}; ORDER(DM);
            const bool last = (l == DEPTH - 1);
            if (!last) { for (int rr_ = 0; rr_ < REP_GATE; ++rr_) { pg8::EpiGate<false> E{XBc, XBn, nullptr, ERAW, DM, stats + (size_t)(SS_PLE + l) * M, stats + (size_t)(SS_E + l) * M, rr_ ? (ss_t*)(ws + WS_CTL + 512 * 1024) : stats + (size_t)(SS_IN + l + 1) * M};
                pg8::gemm_phase<pg8::EpiGate<false>, pg8::GroupOrder, true, true>(F.lds, g, S, E, F.wave); } }
            else { for (int rr_ = 0; rr_ < REP_GATE; ++rr_) { pg8::EpiGate<true> E{XBc, XBn, ap->out, ERAW, DM, stats + (size_t)(SS_PLE + l) * M, stats + (size_t)(SS_E + l) * M, nullptr};
                pg8::gemm_phase<pg8::EpiGate<true>, pg8::GroupOrder, true, true>(F.lds, g, S, E, F.wave); } } }
        SEAM(pb + 5);
    }
#undef IN
#undef SEAM
}

#ifndef MK_N_LAUNCHES
#define MK_N_LAUNCHES 1
#endif
extern "C" void kernel_launch(void* const* d_in, const int* in_sizes, int n_in, void* d_out, int out_size, void* d_ws, size_t ws_size, hipStream_t stream) {
    static int grid = 0;
    if (grid == 0) {
        if (n_in != 23 || in_sizes[0] != M * DM || out_size != M * DM || ws_size < WS_END) { fprintf(stderr, "kernel_launch: unexpected shapes (n_in %d in0 %d out %d ws %zu); nothing launched\n", n_in, n_in > 0 ? in_sizes[0] : -1, out_size, ws_size); grid = -1; return; }
        int dev = 0, cus = 0, per_cu = 0;
        if (hipGetDevice(&dev) != hipSuccess || hipDeviceGetAttribute(&cus, hipDeviceAttributeMultiprocessorCount, dev) != hipSuccess) { grid = -1; return; }
        if (hipFuncSetAttribute((const void*)trunk_fwd, hipFuncAttributeMaxDynamicSharedMemorySize, LDS_BYTES) != hipSuccess) { fprintf(stderr, "kernel_launch: hipFuncSetAttribute failed\n"); grid = -1; return; }
        if (hipOccupancyMaxActiveBlocksPerMultiprocessor(&per_cu, (const void*)trunk_fwd, NWAVES * 64, LDS_BYTES) != hipSuccess || per_cu < 1) { fprintf(stderr, "kernel_launch: occupancy query says %d blocks per CU\n", per_cu); }
        (void)hipGetLastError();
        grid = cus;
    }
    if (grid < 0) return;
    if (hipMemsetAsync((char*)d_ws, 0, ZERO_BYTES, stream) != hipSuccess) return;
    Args a{};
    a.x = (const float*)d_in[0]; a.p = (const float*)d_in[1]; a.pos = (const int*)d_in[2];
    a.in_norm_g = (const float*)d_in[3]; a.w_in = (const float*)d_in[4]; a.b_in = (const float*)d_in[5]; a.mlstm_f_bias = (const float*)d_in[6]; a.conv_w = (const float*)d_in[7]; a.conv_b = (const float*)d_in[8];
    a.mlstm_norm_g = (const float*)d_in[9]; a.hgrn_lb_logits = (const float*)d_in[10]; a.hgrn_norm_g = (const float*)d_in[11]; a.swa_q_g = (const float*)d_in[12]; a.swa_k_g = (const float*)d_in[13]; a.swa_sinks = (const float*)d_in[14];
    a.w_out = (const float*)d_in[15]; a.mlp_norm_g = (const float*)d_in[16]; a.w_up = (const float*)d_in[17]; a.w_down = (const float*)d_in[18]; a.ple_norm_g = (const float*)d_in[19]; a.w_ple_gate = (const float*)d_in[20];
    a.w_ple_proj = (const float*)d_in[21]; a.ple_post_g = (const float*)d_in[22];
    a.out = (float*)d_out; a.ws = (unsigned char*)d_ws;
    for (int i = 0; i < 8; ++i) a.rope_rev[i] = pow(500000.0, -(double)i / 8.0) / 6.283185307179586476925286766559;
#if MK_N_LAUNCHES == 1
    a.ph_lo = 0; a.ph_hi = N_PHASES;
    hipLaunchKernelGGL(trunk_fwd, dim3(grid), dim3(NWAVES * 64), LDS_BYTES, stream, a);
#else
    for (int ph = 0; ph < N_PHASES; ++ph) { a.ph_lo = ph; a.ph_hi = ph + 1; hipLaunchKernelGGL(trunk_fwd, dim3(grid), dim3(NWAVES * 64), LDS_BYTES, stream, a); }
#endif
}
```

```cpp
#include <hip/hip_runtime.h>
#include <cstdio>
#include <cstdint>
#include <cmath>
namespace pg8 {
#define PG8_LAS __attribute__((address_space(3)))
typedef unsigned short bf16_t;
typedef short bf16x8 __attribute__((ext_vector_type(8)));
typedef float f32x4 __attribute__((ext_vector_type(4)));
typedef unsigned u32x4 __attribute__((ext_vector_type(4)));
constexpr int BM = 256, BK = 64, HALF = 128, HTB = HALF * BK * 2  , STAGE_BYTES = 8 * HTB, NXCD = 8, WGM = 8;

__host__ __device__ __forceinline__ int lds_byte(int r, int c) { const int st = (r >> 4) * 2 + (c >> 5), rr = r & 15, cc = c & 31, ob = rr * 64 + cc * 2; return st * 1024 + (ob ^ (((ob >> 9) & 1) << 5)); }
__host__ __device__ __forceinline__ void stage_rc(int b, int& R, int& C) { const int st = b / 1024, sb = b % 1024, swz = sb ^ (((sb >> 9) & 1) << 5); R = (st >> 1) * 16 + swz / 64; C = (st & 1) * 32 + (swz % 64) / 2; }
__host__ __device__ __forceinline__ int perm32(int rho) { const int n = rho >> 4, i = rho & 15; return 8 * (i >> 2) + 4 * n + (i & 3); }

struct Unit { int pm, pn; };
struct Gemm { const bf16_t* A; const bf16_t* Bt; int M, N, K, lda; size_t a_blk; };

struct StaticOrder {
    int nM, nN, nwg, G, c;
    __host__ __device__ void init(int M, int N, int G_, int c_) { nM = M / BM; nN = N / BM; nwg = nM * nN; G = G_; c = c_; }
    __host__ __device__ bool next(int i, Unit& u) const {
        const long L = (long)i * G + c; if (L >= nwg) return false;
        int wgid = (int)L; { const int q = nwg / NXCD, r = nwg % NXCD, xcd = wgid % NXCD, off = wgid / NXCD; wgid = (xcd < r ? xcd * (q + 1) : r * (q + 1) + (xcd - r) * q) + off; }
        const int nig = WGM * nN, gid = wgid / nig, fm = gid * WGM, gsz = (nM - fm) < WGM ? (nM - fm) : WGM;
        u.pm = fm + ((wgid % nig) % gsz); u.pn = (wgid % nig) / gsz; return true;
    }
    __device__ __forceinline__ void a_ready(const Unit&) const {}
    __device__ __forceinline__ void done(const Unit&) const {}
};
typedef __bf16 bf16x2v_t __attribute__((ext_vector_type(2))); typedef float f32x2v_t __attribute__((ext_vector_type(2)));
__device__ __forceinline__ unsigned cvt_pk_bf16(float lo, float hi) { const f32x2v_t v = {lo, hi}; return __builtin_bit_cast(unsigned, __builtin_convertvector(v, bf16x2v_t)); }
typedef float f32x2 __attribute__((ext_vector_type(2)));
template <class Epi, class Sched, bool ALIGN_EPI = false, bool SP2 = false>
__device__ __forceinline__ void gemm_phase(PG8_LAS unsigned char* lds, const Gemm g, const Sched& S, const Epi& E, const int wave_id) {
    int lid_; asm volatile("v_mbcnt_lo_u32_b32 %0, -1, 0\n\tv_mbcnt_hi_u32_b32 %0, -1, %0" : "=v"(lid_)); const int tid_ = __builtin_amdgcn_readfirstlane(wave_id) * 64 + lid_;
    const int tid = tid_, wid = __builtin_amdgcn_readfirstlane(tid >> 6), lane = tid & 63, wr = wid >> 2, wc = wid & 3, fr = lane & 15, fq = lane >> 4;
    int K_ = g.K; asm volatile("" : "+s"(K_));
    const int K = K_, nt = K / BK;
    unsigned voffA[2], voffB[2];
#pragma unroll
    for (int i = 0; i < 2; ++i) { int R, C; stage_rc(tid * 16 + i * 8192, R, C); const int Rb = Epi::PERM ? ((R & ~31) + perm32(R & 31)) : R;
        voffA[i] = (unsigned)(R * g.lda + C) * 2u; voffB[i] = (unsigned)(Rb * K + C) * 2u; }
    const size_t kstep = (size_t)(BK * 2);
    const size_t hstepB = (size_t)HALF * K * 2, hstepA = (size_t)HALF * g.lda * 2;
    const size_t tstepB = 2 * hstepB, tstepA = 2 * hstepA;
    const unsigned ldsw = (unsigned)wid * 1024u;
    const int aoff = lds_byte(wr * 64 + fr, fq * 8), boff = lds_byte(wc * 32 + fr, fq * 8);
#define PG8_SA(b, h) (((b) * 2 + (h)) * HTB)
#define PG8_SB(b, h) ((4 + (b) * 2 + (h)) * HTB)
#define PG8_STAGE(bufoff, gbase, voff) do { _Pragma("unroll") for (int _i = 0; _i < 2; ++_i) \
        __builtin_amdgcn_global_load_lds((const unsigned*)((const char*)(gbase) + (voff)[_i]), (PG8_LAS unsigned*)(lds + (bufoff) + ldsw + _i * 8192), 16, 0, 0); } while (0)
#define PG8_LDA(dst, b, h) do { _Pragma("unroll") for (int m = 0; m < 4; ++m) _Pragma("unroll") for (int k = 0; k < 2; ++k) dst[m][k] = *(const PG8_LAS bf16x8*)(lds + PG8_SA(b, h) + aoff + m * 2048 + k * 1024); } while (0)
#define PG8_LDB(dst, b, h) do { _Pragma("unroll") for (int n = 0; n < 2; ++n) _Pragma("unroll") for (int k = 0; k < 2; ++k) dst[n][k] = *(const PG8_LAS bf16x8*)(lds + PG8_SB(b, h) + boff + n * 2048 + k * 1024); } while (0)
#define PG8_MMA(ai, bj, At, Bt) do { __builtin_amdgcn_s_setprio(1); _Pragma("unroll") for (int m = 0; m < 4; ++m) _Pragma("unroll") for (int n = 0; n < 2; ++n) _Pragma("unroll") for (int k = 0; k < 2; ++k) \
        acc[ai][bj][m][n] = __builtin_amdgcn_mfma_f32_16x16x32_bf16(Bt[n][k], At[m][k], acc[ai][bj][m][n], 0, 0, 0); __builtin_amdgcn_s_setprio(0); } while (0)
#define PG8_WAIT_V(n) asm volatile("s_waitcnt vmcnt(" #n ")" ::: "memory")
#define PG8_WAIT_L(n) asm volatile("s_waitcnt lgkmcnt(" #n ")" ::: "memory")
#define PG8_BAR __builtin_amdgcn_s_barrier()
#define PG8_SCHED __builtin_amdgcn_sched_barrier(0)
    Unit cur, nxt; int ui = 0;
    if (!S.next(0, cur)) return;
    f32x4 acc[2][2][4][2];
#pragma unroll
    for (int a = 0; a < 2; ++a)
#pragma unroll
        for (int b = 0; b < 2; ++b)
#pragma unroll
            for (int m = 0; m < 4; ++m)
#pragma unroll
                for (int n = 0; n < 2; ++n) acc[a][b][m][n] = (f32x4){0.f, 0.f, 0.f, 0.f};
    bf16x8 At[4][2], B0[2][2], B1[2][2];
    const char* cA = (const char*)g.A + (size_t)cur.pm * tstepA + (size_t)(cur.pm >> 3) * g.a_blk; const char* cB = (const char*)g.Bt + (size_t)cur.pn * tstepB;
    S.a_ready(cur);
    if constexpr (SP2) {
        PG8_STAGE(PG8_SB(0, 0), cB, voffB); PG8_STAGE(PG8_SB(0, 1), cB + hstepB, voffB); PG8_STAGE(PG8_SA(0, 0), cA, voffA); PG8_STAGE(PG8_SA(0, 1), cA + hstepA, voffA);
        if (wr == 1) PG8_BAR;
        PG8_WAIT_V(2); PG8_BAR;
        PG8_STAGE(PG8_SB(1, 0), cB + kstep, voffB); PG8_STAGE(PG8_SA(1, 0), cA + kstep, voffA); PG8_STAGE(PG8_SB(1, 1), cB + hstepB + kstep, voffB);
        PG8_WAIT_V(6); PG8_BAR;
    } else {
        PG8_STAGE(PG8_SB(0, 0), cB, voffB); PG8_STAGE(PG8_SA(0, 0), cA, voffA); PG8_STAGE(PG8_SB(0, 1), cB + hstepB, voffB); PG8_STAGE(PG8_SA(0, 1), cA + hstepA, voffA);
        if (wr == 1) PG8_BAR;
        PG8_WAIT_V(4); PG8_BAR;
        PG8_STAGE(PG8_SB(1, 0), cB + kstep, voffB); PG8_STAGE(PG8_SA(1, 0), cA + kstep, voffA); PG8_STAGE(PG8_SB(1, 1), cB + hstepB + kstep, voffB);
        PG8_WAIT_V(6); PG8_BAR;
    }
    for (;;) {
        const bool has_next = S.next(ui + 1, nxt);
        const char* nA = has_next ? (const char*)g.A + (size_t)nxt.pm * tstepA + (size_t)(nxt.pm >> 3) * g.a_blk : cA; const char* nB = has_next ? (const char*)g.Bt + (size_t)nxt.pn * tstepB : cB;
        for (int t = 0; t < nt; t += 2) {
            const bool last = (t == nt - 2);
            const char* a1 = cA + (size_t)(t + 1) * kstep;
            const char* a2 = last ? nA : cA + (size_t)(t + 2) * kstep; const char* b2 = last ? nB : cB + (size_t)(t + 2) * kstep;
            const char* a3 = a2 + kstep; const char* b3 = b2 + kstep;
            if (last && has_next) S.a_ready(nxt);
            if constexpr (SP2) {
            PG8_LDB(B0, 0, 0); PG8_LDB(B1, 0, 1); PG8_SCHED; PG8_LDA(At, 0, 0); PG8_STAGE(PG8_SA(1, 1), a1 + hstepA, voffA);
            PG8_WAIT_V(8); PG8_WAIT_L(0); PG8_BAR; PG8_MMA(0, 0, At, B0); PG8_MMA(0, 1, At, B1); PG8_BAR; PG8_SCHED;
            PG8_LDA(At, 0, 1); PG8_STAGE(PG8_SB(0, 0), b2, voffB); PG8_STAGE(PG8_SB(0, 1), b2 + hstepB, voffB); PG8_STAGE(PG8_SA(0, 0), a2, voffA);
            PG8_WAIT_V(8); PG8_WAIT_L(0); PG8_BAR; PG8_MMA(1, 0, At, B0); PG8_MMA(1, 1, At, B1); PG8_BAR; PG8_SCHED;
            PG8_LDB(B0, 1, 0); PG8_LDB(B1, 1, 1); PG8_SCHED; PG8_LDA(At, 1, 0); PG8_STAGE(PG8_SA(0, 1), a2 + hstepA, voffA);
            PG8_WAIT_V(8); PG8_WAIT_L(0); PG8_BAR; PG8_MMA(0, 0, At, B0); PG8_MMA(0, 1, At, B1); PG8_BAR; PG8_SCHED;
            PG8_LDA(At, 1, 1); PG8_STAGE(PG8_SB(1, 0), b3, voffB); PG8_STAGE(PG8_SB(1, 1), b3 + hstepB, voffB); PG8_STAGE(PG8_SA(1, 0), a3, voffA);
            PG8_WAIT_V(8); PG8_WAIT_L(0); PG8_BAR; PG8_MMA(1, 0, At, B0); PG8_MMA(1, 1, At, B1); PG8_BAR; PG8_SCHED;
            } else {
            PG8_LDB(B0, 0, 0); PG8_SCHED; PG8_LDA(At, 0, 0); PG8_STAGE(PG8_SA(1, 1), a1 + hstepA, voffA);
            PG8_WAIT_L(8); PG8_BAR; PG8_WAIT_L(0); PG8_MMA(0, 0, At, B0); PG8_BAR; PG8_SCHED;
            PG8_LDB(B1, 0, 1); PG8_STAGE(PG8_SB(0, 0), b2, voffB);
            PG8_BAR; PG8_WAIT_L(0); PG8_MMA(0, 1, At, B1); PG8_BAR;
            PG8_LDA(At, 0, 1); PG8_STAGE(PG8_SA(0, 0), a2, voffA);
            PG8_BAR; PG8_WAIT_L(0); PG8_MMA(1, 0, At, B0); PG8_BAR; PG8_SCHED;
            PG8_STAGE(PG8_SB(0, 1), b2 + hstepB, voffB);
            PG8_WAIT_V(6); PG8_BAR; PG8_MMA(1, 1, At, B1); PG8_BAR;
            PG8_LDB(B0, 1, 0); PG8_SCHED; PG8_LDA(At, 1, 0); PG8_STAGE(PG8_SA(0, 1), a2 + hstepA, voffA);
            PG8_WAIT_L(8); PG8_BAR; PG8_WAIT_L(0); PG8_MMA(0, 0, At, B0); PG8_BAR; PG8_SCHED;
            PG8_LDB(B1, 1, 1); PG8_STAGE(PG8_SB(1, 0), b3, voffB);
            PG8_BAR; PG8_WAIT_L(0); PG8_MMA(0, 1, At, B1); PG8_BAR;
            PG8_LDA(At, 1, 1); PG8_STAGE(PG8_SA(1, 0), a3, voffA);
            PG8_BAR; PG8_WAIT_L(0); PG8_MMA(1, 0, At, B0); PG8_BAR; PG8_SCHED;
            PG8_STAGE(PG8_SB(1, 1), b3 + hstepB, voffB);
            PG8_WAIT_V(6); PG8_BAR; PG8_MMA(1, 1, At, B1); PG8_BAR;
            }
        }
        if constexpr (ALIGN_EPI) { if (wr == 0) PG8_BAR; }
        if constexpr (!Epi::AFTER_DRAIN) { E(acc, cur, wr, wc, fr, fq); S.done(cur); }
        if (!has_next) break;
#pragma unroll
        for (int a = 0; a < 2; ++a)
#pragma unroll
            for (int b = 0; b < 2; ++b)
#pragma unroll
                for (int m = 0; m < 4; ++m)
#pragma unroll
                    for (int n = 0; n < 2; ++n) acc[a][b][m][n] = (f32x4){0.f, 0.f, 0.f, 0.f};
        cur = nxt; cA = nA; cB = nB; ++ui;
        if constexpr (ALIGN_EPI) { if (wr == 1) PG8_BAR; }
    }
    PG8_WAIT_V(0);
    if constexpr (!ALIGN_EPI) { if (wr == 0) PG8_BAR; }
    PG8_BAR;
    if constexpr (Epi::AFTER_DRAIN) { E.fused(acc, cur, wr, wc, fr, fq, lds, wid, lane); S.done(cur); }
#undef PG8_SA
#undef PG8_SB
#undef PG8_STAGE
#undef PG8_LDA
#undef PG8_LDB
#undef PG8_MMA
#undef PG8_WAIT_V
#undef PG8_WAIT_L
#undef PG8_BAR
#undef PG8_SCHED
}
}

namespace pg8 {
struct GroupOrder {
    int nM, nN, nwg, G, c, pm_base, remap;
    __device__ __forceinline__ void init(int nM_, int pm_base_, int N, int G_, int c_, int remap_) { nM = nM_; nN = N / BM; nwg = nM * nN; G = G_; c = c_; pm_base = pm_base_; remap = remap_; }
    __device__ __forceinline__ bool next(int i, Unit& u) const {
        const long L = (long)i * G + c; if (L >= nwg) return false;
        int wgid = (int)L; if (remap) { const int q = nwg / NXCD, r = nwg % NXCD, xcd = wgid % NXCD, off = wgid / NXCD; wgid = (xcd < r ? xcd * (q + 1) : r * (q + 1) + (xcd - r) * q) + off; }
        const int nig = WGM * nN, gid = wgid / nig, fm = gid * WGM, gsz = (nM - fm) < WGM ? (nM - fm) : WGM;
        u.pm = pm_base + fm + ((wgid % nig) % gsz); u.pn = (wgid % nig) / gsz; return true;
    }
    __device__ __forceinline__ void a_ready(const Unit&) const {}
    __device__ __forceinline__ void done(const Unit&) const {}
};
}
constexpr int NWAVES = 8;
constexpr int BATCH = 32, SEQ = 2048, DM = 1024, DEPTH = 4, M = BATCH * SEQ, NY = 3072, FF = 4096, PLE = 256, INW = 2824;
constexpr float EPS = 1e-6f;
constexpr int YC_MQ = 0, YC_MK = 256, YC_MV = 512, YC_MO = 768, YC_HQ = 1024, YC_HF = 1280, YC_HI = 1536, YC_HG = 1792, YC_SQ = 2048, YC_SK = 2560, YC_SV = 2688, YC_MI = 2816, YC_MF = 2820;

constexpr size_t MiB = 1u << 20;
constexpr size_t WS_CTL = 0, WS_STATS = 1 * MiB, ZERO_BYTES = 9 * MiB;
constexpr size_t WS_ROPE = 9 * MiB;
constexpr size_t WS_BIASY = 13 * MiB;
constexpr size_t WS_WIN = 14 * MiB, WS_WOUT = 38 * MiB, WS_WUP = 46 * MiB, WS_WDN = 78 * MiB, WS_WG = 110 * MiB, WS_WP = 118 * MiB;
constexpr size_t WS_XB0 = 120 * MiB, WS_XB1 = 248 * MiB;
constexpr size_t WS_BIG = 376 * MiB;
constexpr size_t WS_MIX = WS_BIG + 12 * MiB;
constexpr size_t Y_BLK = 4 * MiB, MIX_BLK = 12 * MiB;
constexpr size_t WS_ERAW = 888 * MiB;
constexpr size_t WS_END = 1016 * MiB;
constexpr int SS_IN = 0, SS_MLP = 4, SS_PLE = 8, SS_E = 12;
constexpr int CW_BAR = 4096, CW_QUEUE = 16384, CW_LBAR = 32768, CW_QBAR = 65536;

constexpr int SCR_BYTES = 159744;
constexpr int LDSCTL_OFF = SCR_BYTES, MISC_OFF = LDSCTL_OFF + 320;
constexpr int LDS_BYTES = 163840;

#define GAS __attribute__((address_space(1)))
#define LAS __attribute__((address_space(3)))
typedef unsigned short bf16;
typedef unsigned v4u __attribute__((ext_vector_type(4)));
typedef float f32x4 __attribute__((ext_vector_type(4)));
typedef short bf16x8 __attribute__((ext_vector_type(8)));
typedef GAS unsigned gu32;
typedef GAS unsigned long long gu64;
#define RLX_AGENT __ATOMIC_RELAXED, __HIP_MEMORY_SCOPE_AGENT
#define LDS_WAIT() asm volatile("s_waitcnt lgkmcnt(0)" ::: "memory")
#define VM_WAIT() asm volatile("s_waitcnt vmcnt(0)" ::: "memory")
__device__ __forceinline__ unsigned long long rt() { return __builtin_amdgcn_s_memrealtime(); }
__device__ __forceinline__ unsigned f2bf(float f) { unsigned u = __builtin_bit_cast(unsigned, f); return (u + 0x7fffu + ((u >> 16) & 1u)) >> 16; }
__device__ __forceinline__ unsigned pk2(float lo, float hi) { return f2bf(lo) | (f2bf(hi) << 16); }
typedef unsigned u32x4 __attribute__((ext_vector_type(4)));
typedef unsigned u32x2 __attribute__((ext_vector_type(2)));
#define XB_TMO      128
#define XB_XCNT(j)  (256  + 64 * (j))
#define XB_XSUB(j)  (1280 + 64 * (j))
#define XB_XGEN(j)  (2304 + 64 * (j))
#define XB_TOP      3328
#define XB_TOPGEN   3392
#define XCD_BAR_WORDS 3456
#define XB_SPIN_CAP (1u << 18)

__device__ __forceinline__ unsigned xb_ld(unsigned* p)              { return __hip_atomic_load(p, __ATOMIC_RELAXED, __HIP_MEMORY_SCOPE_AGENT); }
__device__ __forceinline__ unsigned xb_add(unsigned* p, unsigned v) { return __hip_atomic_fetch_add(p, v, __ATOMIC_RELAXED, __HIP_MEMORY_SCOPE_AGENT); }
__device__ __forceinline__ unsigned xb_xcc_id() { return (unsigned)__builtin_amdgcn_s_getreg((3 << 11) | 20) & 0xFu; }
#define XB_SPIN(cond, bar) do { unsigned _sp = 0; while (cond) { __builtin_amdgcn_s_sleep(1); \
    if ((++_sp & 255u) == 0u) { if (xb_ld(&(bar)[XB_TMO])) break; if (_sp > XB_SPIN_CAP) { atomicAdd(&(bar)[XB_TMO], 1u); break; } } } } while (0)

struct XcdBarrier {
    unsigned* bar; unsigned x;
    volatile LAS unsigned* st;
};

__device__ __forceinline__ XcdBarrier xcd_barrier_post(unsigned* bar, volatile LAS unsigned* st) {
    XcdBarrier b; b.bar = bar; b.x = xb_xcc_id(); b.st = st;
    if (threadIdx.x == 0) (void)xb_add(&bar[XB_XCNT(b.x)], 1u);
    return b;
}
__device__ __forceinline__ void xcd_barrier_complete(unsigned* bar, unsigned x, unsigned& nloc, unsigned& nx) {
    const unsigned G = gridDim.x * gridDim.y * gridDim.z;
    unsigned sum, cnt, mine, sp = 0u;
    for (;;) {
        sum = 0u; cnt = 0u; mine = 0u;
#pragma unroll
        for (unsigned j = 0; j < 16; ++j) { const unsigned c = xb_ld(&bar[XB_XCNT(j)]); sum += c; cnt += (c > 0u) ? 1u : 0u; mine = (j == x) ? c : mine; }
        if (sum == G) break;
        __builtin_amdgcn_s_sleep(1);
        if ((++sp & 255u) == 0u) { if (xb_ld(&bar[XB_TMO])) break; if (sp > XB_SPIN_CAP) { atomicAdd(&bar[XB_TMO], 1u); break; } }
    }
    nloc = mine > 0u ? mine : 1u; nx = cnt > 0u ? cnt : 1u;
}

__device__ __forceinline__ void xcd_barrier(const XcdBarrier& b) {
    asm volatile("s_waitcnt vmcnt(0)" ::: "memory");
    __syncthreads();
    if (threadIdx.x == 0) {
        unsigned* bar = b.bar;
        __builtin_amdgcn_s_waitcnt(0);
        unsigned nloc = b.st[0], nx = b.st[1];
        if (nloc == 0u) { xcd_barrier_complete(bar, b.x, nloc, nx); b.st[0] = nloc; b.st[1] = nx; }
        const unsigned old = xb_add(&bar[XB_XSUB(b.x)], 1u);
        const unsigned gen = old / nloc;
        if (old + 1u == (gen + 1u) * nloc) {
            __builtin_amdgcn_fence(__ATOMIC_RELEASE, "agent");
            asm volatile("s_waitcnt vmcnt(0)" ::: "memory");
            const unsigned og = xb_add(&bar[XB_TOP], 1u);
            const unsigned tg = og / nx;
            if (og + 1u == (tg + 1u) * nx) xb_add(&bar[XB_TOPGEN], 1u);
            else XB_SPIN(xb_ld(&bar[XB_TOPGEN]) == tg, bar);
            __builtin_amdgcn_fence(__ATOMIC_ACQUIRE, "agent");
            xb_add(&bar[XB_XGEN(b.x)], 1u);
            asm volatile("s_waitcnt vmcnt(0)" ::: "memory");
        } else {
            XB_SPIN(xb_ld(&bar[XB_XGEN(b.x)]) == gen, bar);
            __builtin_amdgcn_fence(__ATOMIC_ACQUIRE, "agent");
            asm volatile("s_waitcnt vmcnt(0)" ::: "memory");
        }
    }
    __syncthreads();
}

__device__ __forceinline__ float bf2f(unsigned short b) { return __uint_as_float((unsigned)b << 16); }
__device__ __forceinline__ float bflo(unsigned w) { return __uint_as_float(w << 16); }
__device__ __forceinline__ float bfhi(unsigned w) { return __uint_as_float(w & 0xffff0000u); }
__device__ __forceinline__ unsigned short f2bf16(float f) { return (unsigned short)f2bf(f); }
__device__ __forceinline__ float sigmoid_f(float x) { return 1.f / (1.f + __expf(-x)); }
__device__ __forceinline__ float silu_f(float x) { return x * sigmoid_f(x); }
__device__ __forceinline__ float logsigmoid_f(float x) { return fminf(x, 0.f) - log1pf(__expf(-fabsf(x))); }
__device__ __forceinline__ float wave_sum(float v) {
#pragma unroll
    for (int o = 1; o < 64; o <<= 1) v += __shfl_xor(v, o);
    return v;
}
typedef unsigned long long ss_t;
__device__ __forceinline__ void atomic_add_ss(ss_t* p, float v) { atomicAdd(p, (ss_t)(v * 16777216.0f)); }
__device__ __forceinline__ float ss_rstd_v(ss_t v, float inv_n) { const u32x2 hl_ = __builtin_bit_cast(u32x2, v); const float f = __builtin_fmaf((float)hl_.y, 4294967296.0f, (float)hl_.x); return __builtin_amdgcn_rsqf(f * (inv_n * (1.0f / 16777216.0f)) + 1e-6f); }
__device__ __forceinline__ float ss_rstd(const ss_t* p, float inv_n) { return rsqrtf((float)(*p) * (inv_n * (1.0f / 16777216.0f)) + 1e-6f); }

namespace pg8 {
__device__ __forceinline__ int epi_lane() { int x; asm volatile("v_mbcnt_lo_u32_b32 %0, -1, 0\n\tv_mbcnt_hi_u32_b32 %0, -1, %0" : "=v"(x)); return x; }
#define EPI_ROWCOL const int ln_ = epi_lane(); fr = ln_ & 15; fq = ln_ >> 4; const int row0 = u.pm * BM + wr * 64 + fr; const int col0 = u.pn * BM + wc * 32 + 8 * fq;
__device__ __forceinline__ float sum_x16x32(float x) { auto r = __builtin_amdgcn_permlane16_swap(__float_as_uint(x), __float_as_uint(x), false, false); x = __uint_as_float(r[0]) + __uint_as_float(r[1]);
    auto q = __builtin_amdgcn_permlane32_swap(__float_as_uint(x), __float_as_uint(x), false, false); return __uint_as_float(q[0]) + __uint_as_float(q[1]); }
__device__ __forceinline__ u32x4 pack8(const f32x4 v0, const f32x4 v1) { u32x4 w; w.x = cvt_pk_bf16(v0[0], v0[1]); w.y = cvt_pk_bf16(v0[2], v0[3]); w.z = cvt_pk_bf16(v1[0], v1[1]); w.w = cvt_pk_bf16(v1[2], v1[3]); return w; }
__device__ __forceinline__ float sq8(const u32x4 w) { float s = 0.f;
    { float a = __uint_as_float(w.x << 16), b = __uint_as_float(w.x & 0xffff0000u); s += a * a + b * b; }
    { float a = __uint_as_float(w.y << 16), b = __uint_as_float(w.y & 0xffff0000u); s += a * a + b * b; }
    { float a = __uint_as_float(w.z << 16), b = __uint_as_float(w.z & 0xffff0000u); s += a * a + b * b; }
    { float a = __uint_as_float(w.w << 16), b = __uint_as_float(w.w & 0xffff0000u); s += a * a + b * b; } return s; }
typedef __bf16 bf16x2v __attribute__((ext_vector_type(2)));
__device__ __forceinline__ float dot2sq(unsigned w, float s) { const bf16x2v v = __builtin_bit_cast(bf16x2v, w); return __builtin_amdgcn_fdot2_f32_bf16(v, v, s, false); }
__device__ __forceinline__ void sqacc8(const u32x4 w, float& s0, float& s1) { s0 = dot2sq(w.x, s0); s1 = dot2sq(w.y, s1); s0 = dot2sq(w.z, s0); s1 = dot2sq(w.w, s1); }
__device__ __forceinline__ float rs4(float q0, float q1, float q2, float q3) {
    auto r = __builtin_amdgcn_permlane32_swap(__float_as_uint(q0), __float_as_uint(q2), false, false); const float a = __uint_as_float(r[0]) + __uint_as_float(r[1]);
    auto t = __builtin_amdgcn_permlane32_swap(__float_as_uint(q1), __float_as_uint(q3), false, false); const float c = __uint_as_float(t[0]) + __uint_as_float(t[1]);
    auto z = __builtin_amdgcn_permlane16_swap(__float_as_uint(a), __float_as_uint(c), false, false); return __uint_as_float(z[0]) + __uint_as_float(z[1]); }
__device__ __forceinline__ float ssq8(const f32x4 a, const f32x4 b) { return ((a[0] * a[0] + a[1] * a[1]) + (a[2] * a[2] + a[3] * a[3])) + ((b[0] * b[0] + b[1] * b[1]) + (b[2] * b[2] + b[3] * b[3])); }
__device__ __forceinline__ void unpack8(const u32x4 w, f32x4& v0, f32x4& v1) {
    v0 = (f32x4){__uint_as_float(w.x << 16), __uint_as_float(w.x & 0xffff0000u), __uint_as_float(w.y << 16), __uint_as_float(w.y & 0xffff0000u)};
    v1 = (f32x4){__uint_as_float(w.z << 16), __uint_as_float(w.z & 0xffff0000u), __uint_as_float(w.w << 16), __uint_as_float(w.w & 0xffff0000u)}; }

struct EpiIn {
    static constexpr bool PERM = true, AFTER_DRAIN = false;
    bf16_t* O; int ldc; const float* bias; const ss_t* ss; size_t oblk;
    __device__ __forceinline__ void operator()(const f32x4 (&acc)[2][2][4][2], const Unit& u, int wr, int wc, int fr, int fq) const {
        EPI_ROWCOL
        f32x4 bv[2][2]; ss_t sv[2][4];
#pragma unroll
        for (int ai = 0; ai < 2; ++ai)
#pragma unroll
            for (int m = 0; m < 4; ++m) sv[ai][m] = ss[row0 + ai * HALF + m * 16];
#pragma unroll
        for (int bj = 0; bj < 2; ++bj)
#pragma unroll
            for (int n = 0; n < 2; ++n) bv[bj][n] = *(const f32x4*)(bias + col0 + bj * HALF + 4 * n);
#pragma unroll
        for (int ai = 0; ai < 2; ++ai)
#pragma unroll
            for (int m = 0; m < 4; ++m) { const int row = row0 + ai * HALF + m * 16; const float rs = ss_rstd_v(sv[ai][m], 1.0f / 1024.0f); bf16_t* rowp = O + (size_t)(u.pm >> 3) * oblk + (size_t)row * ldc + col0;
#pragma unroll
                for (int bj = 0; bj < 2; ++bj) { const f32x4 v0 = acc[ai][bj][m][0] * rs + bv[bj][0], v1 = acc[ai][bj][m][1] * rs + bv[bj][1]; *(u32x4*)(rowp + bj * HALF) = pack8(v0, v1); } }
    }
};
struct EpiRes {
    static constexpr bool PERM = true, AFTER_DRAIN = false;
    bf16_t* X; bf16_t* Xo; int ldc; ss_t* ss_out;
    __device__ __forceinline__ void operator()(const f32x4 (&acc)[2][2][4][2], const Unit& u, int wr, int wc, int fr, int fq) const {
        EPI_ROWCOL
        u32x4 old[2][4][2];
#pragma unroll
        for (int ai = 0; ai < 2; ++ai)
#pragma unroll
            for (int m = 0; m < 4; ++m)
#pragma unroll
                for (int bj = 0; bj < 2; ++bj) old[ai][m][bj] = *(const u32x4*)(X + (size_t)(row0 + ai * HALF + m * 16) * ldc + col0 + bj * HALF);
        asm volatile("" ::: "memory");
#pragma unroll
        for (int ai = 0; ai < 2; ++ai)
        { float q[4];
#pragma unroll
            for (int m = 0; m < 4; ++m) { const int row = row0 + ai * HALF + m * 16; bf16_t* rowp = Xo + (size_t)row * ldc + col0; float s0 = 0.f, s1 = 0.f;
#pragma unroll
                for (int bj = 0; bj < 2; ++bj) { f32x4 o0, o1; unpack8(old[ai][m][bj], o0, o1);
                    const f32x4 n0 = o0 + acc[ai][bj][m][0], n1 = o1 + acc[ai][bj][m][1]; const u32x4 w = pack8(n0, n1); *(u32x4*)(rowp + bj * HALF) = w; sqacc8(w, s0, s1); }
                q[m] = s0 + s1; }
            atomic_add_ss(ss_out + row0 + ai * HALF + 16 * fq, rs4(q[0], q[1], q[2], q[3])); }
    }
};
struct EpiUp {
    static constexpr bool PERM = true, AFTER_DRAIN = false;
    bf16_t* O; int ldc; const ss_t* ss;
    __device__ __forceinline__ void operator()(const f32x4 (&acc)[2][2][4][2], const Unit& u, int wr, int wc, int fr, int fq) const {
        EPI_ROWCOL
        ss_t sv[2][4];
#pragma unroll
        for (int ai = 0; ai < 2; ++ai)
#pragma unroll
            for (int m = 0; m < 4; ++m) sv[ai][m] = ss[row0 + ai * HALF + m * 16];
#pragma unroll
        for (int ai = 0; ai < 2; ++ai)
#pragma unroll
            for (int m = 0; m < 4; ++m) { const int row = row0 + ai * HALF + m * 16; const float rs = ss_rstd_v(sv[ai][m], 1.0f / 1024.0f); bf16_t* rowp = O + (size_t)row * ldc + col0;
#pragma unroll
                for (int bj = 0; bj < 2; ++bj) { f32x4 v0 = acc[ai][bj][m][0] * rs, v1 = acc[ai][bj][m][1] * rs;
#pragma unroll
                    for (int j = 0; j < 4; ++j) { const float a = fmaxf(v0[j], 0.f), b = fmaxf(v1[j], 0.f); v0[j] = a * a; v1[j] = b * b; }
                    *(u32x4*)(rowp + bj * HALF) = pack8(v0, v1); } }
    }
};
struct EpiPle {
    static constexpr bool PERM = true, AFTER_DRAIN = false;
    bf16_t* O; int ldc; ss_t* ss_out; const float* gpost;
    __device__ __forceinline__ void operator()(const f32x4 (&acc)[2][2][4][2], const Unit& u, int wr, int wc, int fr, int fq) const {
        EPI_ROWCOL
        f32x4 gp[2][2];
#pragma unroll
        for (int bj = 0; bj < 2; ++bj)
#pragma unroll
            for (int n = 0; n < 2; ++n) gp[bj][n] = *(const f32x4*)(gpost + col0 + bj * HALF + 4 * n);
#pragma unroll
        for (int ai = 0; ai < 2; ++ai)
        { float q[4];
#pragma unroll
            for (int m = 0; m < 4; ++m) { const int row = row0 + ai * HALF + m * 16; bf16_t* rowp = O + (size_t)row * ldc + col0; f32x4 sv = {0.f, 0.f, 0.f, 0.f};
#pragma unroll
                for (int bj = 0; bj < 2; ++bj) { const f32x4 a0 = acc[ai][bj][m][0], a1 = acc[ai][bj][m][1]; *(u32x4*)(rowp + bj * HALF) = pack8(a0 * gp[bj][0], a1 * gp[bj][1]);
                    sv += a0 * a0; sv += a1 * a1; }
                q[m] = (sv[0] + sv[1]) + (sv[2] + sv[3]); }
            atomic_add_ss(ss_out + row0 + ai * HALF + 16 * fq, rs4(q[0], q[1], q[2], q[3])); }
    }
};
template <bool LAST> struct EpiGate {
    static constexpr bool PERM = true, AFTER_DRAIN = false;
    const bf16_t* Xin; bf16_t* Xout; float* Fout; const bf16_t* E; int ldc; const ss_t* ss_x; const ss_t* ss_e; ss_t* ss_out;
    __device__ __forceinline__ void operator()(const f32x4 (&acc)[2][2][4][2], const Unit& u, int wr, int wc, int fr, int fq) const {
        EPI_ROWCOL
        u32x4 xo[2][2][2], ev[2][2][2]; ss_t sx[2][2], se[2][2];
#define GATE_LOAD(q_, b_) do { const int ai_ = (q_) >> 1, m0_ = ((q_) & 1) * 2; \
            _Pragma("unroll") for (int mm = 0; mm < 2; ++mm) { const int row_ = row0 + ai_ * HALF + (m0_ + mm) * 16; sx[b_][mm] = ss_x[row_]; se[b_][mm] = ss_e[row_]; \
                _Pragma("unroll") for (int bj = 0; bj < 2; ++bj) { const size_t off_ = (size_t)row_ * ldc + col0 + bj * HALF; xo[b_][mm][bj] = *(const u32x4*)(Xin + off_); ev[b_][mm][bj] = *(const u32x4*)(E + off_); } } } while (0)
        GATE_LOAD(0, 0);
        float q[4] = {0.f, 0.f, 0.f, 0.f};
#pragma unroll
        for (int qtr = 0; qtr < 4; ++qtr) {
            const int ai = qtr >> 1, m0 = (qtr & 1) * 2, cb = qtr & 1;
            if (qtr < 3) GATE_LOAD(qtr + 1, cb ^ 1);
            asm volatile("" ::: "memory");
#pragma unroll
            for (int mm = 0; mm < 2; ++mm) { const int m = m0 + mm; const int row = row0 + ai * HALF + m * 16; const size_t off = (size_t)row * ldc + col0; float s0 = 0.f, s1 = 0.f;
                const float nrsx2 = -1.4426950408889634f * ss_rstd_v(sx[cb][mm], 1.0f / 1024.0f), rse = ss_rstd_v(se[cb][mm], 1.0f / 1024.0f);
#pragma unroll
                for (int bj = 0; bj < 2; ++bj) { f32x4 x0, x1, e0, e1; unpack8(xo[cb][mm][bj], x0, x1); unpack8(ev[cb][mm][bj], e0, e1);
                    f32x4 d0 = acc[ai][bj][m][0] * nrsx2, d1 = acc[ai][bj][m][1] * nrsx2;
#pragma unroll
                    for (int j = 0; j < 4; ++j) { d0[j] = __builtin_amdgcn_exp2f(d0[j]); d1[j] = __builtin_amdgcn_exp2f(d1[j]); }
                    d0 = d0 + 1.f; d1 = d1 + 1.f;
#pragma unroll
                    for (int j = 0; j < 4; ++j) { d0[j] = __builtin_amdgcn_rcpf(d0[j]); d1[j] = __builtin_amdgcn_rcpf(d1[j]); }
                    const f32x4 r0 = x0 + d0 * (e0 * rse), r1 = x1 + d1 * (e1 * rse);
                    if constexpr (LAST) { *(f32x4*)(Fout + off + bj * HALF) = r0; *(f32x4*)(Fout + off + bj * HALF + 4) = r1; }
                    else { const u32x4 w = pack8(r0, r1); *(u32x4*)(Xout + off + bj * HALF) = w; sqacc8(w, s0, s1); } }
                q[m] = s0 + s1; }
            if constexpr (!LAST) { if (qtr & 1) atomic_add_ss(ss_out + row0 + ai * HALF + 16 * fq, rs4(q[0], q[1], q[2], q[3])); } }
#undef GATE_LOAD
    }
};
}

struct Args {
    const float* x; const float* p; const int* pos;
    const float *in_norm_g, *w_in, *b_in, *mlstm_f_bias, *conv_w, *conv_b, *mlstm_norm_g, *hgrn_lb_logits, *hgrn_norm_g, *swa_q_g, *swa_k_g, *swa_sinks, *w_out, *mlp_norm_g, *w_up, *w_down,
        *ple_norm_g, *w_ple_gate, *w_ple_proj, *ple_post_g;
    float* out; unsigned char* ws;
    double rope_rev[8];
    int ph_lo, ph_hi;
};
struct Frame {
    LAS unsigned char* lds; int wave, G, gw, NGW;
    int local, grp, gsz, ceff;
};
typedef const __attribute__((address_space(4))) Args* ArgsP;
__device__ __forceinline__ ArgsP get_args() { ArgsP p = (ArgsP)__builtin_amdgcn_kernarg_segment_ptr(); asm volatile("" : "+s"(p)); return p; }
__device__ __forceinline__ int lane_id() { int x; asm volatile("v_mbcnt_lo_u32_b32 %0, -1, 0\n\tv_mbcnt_hi_u32_b32 %0, -1, %0" : "=v"(x)); return x; }

template <class ColMap>
__device__ __forceinline__ void transpose_item(const float* W, int K, int N, const float* gain, bf16* WT, int nblk, LAS float* scr, int item, int lane, ColMap cm) {
    const int kb = item / nblk, nb = item % nblk, k0 = 64 * kb, n0 = 32 * nb;
    const int src = cm(n0 + (lane & 31));
    float tv[32];
#pragma unroll
    for (int i = 0; i < 32; ++i) { const int kk = 2 * i + (lane >> 5); tv[i] = (src >= 0) ? W[(size_t)(k0 + kk) * N + src] : 0.f; }
#pragma unroll
    for (int i = 0; i < 32; ++i) { const int kk = 2 * i + (lane >> 5); float v = tv[i]; if (gain) v *= gain[k0 + kk]; scr[kk * 33 + (lane & 31)] = v; }
    LDS_WAIT(); asm volatile("" ::: "memory");
    const int c = lane & 7;
#pragma unroll
    for (int j = 0; j < 4; ++j) { const int n = (lane >> 3) + 8 * j; const LAS float* s = scr + (8 * c) * 33 + n;
        v4u o; o.x = pk2(s[0 * 33], s[1 * 33]); o.y = pk2(s[2 * 33], s[3 * 33]); o.z = pk2(s[4 * 33], s[5 * 33]); o.w = pk2(s[6 * 33], s[7 * 33]);
        *(GAS v4u*)(WT + (size_t)(n0 + n) * K + k0 + 8 * c) = o; }
    LDS_WAIT(); asm volatile("" ::: "memory");
}
struct IdMap { __device__ __forceinline__ int operator()(int n) const { return n; } };
struct YMap { __device__ __forceinline__ int operator()(int n) const { return n < 1024 ? n : (n < 2816 ? n + 8 : (n < 2824 ? n - 2816 + 1024 : -1)); } };

__device__ __forceinline__ void p0_prologue(const Frame& F, ArgsP a) {
    unsigned char* ws = a->ws; const int lane = lane_id();
    LAS float* scr = (LAS float*)(F.lds + F.wave * 16384);
    const int gw = F.gw, NGW = F.NGW;
    constexpr int I_IN = 16 * (NY / 32), I_OUT = 16 * 32, I_UP = 16 * (FF / 32), I_DN = 64 * 32, I_G = 16 * 32, I_P = 4 * 32, I_LAYER = I_IN + I_OUT + I_UP + I_DN + I_G + I_P;
    for (int it = gw; it < DEPTH * I_LAYER; it += NGW) {
        const int l = it / I_LAYER; int r = it % I_LAYER;
        if (r < I_IN) { transpose_item(a->w_in + (size_t)l * DM * INW, DM, INW, a->in_norm_g + l * DM, (bf16*)(ws + WS_WIN) + (size_t)l * NY * DM, NY / 32, scr, r, lane, YMap()); continue; } r -= I_IN;
        if (r < I_OUT) { transpose_item(a->w_out + (size_t)l * DM * DM, DM, DM, nullptr, (bf16*)(ws + WS_WOUT) + (size_t)l * DM * DM, DM / 32, scr, r, lane, IdMap()); continue; } r -= I_OUT;
        if (r < I_UP) { transpose_item(a->w_up + (size_t)l * DM * FF, DM, FF, a->mlp_norm_g + l * DM, (bf16*)(ws + WS_WUP) + (size_t)l * FF * DM, FF / 32, scr, r, lane, IdMap()); continue; } r -= I_UP;
        if (r < I_DN) { transpose_item(a->w_down + (size_t)l * FF * DM, FF, DM, nullptr, (bf16*)(ws + WS_WDN) + (size_t)l * DM * FF, DM / 32, scr, r, lane, IdMap()); continue; } r -= I_DN;
        if (r < I_G) { transpose_item(a->w_ple_gate + (size_t)l * DM * DM, DM, DM, a->ple_norm_g + l * DM, (bf16*)(ws + WS_WG) + (size_t)l * DM * DM, DM / 32, scr, r, lane, IdMap()); continue; } r -= I_G;
        transpose_item(a->w_ple_proj + (size_t)l * PLE * DM, PLE, DM, nullptr, (bf16*)(ws + WS_WP) + (size_t)l * DM * PLE, DM / 32, scr, r, lane, IdMap());
    }
    { bf16* XB = (bf16*)(ws + WS_XB0); ss_t* ss = (ss_t*)(ws + WS_STATS) + (size_t)SS_IN * M;
      for (int m0 = gw; m0 < M; m0 += 2 * NGW) { f32x4 v[2][4];
#pragma unroll
          for (int u = 0; u < 2; ++u) { const int mr = m0 + u * NGW; if (mr < M) { const GAS f32x4* xr = (const GAS f32x4*)(a->x + (size_t)mr * DM) + lane;
#pragma unroll
              for (int j = 0; j < 4; ++j) v[u][j] = xr[64 * j]; } }
#pragma unroll
          for (int u = 0; u < 2; ++u) { const int mr = m0 + u * NGW; if (mr < M) { GAS u32x2* o8 = (GAS u32x2*)(XB + (size_t)mr * DM) + lane; float s = 0.f;
#pragma unroll
              for (int j = 0; j < 4; ++j) { u32x2 w; w.x = pk2(v[u][j].x, v[u][j].y); w.y = pk2(v[u][j].z, v[u][j].w); o8[64 * j] = w;
                  const float a0 = bflo(w.x), a1 = bfhi(w.x), a2 = bflo(w.y), a3 = bfhi(w.y); s += (a0 * a0 + a1 * a1) + (a2 * a2 + a3 * a3); }
              s = wave_sum(s); if (lane == 0) ss[mr] = (ss_t)(long long)(s * 16777216.0f); } } } }
    { const size_t n8 = (size_t)DEPTH * M * PLE / 8; bf16* PB = (bf16*)a->out;
      for (size_t i0 = (size_t)gw * 64 + lane; i0 < n8; i0 += (size_t)NGW * 64 * 4) { f32x4 v0[4], v1[4];
#pragma unroll
          for (int u = 0; u < 4; ++u) { const size_t i = i0 + (size_t)u * NGW * 64; if (i < n8) { v0[u] = *(const GAS f32x4*)(a->p + i * 8); v1[u] = *(const GAS f32x4*)(a->p + i * 8 + 4); } }
#pragma unroll
          for (int u = 0; u < 4; ++u) { const size_t i = i0 + (size_t)u * NGW * 64; if (i < n8) { v4u w; w.x = pk2(v0[u].x, v0[u].y); w.y = pk2(v0[u].z, v0[u].w); w.z = pk2(v1[u].x, v1[u].y); w.w = pk2(v1[u].z, v1[u].w);
              const size_t l_ = i / ((size_t)M * 32), rem_ = i % ((size_t)M * 32), m_ = rem_ >> 5, k8_ = rem_ & 31; *(GAS v4u*)(PB + m_ * 2048 + l_ * 256 + k8_ * 8) = w; } } } }
    { float* rope = (float*)(ws + WS_ROPE);
      for (int i = gw * 64 + lane; i < M * 8; i += NGW * 64) { const int m = i >> 3, f = i & 7; double rev = (double)a->pos[m] * a->rope_rev[f]; rev -= __builtin_floor(rev); const float fr = (float)rev;
          rope[2 * i] = __builtin_amdgcn_cosf(fr); rope[2 * i + 1] = __builtin_amdgcn_sinf(fr); } }
    { float* by = (float*)(ws + WS_BIASY); YMap ym;
      for (int i = gw * 64 + lane; i < DEPTH * NY; i += NGW * 64) { const int l = i / NY, c = i % NY, s = ym(c); by[i] = s >= 0 ? a->b_in[l * INW + s] : 0.f; } }
}

__device__ __forceinline__ bf16x8 ld_frag(const LAS bf16* tile, int ld, int r0, int k0, int lane) { return *(const LAS bf16x8*)(tile + (r0 + (lane & 15)) * ld + k0 + 8 * (lane >> 4)); }
template <int K>
__device__ __forceinline__ f32x4 mma_tile(f32x4 acc, const LAS bf16* A, int lda, int r0, const LAS bf16* Bt, int ldb, int c0, int lane) {
#pragma unroll
    for (int k0 = 0; k0 < K; k0 += 32) acc = __builtin_amdgcn_mfma_f32_16x16x32_bf16(ld_frag(A, lda, r0, k0, lane), ld_frag(Bt, ldb, c0, k0, lane), acc, 0, 0, 0);
    return acc;
}
typedef short v4i16_t __attribute__((ext_vector_type(4)));
__device__ __forceinline__ bf16x8 ld_frag_tr(const LAS bf16* tile, int ld, int k0, int c0, int lane) {
    const int g = lane >> 4, q = (lane >> 2) & 3, p = lane & 3;
    const LAS bf16* p0 = tile + (k0 + 8 * g + q) * ld + c0 + 4 * p;
    const v4i16_t lo = __builtin_amdgcn_ds_read_tr16_b64_v4i16((LAS v4i16_t*)p0), hi = __builtin_amdgcn_ds_read_tr16_b64_v4i16((LAS v4i16_t*)(p0 + 4 * ld));
    return (bf16x8){lo[0], lo[1], lo[2], lo[3], hi[0], hi[1], hi[2], hi[3]};
}
template <int K>
__device__ __forceinline__ f32x4 mma_tile_nt(f32x4 acc, const LAS bf16* A, int lda, int r0, const LAS bf16* T, int ldt, int c0, int lane) {
#pragma unroll
    for (int k0 = 0; k0 < K; k0 += 32) acc = __builtin_amdgcn_mfma_f32_16x16x32_bf16(ld_frag(A, lda, r0, k0, lane), ld_frag_tr(T, ldt, k0, c0, lane), acc, 0, 0, 0);
    return acc;
}
template <int K>
__device__ __forceinline__ f32x4 mma_tile_tt(f32x4 acc, const LAS bf16* TA, int lda, int r0, const LAS bf16* TB, int ldb, int c0, int lane) {
#pragma unroll
    for (int k0 = 0; k0 < K; k0 += 32) acc = __builtin_amdgcn_mfma_f32_16x16x32_bf16(ld_frag_tr(TA, lda, k0, r0, lane), ld_frag_tr(TB, ldb, k0, c0, lane), acc, 0, 0, 0);
    return acc;
}
typedef float f32x2_t __attribute__((ext_vector_type(2))); typedef __bf16 bf16x2_t __attribute__((ext_vector_type(2)));
__device__ __forceinline__ unsigned cvtpk(float lo, float hi) { const f32x2_t v = {lo, hi}; return __builtin_bit_cast(unsigned, __builtin_convertvector(v, bf16x2_t)); }
__device__ __forceinline__ bf16 hbf(float x) { return (bf16)cvtpk(x, x); }
template <int CTRL> __device__ __forceinline__ float dpp_f(float v) { return __builtin_bit_cast(float, __builtin_amdgcn_mov_dpp(__builtin_bit_cast(int, v), CTRL, 0xF, 0xF, true)); }
template <int CTRL, int ROWMASK> __device__ __forceinline__ float dpp_id(float v, float ident) { return __builtin_bit_cast(float, __builtin_amdgcn_update_dpp(__builtin_bit_cast(int, ident), __builtin_bit_cast(int, v), CTRL, ROWMASK, 0xF, false)); }
__device__ __forceinline__ float red8_sum(float v) { v += dpp_f<0xB1>(v); v += dpp_f<0x4E>(v); v += dpp_f<0x141>(v); return v; }
__device__ __forceinline__ float red16_sum(float v) { v = red8_sum(v); v += dpp_f<0x140>(v); return v; }
__device__ __forceinline__ float red16_max(float v) { v = fmaxf(v, dpp_f<0xB1>(v)); v = fmaxf(v, dpp_f<0x4E>(v)); v = fmaxf(v, dpp_f<0x141>(v)); v = fmaxf(v, dpp_f<0x140>(v)); return v; }
__device__ __forceinline__ float xor16_partner(float x, int lane) { auto r = __builtin_amdgcn_permlane16_swap(__float_as_uint(x), __float_as_uint(x), false, false); return __uint_as_float((lane & 16) ? r[0] : r[1]); }
__device__ __forceinline__ float red_x16x32_sum(float x) { auto r = __builtin_amdgcn_permlane16_swap(__float_as_uint(x), __float_as_uint(x), false, false); x = __uint_as_float(r[0]) + __uint_as_float(r[1]);
    auto q = __builtin_amdgcn_permlane32_swap(__float_as_uint(x), __float_as_uint(x), false, false); return __uint_as_float(q[0]) + __uint_as_float(q[1]); }
__device__ __forceinline__ float scan_add(float v, int) { v += dpp_id<0x111, 0xF>(v, 0.f); v += dpp_id<0x112, 0xF>(v, 0.f); v += dpp_id<0x114, 0xF>(v, 0.f); v += dpp_id<0x118, 0xF>(v, 0.f); v += dpp_id<0x142, 0xA>(v, 0.f); v += dpp_id<0x143, 0xC>(v, 0.f); return v; }
__device__ __forceinline__ float scan_max(float v, int) { const float ni = -INFINITY; v = fmaxf(v, dpp_id<0x111, 0xF>(v, ni)); v = fmaxf(v, dpp_id<0x112, 0xF>(v, ni)); v = fmaxf(v, dpp_id<0x114, 0xF>(v, ni)); v = fmaxf(v, dpp_id<0x118, 0xF>(v, ni));
    v = fmaxf(v, dpp_id<0x142, 0xA>(v, ni)); v = fmaxf(v, dpp_id<0x143, 0xC>(v, ni)); return v; }
#define LBAR() asm volatile("s_waitcnt lgkmcnt(0)\n\ts_barrier" ::: "memory")
__device__ __forceinline__ float fexp(float x) { return __builtin_amdgcn_exp2f(x * 1.4426950408889634f); }
__device__ __forceinline__ float frcp(float x) { return __builtin_amdgcn_rcpf(x); }
__device__ __forceinline__ float fsig(float x) { return frcp(1.f + fexp(-x)); }

__device__ __forceinline__ void mlstm_task(const Frame& F, ArgsP a, int layer, int bh) {
    const int tid_ = F.wave * 64 + lane_id(); const int b = bh >> 2, h = bh & 3, tid = tid_, lane = tid & 63, w = F.wave;
    const bf16* Y = (const bf16*)(a->ws + WS_BIG) + (size_t)b * (Y_BLK / 2); bf16* MIX = (bf16*)(a->ws + WS_MIX) + (size_t)b * (MIX_BLK / 2);
    constexpr int LD = 72, TILE = 64 * LD, CTSZ = 80 * LD;
    LAS bf16* tiles = (LAS bf16*)(F.lds);
    LAS bf16* ctsb = tiles + 8 * TILE;
    LAS float* arr = (LAS float*)(ctsb + 2 * CTSZ);
    LAS float* cw = arr + 3 * 400;
#define MT(p_, k_) (tiles + ((p_) * 4 + (k_)) * TILE)
    const int j = tid >> 3, d8 = (tid & 7) * 8;
    for (int i = tid; i < 2 * CTSZ; i += 512) ctsb[i] = 0;
    if (tid < 64) { cw[512 + tid] = a->conv_b[layer * 512 + h * 64 + tid]; cw[576 + tid] = a->conv_b[layer * 512 + 256 + h * 64 + tid]; }
    if (tid < 256) { const int tap = tid >> 6, d = tid & 63; cw[tap * 64 + d] = a->conv_w[(layer * 4 + tap) * 512 + h * 64 + d]; cw[256 + tap * 64 + d] = a->conv_w[(layer * 4 + tap) * 512 + 256 + h * 64 + d]; }
    const float fbias = a->mlstm_f_bias[layer * 4 + h];
    const int cl = lane & 15, g = lane >> 4;
    float gnr[16];
#pragma unroll
    for (int et = 0; et < 4; ++et)
#pragma unroll
        for (int i = 0; i < 4; ++i) gnr[et * 4 + i] = a->mlstm_norm_g[layer * 256 + h * 64 + 16 * et + 4 * g + i];
    f32x4 Ct[5];
#pragma unroll
    for (int et = 0; et < 5; ++et) Ct[et] = (f32x4){0.f, 0.f, 0.f, 0.f};
    float mcar = 0.f;
    u32x4 rq[4], rk[4], rv; u32x2 rog[4]; unsigned short rgi = 0, rgf = 0;
    const u32x4 zero4 = {0u, 0u, 0u, 0u};
#define MLSTM_LOAD(c_) do { const int t_ = (c_) * 64 + j; const bf16* yr_ = Y + ((size_t)b * SEQ + t_) * NY; \
        _Pragma("unroll") for (int tap = 0; tap < 4; ++tap) { if (t_ - 3 + tap >= 0) { rq[tap] = *(const u32x4*)(yr_ + (tap - 3) * NY + YC_MQ + h * 64 + d8); rk[tap] = *(const u32x4*)(yr_ + (tap - 3) * NY + YC_MK + h * 64 + d8); } else { rq[tap] = zero4; rk[tap] = zero4; } } \
        rv = *(const u32x4*)(yr_ + YC_MV + h * 64 + d8); } while (0)
#define MLSTM_LOAD_NC(c_) do { const int t_ = (c_) * 64 + j; const bf16* yr_ = Y + ((size_t)b * SEQ + t_) * NY; \
        _Pragma("unroll") for (int tap = 0; tap < 4; ++tap) { rq[tap] = *(const u32x4*)(yr_ + (tap - 3) * NY + YC_MQ + h * 64 + d8); rk[tap] = *(const u32x4*)(yr_ + (tap - 3) * NY + YC_MK + h * 64 + d8); } \
        rv = *(const u32x4*)(yr_ + YC_MV + h * 64 + d8); } while (0)
#define MLSTM_LOAD_OG(c_) do { const bf16* yo_ = Y + ((size_t)b * SEQ + (c_) * 64 + 16 * (w & 3) + cl) * NY + YC_MO + h * 64 + 4 * g; \
        _Pragma("unroll") for (int et = 0; et < 4; ++et) rog[et] = *(const u32x2*)(yo_ + 16 * et); } while (0)
#define MLSTM_LOAD_G(c_) do { const bf16* yl_ = Y + ((size_t)b * SEQ + (c_) * 64 + lane) * NY; rgi = yl_[YC_MI + h]; rgf = yl_[YC_MF + h]; } while (0)
#define MLSTM_SCAN(c_) do { LAS float* A_ = arr + ((c_) % 3) * 400; const float ip_ = bf2f(rgi), lf_ = logsigmoid_f(bf2f(rgf) + fbias); const float bc_ = scan_add(lf_, lane), g_ = ip_ - bc_, cm_ = scan_max(g_, lane), av_ = fmaxf(mcar, cm_); \
        const float a63_ = __builtin_bit_cast(float, __builtin_amdgcn_readlane(__builtin_bit_cast(int, av_), 63)), b63_ = __builtin_bit_cast(float, __builtin_amdgcn_readlane(__builtin_bit_cast(int, bc_), 63)); \
        A_[lane] = av_; A_[64 + lane] = g_; A_[128 + lane] = fexp(mcar - av_); A_[192 + lane] = fexp(-(bc_ + av_)); A_[256 + lane] = fexp(g_ - a63_); if (lane == 0) A_[320] = fexp(mcar - a63_); mcar = b63_ + a63_; } while (0)
#define MLSTM_BUILD(c_, p_) do { const LAS float* A_ = arr + ((c_) % 3) * 400; float qa[8], ka[8]; \
        _Pragma("unroll") for (int i = 0; i < 8; ++i) { qa[i] = cw[512 + d8 + i]; ka[i] = cw[576 + d8 + i]; } \
        _Pragma("unroll") for (int tap = 0; tap < 4; ++tap) { f32x4 q0, q1, k0, k1; pg8::unpack8(rq[tap], q0, q1); pg8::unpack8(rk[tap], k0, k1); \
            _Pragma("unroll") for (int i = 0; i < 4; ++i) { qa[i] += cw[tap * 64 + d8 + i] * q0[i]; qa[4 + i] += cw[tap * 64 + d8 + 4 + i] * q1[i]; ka[i] += cw[256 + tap * 64 + d8 + i] * k0[i]; ka[4 + i] += cw[256 + tap * 64 + d8 + 4 + i] * k1[i]; } } \
        f32x4 q0, q1, k0, k1, kw0, kw1; const float wsj = A_[256 + j]; \
        _Pragma("unroll") for (int i = 0; i < 4; ++i) { q0[i] = qa[i] * fsig(qa[i]); q1[i] = qa[4 + i] * fsig(qa[4 + i]); k0[i] = ka[i] * fsig(ka[i]) * 0.125f; k1[i] = ka[4 + i] * fsig(ka[4 + i]) * 0.125f; kw0[i] = k0[i] * wsj; kw1[i] = k1[i] * wsj; } \
        *(LAS u32x4*)(MT(p_, 0) + j * LD + d8) = pg8::pack8(q0, q1); *(LAS u32x4*)(MT(p_, 1) + j * LD + d8) = pg8::pack8(k0, k1); *(LAS u32x4*)(MT(p_, 2) + j * LD + d8) = pg8::pack8(kw0, kw1); *(LAS u32x4*)(MT(p_, 3) + j * LD + d8) = rv; } while (0)
    { const int t_ = j; const bf16* yb_ = Y + (size_t)b * SEQ * NY;
#pragma unroll
      for (int tap = 0; tap < 4; ++tap) { const bf16* yr_ = yb_ + (size_t)max(t_ - 3 + tap, 0) * NY; rq[tap] = *(const u32x4*)(yr_ + YC_MQ + h * 64 + d8); rk[tap] = *(const u32x4*)(yr_ + YC_MK + h * 64 + d8); }
      rv = *(const u32x4*)(yb_ + (size_t)t_ * NY + YC_MV + h * 64 + d8);
#pragma unroll
      for (int tap = 0; tap < 4; ++tap) if (t_ - 3 + tap < 0) { rq[tap] = zero4; rk[tap] = zero4; } }
    MLSTM_LOAD_G(0); if (w == 4) MLSTM_SCAN(0);
    MLSTM_LOAD_G(1); if (w == 4) MLSTM_SCAN(1);
    LBAR();
    MLSTM_BUILD(0, 0);
    MLSTM_LOAD_NC(1);
    MLSTM_LOAD_G(2);
    LBAR();
    for (int c = 0; c < SEQ / 64; ++c) {
        const int p = c & 1;
        if (c + 1 < SEQ / 64) MLSTM_BUILD(c + 1, p ^ 1);
        MLSTM_LOAD_NC(min(c + 2, SEQ / 64 - 1)); MLSTM_LOAD_OG(c);
        asm volatile("" ::: "memory");
        const LAS float* A3 = arr + (c % 3) * 400;
        if (w < 4) {
            const int jt = w, jq = 16 * jt + cl; const LAS bf16* Qp = MT(p, 0); const LAS bf16* Kp = MT(p, 1); const LAS bf16* Vp = MT(p, 3); const LAS bf16* Cp = ctsb + p * CTSZ;
            const float aj = A3[jq], wj = A3[128 + jq], ej = A3[192 + jq];
            const bf16x8 qb0 = ld_frag(Qp, LD, 16 * jt, 0, lane), qb1 = ld_frag(Qp, LD, 16 * jt, 32, lane);
            f32x4 pt[4]; float dsum = 0.f;
#pragma unroll
            for (int st = 0; st < 4; ++st) { pt[st] = (f32x4){0.f, 0.f, 0.f, 0.f};
                if (st <= jt) { f32x4 s_ = (f32x4){0.f, 0.f, 0.f, 0.f};
                    s_ = __builtin_amdgcn_mfma_f32_16x16x32_bf16(ld_frag(Kp, LD, 16 * st, 0, lane), qb0, s_, 0, 0, 0); s_ = __builtin_amdgcn_mfma_f32_16x16x32_bf16(ld_frag(Kp, LD, 16 * st, 32, lane), qb1, s_, 0, 0, 0);
                    const f32x4 gs = *(const LAS f32x4*)(A3 + 64 + 16 * st + 4 * g);
#pragma unroll
                    for (int i = 0; i < 4; ++i) { const bool ok = (st < jt) || (4 * g + i <= cl); const float pv = ok ? s_[i] * fexp(gs[i] - aj) : 0.f; pt[st][i] = pv; dsum += pv; } } }
            bf16x8 pf[2];
#pragma unroll
            for (int t = 0; t < 2; ++t) { u32x4 pw; pw.x = cvtpk(pt[2 * t][0], pt[2 * t][1]); pw.y = cvtpk(pt[2 * t][2], pt[2 * t][3]); pw.z = cvtpk(pt[2 * t + 1][0], pt[2 * t + 1][1]); pw.w = cvtpk(pt[2 * t + 1][2], pt[2 * t + 1][3]); pf[t] = __builtin_bit_cast(bf16x8, pw); }
            f32x4 acc[5];
#pragma unroll
            for (int et = 0; et < 5; ++et) { acc[et] = (f32x4){0.f, 0.f, 0.f, 0.f}; acc[et] = __builtin_amdgcn_mfma_f32_16x16x32_bf16(ld_frag(Cp, LD, 16 * et, 0, lane), qb0, acc[et], 0, 0, 0); acc[et] = __builtin_amdgcn_mfma_f32_16x16x32_bf16(ld_frag(Cp, LD, 16 * et, 32, lane), qb1, acc[et], 0, 0, 0); }
            const float qn = red_x16x32_sum(acc[4][0]);
#pragma unroll
            for (int et = 0; et < 4; ++et) acc[et] = acc[et] * wj;
            { const int tq = (lane >> 2) & 3, tp = lane & 3;
#pragma unroll
              for (int t = 0; t < 2; ++t) { if (2 * t <= jt) { const LAS bf16* vb = Vp + (32 * t + 4 * g + tq) * LD + 4 * tp;
#pragma unroll
                  for (int et = 0; et < 4; ++et) { const v4i16_t lo = __builtin_amdgcn_ds_read_tr16_b64_v4i16((LAS v4i16_t*)(vb + 16 * et)), hi = __builtin_amdgcn_ds_read_tr16_b64_v4i16((LAS v4i16_t*)(vb + 16 * LD + 16 * et));
                      const bf16x8 vf = {lo[0], lo[1], lo[2], lo[3], hi[0], hi[1], hi[2], hi[3]}; acc[et] = __builtin_amdgcn_mfma_f32_16x16x32_bf16(vf, pf[t], acc[et], 0, 0, 0); } } } }
            const float den = red_x16x32_sum(dsum) + wj * qn; const float rinv = frcp(fmaxf(fabsf(den), ej));
            float ss = 0.f;
#pragma unroll
            for (int et = 0; et < 4; ++et) { acc[et] = acc[et] * rinv; ss += (acc[et][0] * acc[et][0] + acc[et][1] * acc[et][1]) + (acc[et][2] * acc[et][2] + acc[et][3] * acc[et][3]); }
            ss = red_x16x32_sum(ss); const float rs = rsqrtf(ss * (1.0f / 64.0f) + EPS);
            bf16* orow = MIX + ((size_t)b * SEQ + c * 64 + jq) * DM + h * 64 + 4 * g;
#pragma unroll
            for (int et = 0; et < 4; ++et) { const float o0 = bflo(rog[et].x), o1 = bfhi(rog[et].x), o2 = bflo(rog[et].y), o3 = bfhi(rog[et].y); u32x2 ov;
                ov.x = cvtpk(acc[et][0] * rs * gnr[4 * et] * fsig(o0), acc[et][1] * rs * gnr[4 * et + 1] * fsig(o1)); ov.y = cvtpk(acc[et][2] * rs * gnr[4 * et + 2] * fsig(o2), acc[et][3] * rs * gnr[4 * et + 3] * fsig(o3));
                *(u32x2*)(orow + 16 * et) = ov; }
        } else {
            const int dt = w - 4; const LAS bf16* Vp = MT(p, 3); const LAS bf16* Kwp = MT(p, 2); const float decay = A3[320];
            const unsigned one8 = (cl == 0) ? 0x3f803f80u : 0u; const u32x4 onew = {one8, one8, one8, one8}; const bf16x8 onesf = __builtin_bit_cast(bf16x8, onew);
            const bf16x8 kb0 = ld_frag_tr(Kwp, LD, 0, 16 * dt, lane), kb1 = ld_frag_tr(Kwp, LD, 32, 16 * dt, lane);
#pragma unroll
            for (int et = 0; et < 5; ++et) { Ct[et] = Ct[et] * decay;
                const bf16x8 va0 = (et < 4) ? ld_frag_tr(Vp, LD, 0, 16 * et, lane) : onesf, va1 = (et < 4) ? ld_frag_tr(Vp, LD, 32, 16 * et, lane) : onesf;
                Ct[et] = __builtin_amdgcn_mfma_f32_16x16x32_bf16(va0, kb0, Ct[et], 0, 0, 0); Ct[et] = __builtin_amdgcn_mfma_f32_16x16x32_bf16(va1, kb1, Ct[et], 0, 0, 0); }
            { LAS bf16* Cn = ctsb + (p ^ 1) * CTSZ;
#pragma unroll
              for (int et = 0; et < 4; ++et)
#pragma unroll
                  for (int i = 0; i < 4; ++i) Cn[(16 * et + 4 * g + i) * LD + 16 * dt + cl] = hbf(Ct[et][i]);
              if (g == 0) Cn[64 * LD + 16 * dt + cl] = hbf(Ct[4][0]); }
            if (w == 4 && c + 2 < SEQ / 64) MLSTM_SCAN(c + 2);
        }
        MLSTM_LOAD_G(min(c + 3, SEQ / 64 - 1));
        LBAR();
    }
#undef MLSTM_LOAD_NC
#undef MT
#undef MLSTM_LOAD
#undef MLSTM_LOAD_OG
#undef MLSTM_LOAD_G
#undef MLSTM_SCAN
#undef MLSTM_BUILD
}

__device__ __forceinline__ void hgrn_task(const Frame& F, ArgsP a, int layer, int bh) {
    const int tid_ = F.wave * 64 + lane_id(); const int b = bh >> 2, h = bh & 3, tid = tid_, lane = tid & 63, w = F.wave;
    const bf16* Y = (const bf16*)(a->ws + WS_BIG) + (size_t)b * (Y_BLK / 2); bf16* MIX = (bf16*)(a->ws + WS_MIX) + (size_t)b * (MIX_BLK / 2);
    constexpr int LD = 72, TILE = 64 * LD;
    LAS bf16* tiles = (LAS bf16*)(F.lds);
    LAS bf16* stb = tiles + 12 * TILE;
    LAS float* part = (LAS float*)(stb + 2 * TILE);
    LAS float* egb = part + 2 * 1024;
#define HT(p_, k_) (tiles + ((p_) * 6 + (k_)) * TILE)
    const int dp = tid & 31, d0 = 2 * dp, rgrp = tid >> 5, cl = lane & 15, g = lane >> 4;
    float lbv[2], omlv[2];
#pragma unroll
    for (int ch = 0; ch < 2; ++ch) { const int cidx = h * 64 + d0 + ch; float z[4]; float zm = -INFINITY;
#pragma unroll
      for (int q = 0; q < 4; ++q) { z[q] = a->hgrn_lb_logits[q * 256 + cidx]; zm = fmaxf(zm, z[q]); }
      float e[4], es = 0.f;
#pragma unroll
      for (int q = 0; q < 4; ++q) { e[q] = expf(z[q] - zm); es += e[q]; }
      float cum = 0.f, lb = 0.f;
#pragma unroll
      for (int q = 0; q < 4; ++q) { cum += e[q] / es; if (q == layer) lb = cum; }
      lb -= e[0] / es; if (layer == 0) lb = 0.f;
      lbv[ch] = lb; omlv[ch] = 1.f - lb; }
    for (int i = tid; i < 2 * TILE; i += 512) stb[i] = 0;
    float gnr[16];
#pragma unroll
    for (int et = 0; et < 4; ++et)
#pragma unroll
        for (int i = 0; i < 4; ++i) gnr[et * 4 + i] = a->hgrn_norm_g[layer * 256 + h * 64 + 16 * et + 4 * g + i];
    f32x4 Sr[4];
#pragma unroll
    for (int et = 0; et < 4; ++et) Sr[et] = (f32x4){0.f, 0.f, 0.f, 0.f};
    unsigned rq[4], rf[4], rv[4]; u32x2 rgt[4];
    float qf[4][2], ky[4][2], cs[4][2]; unsigned vraw[4];
#define HGRN_LOAD(c_) do { const bf16* yb_ = Y + ((size_t)b * SEQ + (c_) * 64 + 4 * rgrp) * NY + h * 64 + d0; \
        _Pragma("unroll") for (int r = 0; r < 4; ++r) { rq[r] = *(const unsigned*)(yb_ + r * NY + YC_HQ); rf[r] = *(const unsigned*)(yb_ + r * NY + YC_HF); rv[r] = *(const unsigned*)(yb_ + r * NY + YC_HI); } } while (0)
#define HGRN_LOAD_GATE(c_) do { const bf16* yo_ = Y + ((size_t)b * SEQ + (c_) * 64 + 16 * w + cl) * NY + YC_HG + h * 64 + 4 * g; \
        _Pragma("unroll") for (int et = 0; et < 4; ++et) rgt[et] = *(const u32x2*)(yo_ + 16 * et); } while (0)
#define HGRN_A1(c_) do { float run0 = 0.f, run1 = 0.f; \
        _Pragma("unroll") for (int r = 0; r < 4; ++r) { vraw[r] = rv[r]; \
            { const float qv = bflo(rq[r]), fv = fmaxf(bflo(rf[r]), -80.f); qf[r][0] = qv * fsig(qv); const float t = fexp(-fv), sf = frcp(1.f + t); ky[r][0] = omlv[0] * t * sf; run0 += __builtin_amdgcn_logf(lbv[0] + omlv[0] * sf); cs[r][0] = run0; } \
            { const float qv = bfhi(rq[r]), fv = fmaxf(bfhi(rf[r]), -80.f); qf[r][1] = qv * fsig(qv); const float t = fexp(-fv), sf = frcp(1.f + t); ky[r][1] = omlv[1] * t * sf; run1 += __builtin_amdgcn_logf(lbv[1] + omlv[1] * sf); cs[r][1] = run1; } } \
        *(LAS f32x2_t*)(part + ((c_) & 1) * 1024 + rgrp * 64 + d0) = (f32x2_t){run0, run1}; } while (0)
#define HGRN_TILES(c_, p_) do { const LAS float* P_ = part + ((c_) & 1) * 1024 + d0; f32x2_t pco[8]; f32x2_t acc_ = {0.f, 0.f}, pre = {0.f, 0.f}; \
        _Pragma("unroll") for (int q = 0; q < 16; ++q) { if (q == rgrp) pre = acc_; acc_ += *(const LAS f32x2_t*)(P_ + q * 64); if (q & 1) pco[q >> 1] = acc_; }        \
        const f32x2_t g31 = pco[3], g63 = pco[7], gmid = (rgrp < 8) ? pco[1] : pco[5]; \
        _Pragma("unroll") for (int r = 0; r < 4; ++r) { const int l = 4 * rgrp + r; float vqt[2], vxa[2], vqc[2], vkc[2], vkr[2]; \
            _Pragma("unroll") for (int ch = 0; ch < 2; ++ch) { const float G = pre[ch] + cs[r][ch]; \
                vqt[ch] = qf[r][ch] * __builtin_amdgcn_exp2f(G); vkr[ch] = ky[r][ch] * __builtin_amdgcn_exp2f(g63[ch] - G); \
                vxa[ch] = (rgrp < 8) ? ky[r][ch] * __builtin_amdgcn_exp2f(g31[ch] - G) : qf[r][ch] * __builtin_amdgcn_exp2f(G - g31[ch]); \
                const float dm = fminf(fmaxf(G - gmid[ch], -86.f), 86.f); vqc[ch] = qf[r][ch] * __builtin_amdgcn_exp2f(dm); vkc[ch] = ky[r][ch] * __builtin_amdgcn_exp2f(-dm); } \
            *(LAS unsigned*)(HT(p_, 0) + l * LD + d0) = cvtpk(vqt[0], vqt[1]); *(LAS unsigned*)(HT(p_, 1) + l * LD + d0) = cvtpk(vxa[0], vxa[1]); *(LAS unsigned*)(HT(p_, 2) + l * LD + d0) = cvtpk(vqc[0], vqc[1]); \
            *(LAS unsigned*)(HT(p_, 3) + l * LD + d0) = cvtpk(vkc[0], vkc[1]); *(LAS unsigned*)(HT(p_, 4) + l * LD + d0) = cvtpk(vkr[0], vkr[1]); *(LAS unsigned*)(HT(p_, 5) + l * LD + d0) = vraw[r]; } \
        if (rgrp == 0) *(LAS f32x2_t*)(egb + ((c_) & 1) * 64 + d0) = (f32x2_t){__builtin_amdgcn_exp2f(g63[0]), __builtin_amdgcn_exp2f(g63[1])}; } while (0)
    HGRN_LOAD(0); HGRN_A1(0); HGRN_LOAD(1);
    if (w < 4) HGRN_LOAD_GATE(0);
    LBAR();
    HGRN_TILES(0, 0); HGRN_A1(1); HGRN_LOAD(2);
    LBAR();
    for (int c = 0; c < SEQ / 64; ++c) {
        const int p = c & 1;
        if (c + 1 < SEQ / 64) HGRN_TILES(c + 1, p ^ 1);
        if (c + 2 < SEQ / 64) { HGRN_A1(c + 2); if (c + 3 < SEQ / 64) HGRN_LOAD(c + 3); }
        if (w < 4) {
            const int rt = w; const LAS bf16* QTp = HT(p, 0); const LAS bf16* XAp = HT(p, 1); const LAS bf16* QCp = HT(p, 2); const LAS bf16* KCp = HT(p, 3); const LAS bf16* VRp = HT(p, 5); const LAS bf16* Sp = stb + p * TILE;
            f32x4 at[4];
#pragma unroll
            for (int st = 0; st < 4; ++st) { at[st] = (f32x4){0.f, 0.f, 0.f, 0.f};
                if (st <= rt) { const bool same = ((st >> 1) == (rt >> 1)); const LAS bf16* Aop = same ? KCp : XAp; const LAS bf16* Bop = same ? QCp : XAp;
                    f32x4 s_ = (f32x4){0.f, 0.f, 0.f, 0.f}; s_ = mma_tile<64>(s_, Aop, LD, 16 * st, Bop, LD, 16 * rt, lane);
#pragma unroll
                    for (int i = 0; i < 4; ++i) at[st][i] = ((st < rt) || (4 * g + i <= cl)) ? s_[i] : 0.f; } }
            bf16x8 pf[2];
#pragma unroll
            for (int t = 0; t < 2; ++t) { u32x4 pw; pw.x = cvtpk(at[2 * t][0], at[2 * t][1]); pw.y = cvtpk(at[2 * t][2], at[2 * t][3]); pw.z = cvtpk(at[2 * t + 1][0], at[2 * t + 1][1]); pw.w = cvtpk(at[2 * t + 1][2], at[2 * t + 1][3]); pf[t] = __builtin_bit_cast(bf16x8, pw); }
            f32x4 acc[4];
            { const bf16x8 qb0 = ld_frag(QTp, LD, 16 * rt, 0, lane), qb1 = ld_frag(QTp, LD, 16 * rt, 32, lane);
#pragma unroll
              for (int et = 0; et < 4; ++et) { acc[et] = (f32x4){0.f, 0.f, 0.f, 0.f}; acc[et] = __builtin_amdgcn_mfma_f32_16x16x32_bf16(ld_frag(Sp, LD, 16 * et, 0, lane), qb0, acc[et], 0, 0, 0); acc[et] = __builtin_amdgcn_mfma_f32_16x16x32_bf16(ld_frag(Sp, LD, 16 * et, 32, lane), qb1, acc[et], 0, 0, 0); } }
            { const int tq = (lane >> 2) & 3, tp = lane & 3;
#pragma unroll
              for (int t = 0; t < 2; ++t) { if (2 * t <= rt) { const LAS bf16* vb = VRp + (32 * t + 4 * g + tq) * LD + 4 * tp;
#pragma unroll
                  for (int et = 0; et < 4; ++et) { const v4i16_t lo = __builtin_amdgcn_ds_read_tr16_b64_v4i16((LAS v4i16_t*)(vb + 16 * et)), hi = __builtin_amdgcn_ds_read_tr16_b64_v4i16((LAS v4i16_t*)(vb + 16 * LD + 16 * et));
                      const bf16x8 vf = {lo[0], lo[1], lo[2], lo[3], hi[0], hi[1], hi[2], hi[3]}; acc[et] = __builtin_amdgcn_mfma_f32_16x16x32_bf16(vf, pf[t], acc[et], 0, 0, 0); } } } }
            float ss = 0.f;
#pragma unroll
            for (int et = 0; et < 4; ++et) ss += (acc[et][0] * acc[et][0] + acc[et][1] * acc[et][1]) + (acc[et][2] * acc[et][2] + acc[et][3] * acc[et][3]);
            ss = red_x16x32_sum(ss); const float rs = rsqrtf(ss * (1.0f / 64.0f) + EPS);
            bf16* orow = MIX + ((size_t)b * SEQ + c * 64 + 16 * rt + cl) * DM + 256 + h * 64 + 4 * g;
#pragma unroll
            for (int et = 0; et < 4; ++et) { const float g0 = bflo(rgt[et].x), g1 = bfhi(rgt[et].x), g2 = bflo(rgt[et].y), g3 = bfhi(rgt[et].y); u32x2 ov;
                ov.x = cvtpk(acc[et][0] * rs * gnr[4 * et] * (g0 * fsig(g0)), acc[et][1] * rs * gnr[4 * et + 1] * (g1 * fsig(g1))); ov.y = cvtpk(acc[et][2] * rs * gnr[4 * et + 2] * (g2 * fsig(g2)), acc[et][3] * rs * gnr[4 * et + 3] * (g3 * fsig(g3)));
                *(u32x2*)(orow + 16 * et) = ov; }
            if (c + 1 < SEQ / 64) HGRN_LOAD_GATE(c + 1);
        } else {
            const int dt = w - 4; const LAS bf16* KRp = HT(p, 4); const LAS bf16* VRp = HT(p, 5); const float egd = egb[p * 64 + 16 * dt + cl];
            const bf16x8 kb0 = ld_frag_tr(KRp, LD, 0, 16 * dt, lane), kb1 = ld_frag_tr(KRp, LD, 32, 16 * dt, lane);
            LAS bf16* Sn = stb + (p ^ 1) * TILE;
#pragma unroll
            for (int et = 0; et < 4; ++et) { Sr[et] = Sr[et] * egd; Sr[et] = __builtin_amdgcn_mfma_f32_16x16x32_bf16(ld_frag_tr(VRp, LD, 0, 16 * et, lane), kb0, Sr[et], 0, 0, 0); Sr[et] = __builtin_amdgcn_mfma_f32_16x16x32_bf16(ld_frag_tr(VRp, LD, 32, 16 * et, lane), kb1, Sr[et], 0, 0, 0);
#pragma unroll
                for (int i = 0; i < 4; ++i) Sn[(16 * et + 4 * g + i) * LD + 16 * dt + cl] = hbf(Sr[et][i]); }
        }
        LBAR();
    }
#undef HT
#undef HGRN_LOAD
#undef HGRN_LOAD_GATE
#undef HGRN_A1
#undef HGRN_TILES
}

typedef float f32x16 __attribute__((ext_vector_type(16)));
__device__ __forceinline__ float swap32_sum(float x) { auto q = __builtin_amdgcn_permlane32_swap(__float_as_uint(x), __float_as_uint(x), false, false); return __uint_as_float(q[0]) + __uint_as_float(q[1]); }
__device__ __forceinline__ float swap32_max(float x) { auto q = __builtin_amdgcn_permlane32_swap(__float_as_uint(x), __float_as_uint(x), false, false); return fmaxf(__uint_as_float(q[0]), __uint_as_float(q[1])); }
__device__ __forceinline__ float swap32_partner(float x, int lane) { auto q = __builtin_amdgcn_permlane32_swap(__float_as_uint(x), __float_as_uint(x), false, false); return __uint_as_float((lane & 32) ? q[0] : q[1]); }
__device__ __forceinline__ void swa_loop(const Frame& F, ArgsP a, int layer, gu32* qctr, int ubase, unsigned limit) {
    const int tid_ = F.wave * 64 + lane_id(); const int tid = tid_, lane = tid & 63, w = F.wave;
    const bf16* Y0 = (const bf16*)(a->ws + WS_BIG); bf16* MIX0 = (bf16*)(a->ws + WS_MIX); const float* rope = (const float*)(a->ws + WS_ROPE);
    constexpr int LDK = 72;
    LAS bf16* Ks = (LAS bf16*)(F.lds); LAS bf16* Vs = Ks + 256 * LDK; LAS bf16* St = Vs + 256 * LDK + w * 32 * LDK;
    LAS float* gsh = (LAS float*)(Vs + 256 * LDK + 8 * 32 * LDK);
    volatile LAS unsigned* qslot = (volatile LAS unsigned*)(F.lds + MISC_OFF) + 12;
    const int qq = lane & 31, hh = lane >> 5, kk = tid >> 1, half = tid & 1;
    unsigned nxt_ = 0u;
    if (tid == 0) { *qslot = __hip_atomic_fetch_add(qctr, 1u, __ATOMIC_RELAXED, __HIP_MEMORY_SCOPE_AGENT); }
    if (tid < 64) gsh[tid] = a->swa_k_g[layer * 64 + tid]; else if (tid < 128) gsh[tid] = a->swa_q_g[layer * 64 + tid - 64]; else if (tid < 136) gsh[tid] = a->swa_sinks[layer * 8 + tid - 128];
    __syncthreads(); unsigned cur_u = *qslot; __syncthreads();
    if (cur_u >= limit) return;
    if (tid == 0) nxt_ = __hip_atomic_fetch_add(qctr, 1u, __ATOMIC_RELAXED, __HIP_MEMORY_SCOPE_AGENT);
    u32x4 kraw[4], vraw[4];
#define SWA_PREFETCH(u_) do { const int un_ = ubase + (int)(u_); const int qb_ = un_ & 15, kvh_ = (un_ >> 4) & 1, b_ = un_ >> 5; const int tk_ = max((qb_ - 1) * 128 + kk, 0); \
        { const bf16* yr_ = Y0 + (size_t)b_ * (Y_BLK / 2) + ((size_t)b_ * SEQ + tk_) * NY; \
            _Pragma("unroll") for (int q = 0; q < 4; ++q) { kraw[q] = *(const u32x4*)(yr_ + YC_SK + kvh_ * 64 + 32 * half + 8 * q); vraw[q] = *(const u32x4*)(yr_ + YC_SV + kvh_ * 64 + 32 * half + 8 * q); } } } while (0)
    u32x4 qraw[4]; f32x4 qrope[4];
#define SWA_LOADQ(u_, g_) do { const int un_ = ubase + (int)(u_); const int qb_ = un_ & 15, kvh_ = (un_ >> 4) & 1, b_ = un_ >> 5; \
        const size_t row_ = (size_t)b_ * SEQ + qb_ * 128 + (w & 1) * 64 + (g_) * 32 + qq; const bf16* yr_ = Y0 + (size_t)b_ * (Y_BLK / 2) + row_ * NY + YC_SQ + (kvh_ * 4 + (w >> 1)) * 64 + 8 * hh; \
        _Pragma("unroll") for (int t = 0; t < 4; ++t) { qraw[t] = *(const u32x4*)(yr_ + 16 * t); qrope[t] = *(const f32x4*)(rope + row_ * 16 + 4 * t); } } while (0)
    SWA_PREFETCH(cur_u);
    SWA_LOADQ(cur_u, 0);
    for (;;) {
    const int unit = ubase + (int)cur_u; const int qb = unit & 15, kvh = (unit >> 4) & 1, b = unit >> 5;
    bf16* MIX = MIX0 + (size_t)b * (MIX_BLK / 2);
    const int qh = kvh * 4 + (w >> 1);
    { const int tk = (qb - 1) * 128 + kk; f32x4 cs[4];
      { const size_t row_ = (size_t)b * SEQ + max(tk, 0);
#pragma unroll
        for (int q = 0; q < 4; ++q) cs[q] = *(const f32x4*)(rope + row_ * 16 + 4 * q); }
      asm volatile("" ::: "memory");
      if (tk >= 0) { float x[32];
#pragma unroll
          for (int q = 0; q < 4; ++q) *(LAS u32x4*)(Vs + kk * LDK + 32 * half + 8 * q) = vraw[q];
#pragma unroll
          for (int q = 0; q < 4; ++q) { f32x4 v0, v1; pg8::unpack8(kraw[q], v0, v1);
#pragma unroll
              for (int i = 0; i < 4; ++i) { x[8 * q + i] = v0[i]; x[8 * q + 4 + i] = v1[i]; } }
          float s = 0.f;
#pragma unroll
          for (int i = 0; i < 32; ++i) s += x[i] * x[i];
          s += dpp_f<0xB1>(s); const float rs = rsqrtf(s * (1.0f / 64.0f) + EPS);
#pragma unroll
          for (int q = 0; q < 8; ++q) { const f32x4 gk = *(const LAS f32x4*)(gsh + 32 * half + 4 * q);
#pragma unroll
              for (int i = 0; i < 4; ++i) x[4 * q + i] = x[4 * q + i] * rs * gk[i]; }
          if (half == 0) {
#pragma unroll
              for (int q = 0; q < 4; ++q) {
#pragma unroll
                  for (int e = 0; e < 2; ++e) { const int i = 2 * q + e; const float c_ = cs[q][2 * e], s_ = cs[q][2 * e + 1]; const float x1 = x[i], x2 = x[8 + i]; x[i] = x1 * c_ - x2 * s_; x[8 + i] = x2 * c_ + x1 * s_; } } }
#pragma unroll
          for (int q = 0; q < 4; ++q) { const f32x4 v0 = {x[8 * q], x[8 * q + 1], x[8 * q + 2], x[8 * q + 3]}, v1 = {x[8 * q + 4], x[8 * q + 5], x[8 * q + 6], x[8 * q + 7]}; *(LAS u32x4*)(Ks + kk * LDK + 32 * half + 8 * q) = pg8::pack8(v0, v1); } }
      else { unsigned z0 = 0u; asm volatile("" : "+v"(z0)); const u32x4 z = {z0, z0, z0, z0};
#pragma unroll
          for (int q = 0; q < 4; ++q) { *(LAS u32x4*)(Ks + kk * LDK + 32 * half + 8 * q) = z; *(LAS u32x4*)(Vs + kk * LDK + 32 * half + 8 * q) = z; } } }
    if (tid == 0) *qslot = nxt_;
    __syncthreads();
    const unsigned nxt_u = *qslot;
    const unsigned pf_u = nxt_u < limit ? nxt_u : cur_u;
    if (nxt_u < limit && tid == 0) nxt_ = __hip_atomic_fetch_add(qctr, 1u, __ATOMIC_RELAXED, __HIP_MEMORY_SCOPE_AGENT);
    SWA_PREFETCH(pf_u);
    const float sink2 = gsh[128 + qh] * 1.4426950408889634f;
    const LAS float* gq = gsh + 64;
#pragma unroll
    for (int grp = 0; grp < 2; ++grp) {
        const int q0 = (w & 1) * 64 + grp * 32, T0 = q0 >> 5;
        bf16x8 qf[4];
        { f32x4 v[4][2]; float s = 0.f;
#pragma unroll
          for (int t = 0; t < 4; ++t) { pg8::unpack8(qraw[t], v[t][0], v[t][1]);
#pragma unroll
              for (int i = 0; i < 4; ++i) s += v[t][0][i] * v[t][0][i] + v[t][1][i] * v[t][1][i]; }
          s = swap32_sum(s); const float rs = rsqrtf(s * (1.0f / 64.0f) + EPS) * (0.125f * 1.4426950408889634f);
#pragma unroll
          for (int t = 0; t < 4; ++t) { const f32x4 g0 = *(const LAS f32x4*)(gq + 16 * t + 8 * hh), g1 = *(const LAS f32x4*)(gq + 16 * t + 8 * hh + 4);
#pragma unroll
              for (int i = 0; i < 4; ++i) { v[t][0][i] *= rs * g0[i]; v[t][1][i] *= rs * g1[i]; } }
          { const float cs_[8] = {qrope[0][0], qrope[0][2], qrope[1][0], qrope[1][2], qrope[2][0], qrope[2][2], qrope[3][0], qrope[3][2]};
            const float sn_[8] = {qrope[0][1], qrope[0][3], qrope[1][1], qrope[1][3], qrope[2][1], qrope[2][3], qrope[3][1], qrope[3][3]};
#pragma unroll
            for (int i = 0; i < 4; ++i) { const float p0 = swap32_partner(v[0][0][i], lane), p1 = swap32_partner(v[0][1][i], lane);
                if (hh == 0) { v[0][0][i] = v[0][0][i] * cs_[i] - p0 * sn_[i]; v[0][1][i] = v[0][1][i] * cs_[4 + i] - p1 * sn_[4 + i]; }
                else { v[0][0][i] = v[0][0][i] * cs_[i] + p0 * sn_[i]; v[0][1][i] = v[0][1][i] * cs_[4 + i] + p1 * sn_[4 + i]; } } }
#pragma unroll
          for (int t = 0; t < 4; ++t) qf[t] = __builtin_bit_cast(bf16x8, pg8::pack8(v[t][0], v[t][1])); }
        if (grp == 0) SWA_LOADQ(cur_u, 1); else SWA_LOADQ(pf_u, 0);
        f32x16 x[5];
#pragma unroll
        for (int k = 0; k < 5; ++k) { f32x16 acc = {};
            if (!(qb == 0 && T0 + k < 4)) {
#pragma unroll
                for (int t = 0; t < 4; ++t) acc = __builtin_amdgcn_mfma_f32_32x32x16_bf16(*(const LAS bf16x8*)(Ks + (32 * (T0 + k) + qq) * LDK + 16 * t + 8 * hh), qf[t], acc, 0, 0, 0); }
            x[k] = acc; }
        float mx = sink2;
#pragma unroll
        for (int k = 0; k < 5; ++k) { const bool dead = (qb == 0 && T0 + k < 4);
#pragma unroll
            for (int i = 0; i < 16; ++i) { const int kr = (i & 3) + 8 * (i >> 2) + 4 * hh; bool ok = (k == 0) ? (kr > qq) : ((k == 4) ? (kr <= qq) : true); if (dead) ok = false; if (!ok) x[k][i] = -INFINITY; mx = fmaxf(mx, x[k][i]); } }
        mx = swap32_max(mx);
        float ls = 0.f; f32x16 o[2]; o[0] = (f32x16){}; o[1] = (f32x16){};
#pragma unroll
        for (int k = 0; k < 5; ++k) {
#pragma unroll
            for (int i = 0; i < 16; ++i) { x[k][i] = __builtin_amdgcn_exp2f(x[k][i] - mx); ls += x[k][i]; }
#pragma unroll
            for (int s = 0; s < 2; ++s) { u32x4 pw; pw.x = cvtpk(x[k][8 * s], x[k][8 * s + 1]); pw.y = cvtpk(x[k][8 * s + 2], x[k][8 * s + 3]); pw.z = cvtpk(x[k][8 * s + 4], x[k][8 * s + 5]); pw.w = cvtpk(x[k][8 * s + 6], x[k][8 * s + 7]);
                const bf16x8 pf = __builtin_bit_cast(bf16x8, pw);
                const int gg = lane >> 4, tq = (lane >> 2) & 3, tp = lane & 3; const LAS bf16* vb = Vs + (32 * (T0 + k) + 16 * s + 4 * (gg >> 1) + tq) * LDK + 16 * (gg & 1) + 4 * tp;
#pragma unroll
                for (int et = 0; et < 2; ++et) { const v4i16_t lo = __builtin_amdgcn_ds_read_tr16_b64_v4i16((LAS v4i16_t*)(vb + 32 * et)), hi = __builtin_amdgcn_ds_read_tr16_b64_v4i16((LAS v4i16_t*)(vb + 8 * LDK + 32 * et));
                    const bf16x8 vf = {lo[0], lo[1], lo[2], lo[3], hi[0], hi[1], hi[2], hi[3]};
                    o[et] = __builtin_amdgcn_mfma_f32_32x32x16_bf16(vf, pf, o[et], 0, 0, 0); } } }
        ls = swap32_sum(ls); const float inv = frcp(ls + __builtin_amdgcn_exp2f(sink2 - mx));
#pragma unroll
        for (int et = 0; et < 2; ++et)
#pragma unroll
            for (int blk = 0; blk < 4; ++blk) { u32x2 pv; pv.x = cvtpk(o[et][4 * blk] * inv, o[et][4 * blk + 1] * inv); pv.y = cvtpk(o[et][4 * blk + 2] * inv, o[et][4 * blk + 3] * inv); *(LAS u32x2*)(St + qq * LDK + 32 * et + 8 * blk + 4 * hh) = pv; }
        asm volatile("s_waitcnt lgkmcnt(0)" ::: "memory");
        { const size_t orow = (size_t)b * SEQ + qb * 128 + q0;
#pragma unroll
          for (int it = 0; it < 4; ++it) { const int r = it * 8 + (lane >> 3), ch = lane & 7; const u32x4 v = *(const LAS u32x4*)(St + r * LDK + ch * 8); *(u32x4*)(MIX + (orow + r) * DM + 512 + qh * 64 + ch * 8) = v; } }
        asm volatile("s_waitcnt lgkmcnt(0)" ::: "memory");
    }
    __syncthreads();
    if (nxt_u >= limit) break;
    cur_u = nxt_u;
    }
#undef SWA_PREFETCH
#undef SWA_LOADQ
}
constexpr int N_PHASES = 1 + 6 * DEPTH;
#ifndef REPEAT_PRO
#define REPEAT_PRO 1
#endif
#ifndef REPEAT_HGRN
#define REPEAT_HGRN 1
#endif
#ifndef REPEAT_MLSTM
#define REPEAT_MLSTM 1
#endif
#ifndef REPEAT_SWA
#define REPEAT_SWA 1
#endif
#ifndef EXTRA_BARRIERS
#define EXTRA_BARRIERS 0
#endif
#ifndef REP_IN
#define REP_IN 1
#endif
#ifndef REP_OUT
#define REP_OUT 1
#endif
#ifndef REP_UP
#define REP_UP 1
#endif
#ifndef REP_DOWN
#define REP_DOWN 1
#endif
#ifndef REP_PLE
#define REP_PLE 1
#endif
#ifndef REP_GATE
#define REP_GATE 1
#endif
__device__ __forceinline__ void grp_barrier(unsigned* base  , unsigned x, unsigned sh  ) {
    asm volatile("s_waitcnt vmcnt(0)" ::: "memory");
    __syncthreads();
    if (threadIdx.x == 0) {
        unsigned* ctr = base + CW_LBAR + 128 * x; unsigned* gen = ctr + 64; unsigned* tmo = base + CW_BAR + XB_TMO;
        __builtin_amdgcn_s_waitcnt(0);
        const unsigned old = xb_add(ctr, 1u); const unsigned g = old >> sh;
        if (((old + 1u) & ((1u << sh) - 1u)) == 0u) xb_add(gen, 1u);
        else XB_SPIN(xb_ld(gen) == g, base + CW_BAR);
        (void)tmo;
        __builtin_amdgcn_fence(__ATOMIC_ACQUIRE, "agent");
        asm volatile("s_waitcnt vmcnt(0)" ::: "memory");
    }
    __syncthreads();
}
__global__ void __launch_bounds__(NWAVES * 64, 2) trunk_fwd(Args args) {
    extern __shared__ __attribute__((aligned(16))) unsigned char lds_raw[];
    Frame F; F.lds = (LAS unsigned char*)lds_raw; F.wave = __builtin_amdgcn_readfirstlane((int)threadIdx.x >> 6); F.G = gridDim.x; F.gw = blockIdx.x * NWAVES + F.wave; F.NGW = F.G * NWAVES;
    for (int u = threadIdx.x; u < (LDS_BYTES - LDSCTL_OFF) / 4; u += NWAVES * 64) ((LAS unsigned*)(F.lds + LDSCTL_OFF))[u] = 0u;
    __syncthreads();
    const int lo = get_args()->ph_lo, hi = get_args()->ph_hi;
    volatile LAS unsigned* MISCW = (volatile LAS unsigned*)(F.lds + MISC_OFF);
    if (hi - lo > 1 && threadIdx.x == 0) { unsigned* barw = (unsigned*)((gu32*)(get_args()->ws + WS_CTL) + CW_BAR); const unsigned x_ = xb_xcc_id(); MISCW[11] = x_; MISCW[10] = xb_add(&barw[XB_XCNT(x_)], 1u); }
#ifndef REPEAT_MIX
#define REPEAT_MIX 1
#endif
#ifndef PHASE_MASK
#define PHASE_MASK 0xffff
#endif
#ifndef FORCE_GLOBAL
#define FORCE_GLOBAL 0
#endif
#ifndef GROUP_WGS
#define GROUP_WGS 32
#endif
#define PHM(b) ((PHASE_MASK >> (b)) & 1)
#ifndef PROBE_STAMP
#define PROBE_STAMP -1
#endif
#ifndef PROBE_SCALE
#define PROBE_SCALE 1
#endif
#ifndef PROBE_WG
#define PROBE_WG 0
#endif
#ifndef PROBE_CLOCK
#define PROBE_CLOCK 0
#endif
#define TS_BEGIN(k) do { if (PROBE_STAMP == (k) && (PROBE_WG < 0 || blockIdx.x == PROBE_WG) && threadIdx.x == 0) { MISCW[20] = (unsigned)__builtin_amdgcn_s_memrealtime(); MISCW[22] = (unsigned)__builtin_amdgcn_s_memtime(); } } while (0)
#define TS_END(k) do { if (PROBE_STAMP == (k) && (PROBE_WG < 0 || blockIdx.x == PROBE_WG) && threadIdx.x == 0) { MISCW[21] += (unsigned)__builtin_amdgcn_s_memrealtime() - MISCW[20]; MISCW[23] += (unsigned)__builtin_amdgcn_s_memtime() - MISCW[22]; } } while (0)
#define IN(k) (lo <= (k) && (k) < hi)
#define GLOBAL_BAR() do { XcdBarrier bar_; bar_.bar = (unsigned*)((gu32*)(get_args()->ws + WS_CTL) + CW_BAR); bar_.x = xb_xcc_id(); bar_.st = (volatile LAS unsigned*)(F.lds + MISC_OFF) + 8; xcd_barrier(bar_); } while (0)
#ifndef PAIR_SEAMS
#define PAIR_SEAMS 0
#endif
#define CW_PBAR (CW_QBAR + 128 * 64)
#define SEAM(k) do { if (IN(k) && IN((k) + 1)) { TS_BEGIN(7); if (F.local) { if (PAIR_SEAMS && F.gsz == 32) grp_barrier((unsigned*)((gu32*)(get_args()->ws + WS_CTL)) + (CW_PBAR - CW_LBAR), (unsigned)(F.grp >> 1), 6u); else grp_barrier((unsigned*)((gu32*)(get_args()->ws + WS_CTL)), (unsigned)F.grp, F.gsz == 8 ? 3u : 5u); } else GLOBAL_BAR(); TS_END(7); } } while (0)
#define SEAM_OWN(k) do { if (IN(k) && IN((k) + 1)) { if (F.local && F.gsz == 32) { TS_BEGIN(7); grp_barrier((unsigned*)((gu32*)(get_args()->ws + WS_CTL)) + (CW_QBAR - CW_LBAR), (unsigned)(8 * F.grp + (F.ceff & 7)), 2u); TS_END(7); } else if (!(F.local && F.gsz == 8)) SEAM(k); } } while (0)
#define PHASE_BEGIN ArgsP ap = get_args(); unsigned char* ws = ap->ws; ss_t* stats = (ss_t*)(ws + WS_STATS); bf16* Yb = (bf16*)(ws + WS_BIG); bf16* MIXb = (bf16*)(ws + WS_MIX); bf16* HID = (bf16*)(ws + WS_BIG); bf16* ERAW = (bf16*)(ws + WS_ERAW); \
        bf16* XBc = (bf16*)(ws + ((l & 1) ? WS_XB1 : WS_XB0)); bf16* XBn = (bf16*)(ws + ((l & 1) ? WS_XB0 : WS_XB1)); (void)stats; (void)Yb; (void)MIXb; (void)HID; (void)ERAW; (void)XBc; (void)XBn;
#define ORDER(N_) pg8::GroupOrder S; S.init(F.local ? F.gsz : M / 256, F.local ? F.gsz * F.grp : 0, (N_), F.gsz, F.ceff, F.local ? 0 : 1)

    F.local = 0; F.grp = 0; F.gsz = F.G; F.ceff = (int)blockIdx.x;
    TS_BEGIN(8); TS_BEGIN(0);
    if (PHM(6) && IN(0)) { for (int rp_ = 0; rp_ < REPEAT_PRO; ++rp_) p0_prologue(F, get_args()); }
    if (IN(0) && IN(1)) {
        GLOBAL_BAR();
        if (threadIdx.x == 0) { unsigned* barw = (unsigned*)((gu32*)(get_args()->ws + WS_CTL) + CW_BAR); unsigned ok = (gridDim.x == 256u) ? 1u : 0u;
#pragma unroll
            for (int j = 0; j < 16; ++j) { const unsigned c_ = xb_ld(&barw[XB_XCNT(j)]); if (c_ != (j < 8 ? 32u : 0u)) ok = 0u; }
            if (FORCE_GLOBAL) ok = 0u;
            MISCW[13] = ok; }
        __syncthreads();
        if (MISCW[13]) { const int x_ = (int)MISCW[11], r_ = (int)MISCW[10]; F.local = 1; F.gsz = GROUP_WGS; F.grp = x_ * (32 / GROUP_WGS) + r_ / GROUP_WGS; F.ceff = r_ % GROUP_WGS; }
        F.local = __builtin_amdgcn_readfirstlane(F.local); F.grp = __builtin_amdgcn_readfirstlane(F.grp); F.ceff = __builtin_amdgcn_readfirstlane(F.ceff); F.gsz = __builtin_amdgcn_readfirstlane(F.gsz);
    }

    TS_END(0);
    for (int l = 0; l < DEPTH; ++l) {
        const int pb = 1 + 6 * l;
        TS_BEGIN(1); if (PHM(0) && IN(pb)) { PHASE_BEGIN pg8::Gemm g{XBc, (const bf16*)(ws + WS_WIN) + (size_t)l * NY * DM, M, NY, DM, DM, 0}; ORDER(NY);
            pg8::EpiIn E{Yb, NY, (const float*)(ws + WS_BIASY) + l * NY, stats + (size_t)(SS_IN + l) * M, Y_BLK / 2};
            for (int rr_ = 0; rr_ < REP_IN; ++rr_) pg8::gemm_phase<pg8::EpiIn, pg8::GroupOrder, true, true>(F.lds, g, S, E, F.wave); }
        TS_END(1); SEAM(pb);
        TS_BEGIN(2); if (PHM(1) && IN(pb + 1)) { for (int rep_ = 0; rep_ < REPEAT_MIX; ++rep_) {
            const int ntask = F.local ? F.gsz : 256, half_ = ntask >> 1, bh0 = F.local ? half_ * F.grp : 0;
            for (int task = F.ceff; task < ntask; task += F.gsz) {
                if (task < half_) { TS_BEGIN(9); for (int r1_ = 0; r1_ < REPEAT_MLSTM; ++r1_) mlstm_task(F, get_args(), l, bh0 + task); TS_END(9); } else { TS_BEGIN(10); for (int r2_ = 0; r2_ < REPEAT_HGRN; ++r2_) hgrn_task(F, get_args(), l, bh0 + task - half_); TS_END(10); } }
            swa_loop(F, get_args(), l, (gu32*)(get_args()->ws + WS_CTL) + CW_QUEUE + 64 * (32 * l + F.grp) + 16 * rep_, F.local ? 4 * F.gsz * F.grp : 0, F.local ? (unsigned)(4 * F.gsz) : 1024u); } }
        TS_END(2); SEAM(pb + 1);
        TS_BEGIN(3); if (PHM(2) && IN(pb + 2)) { PHASE_BEGIN pg8::Gemm g{MIXb, (const bf16*)(ws + WS_WOUT) + (size_t)l * DM * DM, M, DM, DM, DM, MIX_BLK}; ORDER(DM);
            for (int rr_ = 0; rr_ < REP_OUT; ++rr_) { pg8::EpiRes E{XBc, rr_ ? XBn : XBc, DM, rr_ ? (ss_t*)(ws + WS_CTL + 512 * 1024) : stats + (size_t)(SS_MLP + l) * M};
            pg8::gemm_phase<pg8::EpiRes, pg8::GroupOrder, true, true>(F.lds, g, S, E, F.wave); } }
        TS_END(3); SEAM(pb + 2);
        TS_BEGIN(4); if (PHM(3) && IN(pb + 3)) { PHASE_BEGIN pg8::Gemm g{XBc, (const bf16*)(ws + WS_WUP) + (size_t)l * FF * DM, M, FF, DM, DM, 0}; ORDER(FF);
            pg8::EpiUp E{HID, FF, stats + (size_t)(SS_MLP + l) * M};
            for (int rr_ = 0; rr_ < REP_UP; ++rr_) pg8::gemm_phase<pg8::EpiUp, pg8::GroupOrder, true, true>(F.lds, g, S, E, F.wave); }
        TS_END(4); SEAM_OWN(pb + 3);
        TS_BEGIN(5); if (PHM(4) && IN(pb + 4)) {
            { PHASE_BEGIN pg8::Gemm g{HID, (const bf16*)(ws + WS_WDN) + (size_t)l * DM * FF, M, DM, FF, FF, 0}; ORDER(DM);
              for (int rr_ = 0; rr_ < REP_DOWN; ++rr_) { pg8::EpiRes E{XBc, rr_ ? XBn : XBc, DM, rr_ ? (ss_t*)(ws + WS_CTL + 512 * 1024) : stats + (size_t)(SS_PLE + l) * M};
              pg8::gemm_phase<pg8::EpiRes, pg8::GroupOrder, true, true>(F.lds, g, S, E, F.wave); } }
            int go2_ = 1; asm volatile("" : "+s"(go2_));
            if (go2_) { PHASE_BEGIN pg8::Gemm g{(const bf16*)ap->out + (size_t)l * PLE, (const bf16*)(ws + WS_WP) + (size_t)l * DM * PLE, M, DM, PLE, 2048, 0}; ORDER(DM);
              for (int rr_ = 0; rr_ < REP_PLE; ++rr_) { pg8::EpiPle E{ERAW, DM, rr_ ? (ss_t*)(ws + WS_CTL + 512 * 1024) : stats + (size_t)(SS_E + l) * M, ap->ple_post_g + l * DM};
              pg8::gemm_phase<pg8::EpiPle, pg8::GroupOrder, true, true>(F.lds, g, S, E, F.wave); } } }
        TS_END(5); SEAM_OWN(pb + 4);
        TS_BEGIN(6); if (PHM(5) && IN(pb + 5)) { PHASE_BEGIN pg8::Gemm g{XBc, (const bf16*)(ws + WS_WG) + (size_t)l * DM * DM, M, DM, DM, DM, 0}; ORDER(DM);
            const bool last = (l == DEPTH - 1);
            if (!last) { for (int rr_ = 0; rr_ < REP_GATE; ++rr_) { pg8::EpiGate<false> E{XBc, XBn, nullptr, ERAW, DM, stats + (size_t)(SS_PLE + l) * M, stats + (size_t)(SS_E + l) * M, rr_ ? (ss_t*)(ws + WS_CTL + 512 * 1024) : stats + (size_t)(SS_IN + l + 1) * M};
                pg8::gemm_phase<pg8::EpiGate<false>, pg8::GroupOrder, true, true>(F.lds, g, S, E, F.wave); } }
            else { for (int rr_ = 0; rr_ < REP_GATE; ++rr_) { pg8::EpiGate<true> E{XBc, XBn, ap->out, ERAW, DM, stats + (size_t)(SS_PLE + l) * M, stats + (size_t)(SS_E + l) * M, nullptr};
                pg8::gemm_phase<pg8::EpiGate<true>, pg8::GroupOrder, true, true>(F.lds, g, S, E, F.wave); } } }
        TS_END(6); SEAM(pb + 5);
    }
    TS_END(8);
    if (PROBE_STAMP >= 0 && (PROBE_WG < 0 || blockIdx.x == PROBE_WG) && threadIdx.x == 0) { const unsigned long long w_ = PROBE_CLOCK ? (unsigned long long)MISCW[23] * 10000ull / (MISCW[21] ? MISCW[21] : 1u) : (unsigned long long)MISCW[21] * PROBE_SCALE;
        const unsigned long long t0_ = __builtin_amdgcn_s_memrealtime(); while (__builtin_amdgcn_s_memrealtime() - t0_ < w_) __builtin_amdgcn_s_sleep(64); }
#undef IN
#undef SEAM
}

#ifndef MK_N_LAUNCHES
#define MK_N_LAUNCHES 1
#endif
extern "C" void kernel_launch(void* const* d_in, const int* in_sizes, int n_in, void* d_out, int out_size, void* d_ws, size_t ws_size, hipStream_t stream) {
    static int grid = 0;
    if (grid == 0) {
        if (n_in != 23 || in_sizes[0] != M * DM || out_size != M * DM || ws_size < WS_END) { fprintf(stderr, "kernel_launch: unexpected shapes (n_in %d in0 %d out %d ws %zu); nothing launched\n", n_in, n_in > 0 ? in_sizes[0] : -1, out_size, ws_size); grid = -1; return; }
        int dev = 0, cus = 0, per_cu = 0;
        if (hipGetDevice(&dev) != hipSuccess || hipDeviceGetAttribute(&cus, hipDeviceAttributeMultiprocessorCount, dev) != hipSuccess) { grid = -1; return; }
        if (hipFuncSetAttribute((const void*)trunk_fwd, hipFuncAttributeMaxDynamicSharedMemorySize, LDS_BYTES) != hipSuccess) { fprintf(stderr, "kernel_launch: hipFuncSetAttribute failed\n"); grid = -1; return; }
        if (hipOccupancyMaxActiveBlocksPerMultiprocessor(&per_cu, (const void*)trunk_fwd, NWAVES * 64, LDS_BYTES) != hipSuccess || per_cu < 1) { fprintf(stderr, "kernel_launch: occupancy query says %d blocks per CU\n", per_cu); }
        (void)hipGetLastError();
        grid = cus;
    }
    if (grid < 0) return;
    if (hipMemsetAsync((char*)d_ws, 0, ZERO_BYTES, stream) != hipSuccess) return;
    Args a{};
    a.x = (const float*)d_in[0]; a.p = (const float*)d_in[1]; a.pos = (const int*)d_in[2];
    a.in_norm_g = (const float*)d_in[3]; a.w_in = (const float*)d_in[4]; a.b_in = (const float*)d_in[5]; a.mlstm_f_bias = (const float*)d_in[6]; a.conv_w = (const float*)d_in[7]; a.conv_b = (const float*)d_in[8];
    a.mlstm_norm_g = (const float*)d_in[9]; a.hgrn_lb_logits = (const float*)d_in[10]; a.hgrn_norm_g = (const float*)d_in[11]; a.swa_q_g = (const float*)d_in[12]; a.swa_k_g = (const float*)d_in[13]; a.swa_sinks = (const float*)d_in[14];
    a.w_out = (const float*)d_in[15]; a.mlp_norm_g = (const float*)d_in[16]; a.w_up = (const float*)d_in[17]; a.w_down = (const float*)d_in[18]; a.ple_norm_g = (const float*)d_in[19]; a.w_ple_gate = (const float*)d_in[20];
    a.w_ple_proj = (const float*)d_in[21]; a.ple_post_g = (const float*)d_in[22];
    a.out = (float*)d_out; a.ws = (unsigned char*)d_ws;
    for (int i = 0; i < 8; ++i) a.rope_rev[i] = pow(500000.0, -(double)i / 8.0) / 6.283185307179586476925286766559;
#if MK_N_LAUNCHES == 1
    a.ph_lo = 0; a.ph_hi = N_PHASES;
    hipLaunchKernelGGL(trunk_fwd, dim3(grid), dim3(NWAVES * 64), LDS_BYTES, stream, a);
#else
    for (int ph = 0; ph < N_PHASES; ++ph) { a.ph_lo = ph; a.ph_hi = ph + 1; hipLaunchKernelGGL(trunk_fwd, dim3(grid), dim3(NWAVES * 64), LDS_BYTES, stream, a); }
#endif
}
```

```cpp
#include <hip/hip_runtime.h>
#include <cstdio>
#include <cstdint>
#include <cmath>
namespace pg8 {
#define PG8_LAS __attribute__((address_space(3)))
typedef unsigned short bf16_t;
typedef short bf16x8 __attribute__((ext_vector_type(8)));
typedef float f32x4 __attribute__((ext_vector_type(4)));
typedef unsigned u32x4 __attribute__((ext_vector_type(4)));
constexpr int BM = 256, BK = 64, HALF = 128, HTB = HALF * BK * 2  , STAGE_BYTES = 8 * HTB, NXCD = 8, WGM = 8;

__host__ __device__ __forceinline__ int lds_byte(int r, int c) { const int st = (r >> 4) * 2 + (c >> 5), rr = r & 15, cc = c & 31, ob = rr * 64 + cc * 2; return st * 1024 + (ob ^ (((ob >> 9) & 1) << 5)); }
__host__ __device__ __forceinline__ void stage_rc(int b, int& R, int& C) { const int st = b / 1024, sb = b % 1024, swz = sb ^ (((sb >> 9) & 1) << 5); R = (st >> 1) * 16 + swz / 64; C = (st & 1) * 32 + (swz % 64) / 2; }
__host__ __device__ __forceinline__ int perm32(int rho) { const int n = rho >> 4, i = rho & 15; return 8 * (i >> 2) + 4 * n + (i & 3); }

struct Unit { int pm, pn; };
struct Gemm { const bf16_t* A; const bf16_t* Bt; int M, N, K, lda; size_t a_blk; };

struct StaticOrder {
    int nM, nN, nwg, G, c;
    __host__ __device__ void init(int M, int N, int G_, int c_) { nM = M / BM; nN = N / BM; nwg = nM * nN; G = G_; c = c_; }
    __host__ __device__ bool next(int i, Unit& u) const {
        const long L = (long)i * G + c; if (L >= nwg) return false;
        int wgid = (int)L; { const int q = nwg / NXCD, r = nwg % NXCD, xcd = wgid % NXCD, off = wgid / NXCD; wgid = (xcd < r ? xcd * (q + 1) : r * (q + 1) + (xcd - r) * q) + off; }
        const int nig = WGM * nN, gid = wgid / nig, fm = gid * WGM, gsz = (nM - fm) < WGM ? (nM - fm) : WGM;
        u.pm = fm + ((wgid % nig) % gsz); u.pn = (wgid % nig) / gsz; return true;
    }
    __device__ __forceinline__ void a_ready(const Unit&) const {}
    __device__ __forceinline__ void done(const Unit&) const {}
};
typedef __bf16 bf16x2v_t __attribute__((ext_vector_type(2))); typedef float f32x2v_t __attribute__((ext_vector_type(2)));
__device__ __forceinline__ unsigned cvt_pk_bf16(float lo, float hi) { const f32x2v_t v = {lo, hi}; return __builtin_bit_cast(unsigned, __builtin_convertvector(v, bf16x2v_t)); }
typedef float f32x2 __attribute__((ext_vector_type(2)));
template <class Epi, class Sched, bool ALIGN_EPI = false, bool SP2 = false>
__device__ __forceinline__ void gemm_phase(PG8_LAS unsigned char* lds, const Gemm g, const Sched& S, const Epi& E, const int wave_id) {
    int lid_; asm volatile("v_mbcnt_lo_u32_b32 %0, -1, 0\n\tv_mbcnt_hi_u32_b32 %0, -1, %0" : "=v"(lid_)); const int tid_ = __builtin_amdgcn_readfirstlane(wave_id) * 64 + lid_;
    const int tid = tid_, wid = __builtin_amdgcn_readfirstlane(tid >> 6), lane = tid & 63, wr = wid >> 2, wc = wid & 3, fr = lane & 15, fq = lane >> 4;
    int K_ = g.K; asm volatile("" : "+s"(K_));
    const int K = K_, nt = K / BK;
    unsigned voffA[2], voffB[2];
#pragma unroll
    for (int i = 0; i < 2; ++i) { int R, C; stage_rc(tid * 16 + i * 8192, R, C); const int Rb = Epi::PERM ? ((R & ~31) + perm32(R & 31)) : R;
        voffA[i] = (unsigned)(R * g.lda + C) * 2u; voffB[i] = (unsigned)(Rb * K + C) * 2u; }
    const size_t kstep = (size_t)(BK * 2);
    const size_t hstepB = (size_t)HALF * K * 2, hstepA = (size_t)HALF * g.lda * 2;
    const size_t tstepB = 2 * hstepB, tstepA = 2 * hstepA;
    const unsigned ldsw = (unsigned)wid * 1024u;
    const int aoff = lds_byte(wr * 64 + fr, fq * 8), boff = lds_byte(wc * 32 + fr, fq * 8);
#define PG8_SA(b, h) (((b) * 2 + (h)) * HTB)
#define PG8_SB(b, h) ((4 + (b) * 2 + (h)) * HTB)
#define PG8_STAGE(bufoff, gbase, voff) do { _Pragma("unroll") for (int _i = 0; _i < 2; ++_i) \
        __builtin_amdgcn_global_load_lds((const unsigned*)((const char*)(gbase) + (voff)[_i]), (PG8_LAS unsigned*)(lds + (bufoff) + ldsw + _i * 8192), 16, 0, 0); } while (0)
#define PG8_LDA(dst, b, h) do { _Pragma("unroll") for (int m = 0; m < 4; ++m) _Pragma("unroll") for (int k = 0; k < 2; ++k) dst[m][k] = *(const PG8_LAS bf16x8*)(lds + PG8_SA(b, h) + aoff + m * 2048 + k * 1024); } while (0)
#define PG8_LDB(dst, b, h) do { _Pragma("unroll") for (int n = 0; n < 2; ++n) _Pragma("unroll") for (int k = 0; k < 2; ++k) dst[n][k] = *(const PG8_LAS bf16x8*)(lds + PG8_SB(b, h) + boff + n * 2048 + k * 1024); } while (0)
#define PG8_MMA(ai, bj, At, Bt) do { __builtin_amdgcn_s_setprio(1); _Pragma("unroll") for (int m = 0; m < 4; ++m) _Pragma("unroll") for (int n = 0; n < 2; ++n) _Pragma("unroll") for (int k = 0; k < 2; ++k) \
        acc[ai][bj][m][n] = __builtin_amdgcn_mfma_f32_16x16x32_bf16(Bt[n][k], At[m][k], acc[ai][bj][m][n], 0, 0, 0); __builtin_amdgcn_s_setprio(0); } while (0)
#define PG8_WAIT_V(n) asm volatile("s_waitcnt vmcnt(" #n ")" ::: "memory")
#define PG8_WAIT_L(n) asm volatile("s_waitcnt lgkmcnt(" #n ")" ::: "memory")
#define PG8_BAR __builtin_amdgcn_s_barrier()
#define PG8_SCHED __builtin_amdgcn_sched_barrier(0)
    Unit cur, nxt; int ui = 0;
    if (!S.next(0, cur)) return;
    f32x4 acc[2][2][4][2];
#pragma unroll
    for (int a = 0; a < 2; ++a)
#pragma unroll
        for (int b = 0; b < 2; ++b)
#pragma unroll
            for (int m = 0; m < 4; ++m)
#pragma unroll
                for (int n = 0; n < 2; ++n) acc[a][b][m][n] = (f32x4){0.f, 0.f, 0.f, 0.f};
    bf16x8 At[4][2], B0[2][2], B1[2][2];
    const char* cA = (const char*)g.A + (size_t)cur.pm * tstepA + (size_t)(cur.pm >> 3) * g.a_blk; const char* cB = (const char*)g.Bt + (size_t)cur.pn * tstepB;
    S.a_ready(cur);
    if constexpr (SP2) {
        PG8_STAGE(PG8_SB(0, 0), cB, voffB); PG8_STAGE(PG8_SB(0, 1), cB + hstepB, voffB); PG8_STAGE(PG8_SA(0, 0), cA, voffA); PG8_STAGE(PG8_SA(0, 1), cA + hstepA, voffA);
        if (wr == 1) PG8_BAR;
        PG8_WAIT_V(2); PG8_BAR;
        PG8_STAGE(PG8_SB(1, 0), cB + kstep, voffB); PG8_STAGE(PG8_SA(1, 0), cA + kstep, voffA); PG8_STAGE(PG8_SB(1, 1), cB + hstepB + kstep, voffB);
        PG8_WAIT_V(6); PG8_BAR;
    } else {
        PG8_STAGE(PG8_SB(0, 0), cB, voffB); PG8_STAGE(PG8_SA(0, 0), cA, voffA); PG8_STAGE(PG8_SB(0, 1), cB + hstepB, voffB); PG8_STAGE(PG8_SA(0, 1), cA + hstepA, voffA);
        if (wr == 1) PG8_BAR;
        PG8_WAIT_V(4); PG8_BAR;
        PG8_STAGE(PG8_SB(1, 0), cB + kstep, voffB); PG8_STAGE(PG8_SA(1, 0), cA + kstep, voffA); PG8_STAGE(PG8_SB(1, 1), cB + hstepB + kstep, voffB);
        PG8_WAIT_V(6); PG8_BAR;
    }
    for (;;) {
        const bool has_next = S.next(ui + 1, nxt);
        const char* nA = has_next ? (const char*)g.A + (size_t)nxt.pm * tstepA + (size_t)(nxt.pm >> 3) * g.a_blk : cA; const char* nB = has_next ? (const char*)g.Bt + (size_t)nxt.pn * tstepB : cB;
        for (int t = 0; t < nt; t += 2) {
            const bool last = (t == nt - 2);
            const char* a1 = cA + (size_t)(t + 1) * kstep;
            const char* a2 = last ? nA : cA + (size_t)(t + 2) * kstep; const char* b2 = last ? nB : cB + (size_t)(t + 2) * kstep;
            const char* a3 = a2 + kstep; const char* b3 = b2 + kstep;
            if (last && has_next) S.a_ready(nxt);
            if constexpr (SP2) {
            PG8_LDB(B0, 0, 0); PG8_LDB(B1, 0, 1); PG8_SCHED; PG8_LDA(At, 0, 0); PG8_STAGE(PG8_SA(1, 1), a1 + hstepA, voffA);
            PG8_WAIT_V(8); PG8_WAIT_L(0); PG8_BAR; PG8_MMA(0, 0, At, B0); PG8_MMA(0, 1, At, B1); PG8_BAR; PG8_SCHED;
            PG8_LDA(At, 0, 1); PG8_STAGE(PG8_SB(0, 0), b2, voffB); PG8_STAGE(PG8_SB(0, 1), b2 + hstepB, voffB); PG8_STAGE(PG8_SA(0, 0), a2, voffA);
            PG8_WAIT_V(8); PG8_WAIT_L(0); PG8_BAR; PG8_MMA(1, 0, At, B0); PG8_MMA(1, 1, At, B1); PG8_BAR; PG8_SCHED;
            PG8_LDB(B0, 1, 0); PG8_LDB(B1, 1, 1); PG8_SCHED; PG8_LDA(At, 1, 0); PG8_STAGE(PG8_SA(0, 1), a2 + hstepA, voffA);
            PG8_WAIT_V(8); PG8_WAIT_L(0); PG8_BAR; PG8_MMA(0, 0, At, B0); PG8_MMA(0, 1, At, B1); PG8_BAR; PG8_SCHED;
            PG8_LDA(At, 1, 1); PG8_STAGE(PG8_SB(1, 0), b3, voffB); PG8_STAGE(PG8_SB(1, 1), b3 + hstepB, voffB); PG8_STAGE(PG8_SA(1, 0), a3, voffA);
            PG8_WAIT_V(8); PG8_WAIT_L(0); PG8_BAR; PG8_MMA(1, 0, At, B0); PG8_MMA(1, 1, At, B1); PG8_BAR; PG8_SCHED;
            } else {
            PG8_LDB(B0, 0, 0); PG8_SCHED; PG8_LDA(At, 0, 0); PG8_STAGE(PG8_SA(1, 1), a1 + hstepA, voffA);
            PG8_WAIT_L(8); PG8_BAR; PG8_WAIT_L(0); PG8_MMA(0, 0, At, B0); PG8_BAR; PG8_SCHED;
            PG8_LDB(B1, 0, 1); PG8_STAGE(PG8_SB(0, 0), b2, voffB);
            PG8_BAR; PG8_WAIT_L(0); PG8_MMA(0, 1, At, B1); PG8_BAR;
            PG8_LDA(At, 0, 1); PG8_STAGE(PG8_SA(0, 0), a2, voffA);
            PG8_BAR; PG8_WAIT_L(0); PG8_MMA(1, 0, At, B0); PG8_BAR; PG8_SCHED;
            PG8_STAGE(PG8_SB(0, 1), b2 + hstepB, voffB);
            PG8_WAIT_V(6); PG8_BAR; PG8_MMA(1, 1, At, B1); PG8_BAR;
            PG8_LDB(B0, 1, 0); PG8_SCHED; PG8_LDA(At, 1, 0); PG8_STAGE(PG8_SA(0, 1), a2 + hstepA, voffA);
            PG8_WAIT_L(8); PG8_BAR; PG8_WAIT_L(0); PG8_MMA(0, 0, At, B0); PG8_BAR; PG8_SCHED;
            PG8_LDB(B1, 1, 1); PG8_STAGE(PG8_SB(1, 0), b3, voffB);
            PG8_BAR; PG8_WAIT_L(0); PG8_MMA(0, 1, At, B1); PG8_BAR;
            PG8_LDA(At, 1, 1); PG8_STAGE(PG8_SA(1, 0), a3, voffA);
            PG8_BAR; PG8_WAIT_L(0); PG8_MMA(1, 0, At, B0); PG8_BAR; PG8_SCHED;
            PG8_STAGE(PG8_SB(1, 1), b3 + hstepB, voffB);
            PG8_WAIT_V(6); PG8_BAR; PG8_MMA(1, 1, At, B1); PG8_BAR;
            }
        }
        if constexpr (ALIGN_EPI) { if (wr == 0) PG8_BAR; }
        if constexpr (!Epi::AFTER_DRAIN) { E(acc, cur, wr, wc, fr, fq); S.done(cur); }
        if (!has_next) break;
#pragma unroll
        for (int a = 0; a < 2; ++a)
#pragma unroll
            for (int b = 0; b < 2; ++b)
#pragma unroll
                for (int m = 0; m < 4; ++m)
#pragma unroll
                    for (int n = 0; n < 2; ++n) acc[a][b][m][n] = (f32x4){0.f, 0.f, 0.f, 0.f};
        cur = nxt; cA = nA; cB = nB; ++ui;
        if constexpr (ALIGN_EPI) { if (wr == 1) PG8_BAR; }
    }
    PG8_WAIT_V(0);
    if constexpr (!ALIGN_EPI) { if (wr == 0) PG8_BAR; }
    PG8_BAR;
    if constexpr (Epi::AFTER_DRAIN) { E.fused(acc, cur, wr, wc, fr, fq, lds, wid, lane); S.done(cur); }
#undef PG8_SA
#undef PG8_SB
#undef PG8_STAGE
#undef PG8_LDA
#undef PG8_LDB
#undef PG8_MMA
#undef PG8_WAIT_V
#undef PG8_WAIT_L
#undef PG8_BAR
#undef PG8_SCHED
}
}

namespace pg8 {
struct GroupOrder {
    int nM, nN, nwg, G, c, pm_base, remap;
    __device__ __forceinline__ void init(int nM_, int pm_base_, int N, int G_, int c_, int remap_) { nM = nM_; nN = N / BM; nwg = nM * nN; G = G_; c = c_; pm_base = pm_base_; remap = remap_; }
    __device__ __forceinline__ bool next(int i, Unit& u) const {
        const long L = (long)i * G + c; if (L >= nwg) return false;
        int wgid = (int)L; if (remap) { const int q = nwg / NXCD, r = nwg % NXCD, xcd = wgid % NXCD, off = wgid / NXCD; wgid = (xcd < r ? xcd * (q + 1) : r * (q + 1) + (xcd - r) * q) + off; }
        const int nig = WGM * nN, gid = wgid / nig, fm = gid * WGM, gsz = (nM - fm) < WGM ? (nM - fm) : WGM;
        u.pm = pm_base + fm + ((wgid % nig) % gsz); u.pn = (wgid % nig) / gsz; return true;
    }
    __device__ __forceinline__ void a_ready(const Unit&) const {}
    __device__ __forceinline__ void done(const Unit&) const {}
};
}
constexpr int NWAVES = 8;
constexpr int BATCH = 32, SEQ = 2048, DM = 1024, DEPTH = 4, M = BATCH * SEQ, NY = 3072, FF = 4096, PLE = 256, INW = 2824;
constexpr float EPS = 1e-6f;
constexpr int YC_MQ = 0, YC_MK = 256, YC_MV = 512, YC_MO = 768, YC_HQ = 1024, YC_HF = 1280, YC_HI = 1536, YC_HG = 1792, YC_SQ = 2048, YC_SK = 2560, YC_SV = 2688, YC_MI = 2816, YC_MF = 2820;

constexpr size_t MiB = 1u << 20;
constexpr size_t WS_CTL = 0, WS_STATS = 1 * MiB, ZERO_BYTES = 9 * MiB;
constexpr size_t WS_ROPE = 9 * MiB;
constexpr size_t WS_BIASY = 13 * MiB;
constexpr size_t WS_WIN = 14 * MiB, WS_WOUT = 38 * MiB, WS_WUP = 46 * MiB, WS_WDN = 78 * MiB, WS_WG = 110 * MiB, WS_WP = 118 * MiB;
constexpr size_t WS_XB0 = 120 * MiB, WS_XB1 = 248 * MiB;
constexpr size_t WS_BIG = 376 * MiB;
constexpr size_t WS_MIX = WS_BIG + 12 * MiB;
constexpr size_t Y_BLK = 4 * MiB, MIX_BLK = 12 * MiB;
constexpr size_t WS_ERAW = 888 * MiB;
constexpr size_t WS_END = 1016 * MiB;
constexpr int SS_IN = 0, SS_MLP = 4, SS_PLE = 8, SS_E = 12;
constexpr int CW_BAR = 4096, CW_QUEUE = 16384, CW_LBAR = 32768, CW_QBAR = 65536;

constexpr int SCR_BYTES = 159744;
constexpr int LDSCTL_OFF = SCR_BYTES, MISC_OFF = LDSCTL_OFF + 320;
constexpr int LDS_BYTES = 163840;

#define GAS __attribute__((address_space(1)))
#define LAS __attribute__((address_space(3)))
typedef unsigned short bf16;
typedef unsigned v4u __attribute__((ext_vector_type(4)));
typedef float f32x4 __attribute__((ext_vector_type(4)));
typedef short bf16x8 __attribute__((ext_vector_type(8)));
typedef GAS unsigned gu32;
typedef GAS unsigned long long gu64;
#define RLX_AGENT __ATOMIC_RELAXED, __HIP_MEMORY_SCOPE_AGENT
#define LDS_WAIT() asm volatile("s_waitcnt lgkmcnt(0)" ::: "memory")
#define VM_WAIT() asm volatile("s_waitcnt vmcnt(0)" ::: "memory")
__device__ __forceinline__ unsigned long long rt() { return __builtin_amdgcn_s_memrealtime(); }
__device__ __forceinline__ unsigned f2bf(float f) { unsigned u = __builtin_bit_cast(unsigned, f); return (u + 0x7fffu + ((u >> 16) & 1u)) >> 16; }
__device__ __forceinline__ unsigned pk2(float lo, float hi) { return f2bf(lo) | (f2bf(hi) << 16); }
typedef unsigned u32x4 __attribute__((ext_vector_type(4)));
typedef unsigned u32x2 __attribute__((ext_vector_type(2)));
#define XB_TMO      128
#define XB_XCNT(j)  (256  + 64 * (j))
#define XB_XSUB(j)  (1280 + 64 * (j))
#define XB_XGEN(j)  (2304 + 64 * (j))
#define XB_TOP      3328
#define XB_TOPGEN   3392
#define XCD_BAR_WORDS 3456
#define XB_SPIN_CAP (1u << 18)

__device__ __forceinline__ unsigned xb_ld(unsigned* p)              { return __hip_atomic_load(p, __ATOMIC_RELAXED, __HIP_MEMORY_SCOPE_AGENT); }
__device__ __forceinline__ unsigned xb_add(unsigned* p, unsigned v) { return __hip_atomic_fetch_add(p, v, __ATOMIC_RELAXED, __HIP_MEMORY_SCOPE_AGENT); }
__device__ __forceinline__ unsigned xb_xcc_id() { return (unsigned)__builtin_amdgcn_s_getreg((3 << 11) | 20) & 0xFu; }
#define XB_SPIN(cond, bar) do { unsigned _sp = 0; while (cond) { __builtin_amdgcn_s_sleep(1); \
    if ((++_sp & 255u) == 0u) { if (xb_ld(&(bar)[XB_TMO])) break; if (_sp > XB_SPIN_CAP) { atomicAdd(&(bar)[XB_TMO], 1u); break; } } } } while (0)

struct XcdBarrier {
    unsigned* bar; unsigned x;
    volatile LAS unsigned* st;
};

__device__ __forceinline__ XcdBarrier xcd_barrier_post(unsigned* bar, volatile LAS unsigned* st) {
    XcdBarrier b; b.bar = bar; b.x = xb_xcc_id(); b.st = st;
    if (threadIdx.x == 0) (void)xb_add(&bar[XB_XCNT(b.x)], 1u);
    return b;
}
__device__ __forceinline__ void xcd_barrier_complete(unsigned* bar, unsigned x, unsigned& nloc, unsigned& nx) {
    const unsigned G = gridDim.x * gridDim.y * gridDim.z;
    unsigned sum, cnt, mine, sp = 0u;
    for (;;) {
        sum = 0u; cnt = 0u; mine = 0u;
#pragma unroll
        for (unsigned j = 0; j < 16; ++j) { const unsigned c = xb_ld(&bar[XB_XCNT(j)]); sum += c; cnt += (c > 0u) ? 1u : 0u; mine = (j == x) ? c : mine; }
        if (sum == G) break;
        __builtin_amdgcn_s_sleep(1);
        if ((++sp & 255u) == 0u) { if (xb_ld(&bar[XB_TMO])) break; if (sp > XB_SPIN_CAP) { atomicAdd(&bar[XB_TMO], 1u); break; } }
    }
    nloc = mine > 0u ? mine : 1u; nx = cnt > 0u ? cnt : 1u;
}

__device__ __forceinline__ void xcd_barrier(const XcdBarrier& b) {
    asm volatile("s_waitcnt vmcnt(0)" ::: "memory");
    __syncthreads();
    if (threadIdx.x == 0) {
        unsigned* bar = b.bar;
        __builtin_amdgcn_s_waitcnt(0);
        unsigned nloc = b.st[0], nx = b.st[1];
        if (nloc == 0u) { xcd_barrier_complete(bar, b.x, nloc, nx); b.st[0] = nloc; b.st[1] = nx; }
        const unsigned old = xb_add(&bar[XB_XSUB(b.x)], 1u);
        const unsigned gen = old / nloc;
        if (old + 1u == (gen + 1u) * nloc) {
            __builtin_amdgcn_fence(__ATOMIC_RELEASE, "agent");
            asm volatile("s_waitcnt vmcnt(0)" ::: "memory");
            const unsigned og = xb_add(&bar[XB_TOP], 1u);
            const unsigned tg = og / nx;
            if (og + 1u == (tg + 1u) * nx) xb_add(&bar[XB_TOPGEN], 1u);
            else XB_SPIN(xb_ld(&bar[XB_TOPGEN]) == tg, bar);
            __builtin_amdgcn_fence(__ATOMIC_ACQUIRE, "agent");
            xb_add(&bar[XB_XGEN(b.x)], 1u);
            asm volatile("s_waitcnt vmcnt(0)" ::: "memory");
        } else {
            XB_SPIN(xb_ld(&bar[XB_XGEN(b.x)]) == gen, bar);
            __builtin_amdgcn_fence(__ATOMIC_ACQUIRE, "agent");
            asm volatile("s_waitcnt vmcnt(0)" ::: "memory");
        }
    }
    __syncthreads();
}

__device__ __forceinline__ float bf2f(unsigned short b) { return __uint_as_float((unsigned)b << 16); }
__device__ __forceinline__ float bflo(unsigned w) { return __uint_as_float(w << 16); }
__device__ __forceinline__ float bfhi(unsigned w) { return __uint_as_float(w & 0xffff0000u); }
__device__ __forceinline__ unsigned short f2bf16(float f) { return (unsigned short)f2bf(f); }
__device__ __forceinline__ float sigmoid_f(float x) { return 1.f / (1.f + __expf(-x)); }
__device__ __forceinline__ float silu_f(float x) { return x * sigmoid_f(x); }
__device__ __forceinline__ float logsigmoid_f(float x) { return fminf(x, 0.f) - log1pf(__expf(-fabsf(x))); }
__device__ __forceinline__ float wave_sum(float v) {
#pragma unroll
    for (int o = 1; o < 64; o <<= 1) v += __shfl_xor(v, o);
    return v;
}
typedef unsigned long long ss_t;
__device__ __forceinline__ void atomic_add_ss(ss_t* p, float v) { atomicAdd(p, (ss_t)(v * 16777216.0f)); }
__device__ __forceinline__ float ss_rstd_v(ss_t v, float inv_n) { const u32x2 hl_ = __builtin_bit_cast(u32x2, v); const float f = __builtin_fmaf((float)hl_.y, 4294967296.0f, (float)hl_.x); return __builtin_amdgcn_rsqf(f * (inv_n * (1.0f / 16777216.0f)) + 1e-6f); }
__device__ __forceinline__ float ss_rstd(const ss_t* p, float inv_n) { return rsqrtf((float)(*p) * (inv_n * (1.0f / 16777216.0f)) + 1e-6f); }

namespace pg8 {
__device__ __forceinline__ int epi_lane() { int x; asm volatile("v_mbcnt_lo_u32_b32 %0, -1, 0\n\tv_mbcnt_hi_u32_b32 %0, -1, %0" : "=v"(x)); return x; }
#define EPI_ROWCOL const int ln_ = epi_lane(); fr = ln_ & 15; fq = ln_ >> 4; const int row0 = u.pm * BM + wr * 64 + fr; const int col0 = u.pn * BM + wc * 32 + 8 * fq;
__device__ __forceinline__ float sum_x16x32(float x) { auto r = __builtin_amdgcn_permlane16_swap(__float_as_uint(x), __float_as_uint(x), false, false); x = __uint_as_float(r[0]) + __uint_as_float(r[1]);
    auto q = __builtin_amdgcn_permlane32_swap(__float_as_uint(x), __float_as_uint(x), false, false); return __uint_as_float(q[0]) + __uint_as_float(q[1]); }
__device__ __forceinline__ u32x4 pack8(const f32x4 v0, const f32x4 v1) { u32x4 w; w.x = cvt_pk_bf16(v0[0], v0[1]); w.y = cvt_pk_bf16(v0[2], v0[3]); w.z = cvt_pk_bf16(v1[0], v1[1]); w.w = cvt_pk_bf16(v1[2], v1[3]); return w; }
__device__ __forceinline__ float sq8(const u32x4 w) { float s = 0.f;
    { float a = __uint_as_float(w.x << 16), b = __uint_as_float(w.x & 0xffff0000u); s += a * a + b * b; }
    { float a = __uint_as_float(w.y << 16), b = __uint_as_float(w.y & 0xffff0000u); s += a * a + b * b; }
    { float a = __uint_as_float(w.z << 16), b = __uint_as_float(w.z & 0xffff0000u); s += a * a + b * b; }
    { float a = __uint_as_float(w.w << 16), b = __uint_as_float(w.w & 0xffff0000u); s += a * a + b * b; } return s; }
typedef __bf16 bf16x2v __attribute__((ext_vector_type(2)));
__device__ __forceinline__ float dot2sq(unsigned w, float s) { const bf16x2v v = __builtin_bit_cast(bf16x2v, w); return __builtin_amdgcn_fdot2_f32_bf16(v, v, s, false); }
__device__ __forceinline__ void sqacc8(const u32x4 w, float& s0, float& s1) { s0 = dot2sq(w.x, s0); s1 = dot2sq(w.y, s1); s0 = dot2sq(w.z, s0); s1 = dot2sq(w.w, s1); }
__device__ __forceinline__ float rs4(float q0, float q1, float q2, float q3) {
    auto r = __builtin_amdgcn_permlane32_swap(__float_as_uint(q0), __float_as_uint(q2), false, false); const float a = __uint_as_float(r[0]) + __uint_as_float(r[1]);
    auto t = __builtin_amdgcn_permlane32_swap(__float_as_uint(q1), __float_as_uint(q3), false, false); const float c = __uint_as_float(t[0]) + __uint_as_float(t[1]);
    auto z = __builtin_amdgcn_permlane16_swap(__float_as_uint(a), __float_as_uint(c), false, false); return __uint_as_float(z[0]) + __uint_as_float(z[1]); }
__device__ __forceinline__ float ssq8(const f32x4 a, const f32x4 b) { return ((a[0] * a[0] + a[1] * a[1]) + (a[2] * a[2] + a[3] * a[3])) + ((b[0] * b[0] + b[1] * b[1]) + (b[2] * b[2] + b[3] * b[3])); }
__device__ __forceinline__ void unpack8(const u32x4 w, f32x4& v0, f32x4& v1) {
    v0 = (f32x4){__uint_as_float(w.x << 16), __uint_as_float(w.x & 0xffff0000u), __uint_as_float(w.y << 16), __uint_as_float(w.y & 0xffff0000u)};
    v1 = (f32x4){__uint_as_float(w.z << 16), __uint_as_float(w.z & 0xffff0000u), __uint_as_float(w.w << 16), __uint_as_float(w.w & 0xffff0000u)}; }

struct EpiIn {
    static constexpr bool PERM = true, AFTER_DRAIN = false;
    bf16_t* O; int ldc; const float* bias; const ss_t* ss; size_t oblk;
    __device__ __forceinline__ void operator()(const f32x4 (&acc)[2][2][4][2], const Unit& u, int wr, int wc, int fr, int fq) const {
        EPI_ROWCOL
        f32x4 bv[2][2]; ss_t sv[2][4];
#pragma unroll
        for (int ai = 0; ai < 2; ++ai)
#pragma unroll
            for (int m = 0; m < 4; ++m) sv[ai][m] = ss[row0 + ai * HALF + m * 16];
#pragma unroll
        for (int bj = 0; bj < 2; ++bj)
#pragma unroll
            for (int n = 0; n < 2; ++n) bv[bj][n] = *(const f32x4*)(bias + col0 + bj * HALF + 4 * n);
#pragma unroll
        for (int ai = 0; ai < 2; ++ai)
#pragma unroll
            for (int m = 0; m < 4; ++m) { const int row = row0 + ai * HALF + m * 16; const float rs = ss_rstd_v(sv[ai][m], 1.0f / 1024.0f); bf16_t* rowp = O + (size_t)(u.pm >> 3) * oblk + (size_t)row * ldc + col0;
#pragma unroll
                for (int bj = 0; bj < 2; ++bj) { const f32x4 v0 = acc[ai][bj][m][0] * rs + bv[bj][0], v1 = acc[ai][bj][m][1] * rs + bv[bj][1]; *(u32x4*)(rowp + bj * HALF) = pack8(v0, v1); } }
    }
};
struct EpiRes {
    static constexpr bool PERM = true, AFTER_DRAIN = false;
    bf16_t* X; bf16_t* Xo; int ldc; ss_t* ss_out;
    __device__ __forceinline__ void operator()(const f32x4 (&acc)[2][2][4][2], const Unit& u, int wr, int wc, int fr, int fq) const {
        EPI_ROWCOL
        u32x4 old[2][4][2];
#pragma unroll
        for (int ai = 0; ai < 2; ++ai)
#pragma unroll
            for (int m = 0; m < 4; ++m)
#pragma unroll
                for (int bj = 0; bj < 2; ++bj) old[ai][m][bj] = *(const u32x4*)(X + (size_t)(row0 + ai * HALF + m * 16) * ldc + col0 + bj * HALF);
        asm volatile("" ::: "memory");
#pragma unroll
        for (int ai = 0; ai < 2; ++ai)
        { float q[4];
#pragma unroll
            for (int m = 0; m < 4; ++m) { const int row = row0 + ai * HALF + m * 16; bf16_t* rowp = Xo + (size_t)row * ldc + col0; float s0 = 0.f, s1 = 0.f;
#pragma unroll
                for (int bj = 0; bj < 2; ++bj) { f32x4 o0, o1; unpack8(old[ai][m][bj], o0, o1);
                    const f32x4 n0 = o0 + acc[ai][bj][m][0], n1 = o1 + acc[ai][bj][m][1]; const u32x4 w = pack8(n0, n1); *(u32x4*)(rowp + bj * HALF) = w; sqacc8(w, s0, s1); }
                q[m] = s0 + s1; }
            atomic_add_ss(ss_out + row0 + ai * HALF + 16 * fq, rs4(q[0], q[1], q[2], q[3])); }
    }
};
struct EpiUp {
    static constexpr bool PERM = true, AFTER_DRAIN = false;
    bf16_t* O; int ldc; const ss_t* ss;
    __device__ __forceinline__ void operator()(const f32x4 (&acc)[2][2][4][2], const Unit& u, int wr, int wc, int fr, int fq) const {
        EPI_ROWCOL
        ss_t sv[2][4];
#pragma unroll
        for (int ai = 0; ai < 2; ++ai)
#pragma unroll
            for (int m = 0; m < 4; ++m) sv[ai][m] = ss[row0 + ai * HALF + m * 16];
#pragma unroll
        for (int ai = 0; ai < 2; ++ai)
#pragma unroll
            for (int m = 0; m < 4; ++m) { const int row = row0 + ai * HALF + m * 16; const float rs = ss_rstd_v(sv[ai][m], 1.0f / 1024.0f); bf16_t* rowp = O + (size_t)row * ldc + col0;
#pragma unroll
                for (int bj = 0; bj < 2; ++bj) { f32x4 v0 = acc[ai][bj][m][0] * rs, v1 = acc[ai][bj][m][1] * rs;
#pragma unroll
                    for (int j = 0; j < 4; ++j) { const float a = fmaxf(v0[j], 0.f), b = fmaxf(v1[j], 0.f); v0[j] = a * a; v1[j] = b * b; }
                    *(u32x4*)(rowp + bj * HALF) = pack8(v0, v1); } }
    }
};
struct EpiPle {
    static constexpr bool PERM = true, AFTER_DRAIN = false;
    bf16_t* O; int ldc; ss_t* ss_out; const float* gpost;
    __device__ __forceinline__ void operator()(const f32x4 (&acc)[2][2][4][2], const Unit& u, int wr, int wc, int fr, int fq) const {
        EPI_ROWCOL
        f32x4 gp[2][2];
#pragma unroll
        for (int bj = 0; bj < 2; ++bj)
#pragma unroll
            for (int n = 0; n < 2; ++n) gp[bj][n] = *(const f32x4*)(gpost + col0 + bj * HALF + 4 * n);
#pragma unroll
        for (int ai = 0; ai < 2; ++ai)
        { float q[4];
#pragma unroll
            for (int m = 0; m < 4; ++m) { const int row = row0 + ai * HALF + m * 16; bf16_t* rowp = O + (size_t)row * ldc + col0; f32x4 sv = {0.f, 0.f, 0.f, 0.f};
#pragma unroll
                for (int bj = 0; bj < 2; ++bj) { const f32x4 a0 = acc[ai][bj][m][0], a1 = acc[ai][bj][m][1]; *(u32x4*)(rowp + bj * HALF) = pack8(a0 * gp[bj][0], a1 * gp[bj][1]);
                    sv += a0 * a0; sv += a1 * a1; }
                q[m] = (sv[0] + sv[1]) + (sv[2] + sv[3]); }
            atomic_add_ss(ss_out + row0 + ai * HALF + 16 * fq, rs4(q[0], q[1], q[2], q[3])); }
    }
};
template <bool LAST> struct EpiGate {
    static constexpr bool PERM = true, AFTER_DRAIN = false;
    const bf16_t* Xin; bf16_t* Xout; float* Fout; const bf16_t* E; int ldc; const ss_t* ss_x; const ss_t* ss_e; ss_t* ss_out;
    __device__ __forceinline__ void operator()(const f32x4 (&acc)[2][2][4][2], const Unit& u, int wr, int wc, int fr, int fq) const {
        EPI_ROWCOL
        u32x4 xo[2][2][2], ev[2][2][2]; ss_t sx[2][2], se[2][2];
#define GATE_LOAD(q_, b_) do { const int ai_ = (q_) >> 1, m0_ = ((q_) & 1) * 2; \
            _Pragma("unroll") for (int mm = 0; mm < 2; ++mm) { const int row_ = row0 + ai_ * HALF + (m0_ + mm) * 16; sx[b_][mm] = ss_x[row_]; se[b_][mm] = ss_e[row_]; \
                _Pragma("unroll") for (int bj = 0; bj < 2; ++bj) { const size_t off_ = (size_t)row_ * ldc + col0 + bj * HALF; xo[b_][mm][bj] = *(const u32x4*)(Xin + off_); ev[b_][mm][bj] = *(const u32x4*)(E + off_); } } } while (0)
        GATE_LOAD(0, 0);
        float q[4] = {0.f, 0.f, 0.f, 0.f};
#pragma unroll
        for (int qtr = 0; qtr < 4; ++qtr) {
            const int ai = qtr >> 1, m0 = (qtr & 1) * 2, cb = qtr & 1;
            if (qtr < 3) GATE_LOAD(qtr + 1, cb ^ 1);
            asm volatile("" ::: "memory");
#pragma unroll
            for (int mm = 0; mm < 2; ++mm) { const int m = m0 + mm; const int row = row0 + ai * HALF + m * 16; const size_t off = (size_t)row * ldc + col0; float s0 = 0.f, s1 = 0.f;
                const float nrsx2 = -1.4426950408889634f * ss_rstd_v(sx[cb][mm], 1.0f / 1024.0f), rse = ss_rstd_v(se[cb][mm], 1.0f / 1024.0f);
#pragma unroll
                for (int bj = 0; bj < 2; ++bj) { f32x4 x0, x1, e0, e1; unpack8(xo[cb][mm][bj], x0, x1); unpack8(ev[cb][mm][bj], e0, e1);
                    f32x4 d0 = acc[ai][bj][m][0] * nrsx2, d1 = acc[ai][bj][m][1] * nrsx2;
#pragma unroll
                    for (int j = 0; j < 4; ++j) { d0[j] = __builtin_amdgcn_exp2f(d0[j]); d1[j] = __builtin_amdgcn_exp2f(d1[j]); }
                    d0 = d0 + 1.f; d1 = d1 + 1.f;
#pragma unroll
                    for (int j = 0; j < 4; ++j) { d0[j] = __builtin_amdgcn_rcpf(d0[j]); d1[j] = __builtin_amdgcn_rcpf(d1[j]); }
                    const f32x4 r0 = x0 + d0 * (e0 * rse), r1 = x1 + d1 * (e1 * rse);
                    if constexpr (LAST) { *(f32x4*)(Fout + off + bj * HALF) = r0; *(f32x4*)(Fout + off + bj * HALF + 4) = r1; }
                    else { const u32x4 w = pack8(r0, r1); *(u32x4*)(Xout + off + bj * HALF) = w; sqacc8(w, s0, s1); } }
                q[m] = s0 + s1; }
            if constexpr (!LAST) { if (qtr & 1) atomic_add_ss(ss_out + row0 + ai * HALF + 16 * fq, rs4(q[0], q[1], q[2], q[3])); } }
#undef GATE_LOAD
    }
};
}

struct Args {
    const float* x; const float* p; const int* pos;
    const float *in_norm_g, *w_in, *b_in, *mlstm_f_bias, *conv_w, *conv_b, *mlstm_norm_g, *hgrn_lb_logits, *hgrn_norm_g, *swa_q_g, *swa_k_g, *swa_sinks, *w_out, *mlp_norm_g, *w_up, *w_down,
        *ple_norm_g, *w_ple_gate, *w_ple_proj, *ple_post_g;
    float* out; unsigned char* ws;
    double rope_rev[8];
    int ph_lo, ph_hi;
};
struct Frame {
    LAS unsigned char* lds; int wave, G, gw, NGW;
    int local, grp, gsz, ceff;
};
typedef const __attribute__((address_space(4))) Args* ArgsP;
__device__ __forceinline__ ArgsP get_args() { ArgsP p = (ArgsP)__builtin_amdgcn_kernarg_segment_ptr(); asm volatile("" : "+s"(p)); return p; }
__device__ __forceinline__ int lane_id() { int x; asm volatile("v_mbcnt_lo_u32_b32 %0, -1, 0\n\tv_mbcnt_hi_u32_b32 %0, -1, %0" : "=v"(x)); return x; }

template <class ColMap>
__device__ __forceinline__ void transpose_item(const float* W, int K, int N, const float* gain, bf16* WT, int nblk, LAS float* scr, int item, int lane, ColMap cm) {
    const int kb = item / nblk, nb = item % nblk, k0 = 64 * kb, n0 = 32 * nb;
    const int src = cm(n0 + (lane & 31));
    float tv[32];
#pragma unroll
    for (int i = 0; i < 32; ++i) { const int kk = 2 * i + (lane >> 5); tv[i] = (src >= 0) ? W[(size_t)(k0 + kk) * N + src] : 0.f; }
#pragma unroll
    for (int i = 0; i < 32; ++i) { const int kk = 2 * i + (lane >> 5); float v = tv[i]; if (gain) v *= gain[k0 + kk]; scr[kk * 33 + (lane & 31)] = v; }
    LDS_WAIT(); asm volatile("" ::: "memory");
    const int c = lane & 7;
#pragma unroll
    for (int j = 0; j < 4; ++j) { const int n = (lane >> 3) + 8 * j; const LAS float* s = scr + (8 * c) * 33 + n;
        v4u o; o.x = pk2(s[0 * 33], s[1 * 33]); o.y = pk2(s[2 * 33], s[3 * 33]); o.z = pk2(s[4 * 33], s[5 * 33]); o.w = pk2(s[6 * 33], s[7 * 33]);
        *(GAS v4u*)(WT + (size_t)(n0 + n) * K + k0 + 8 * c) = o; }
    LDS_WAIT(); asm volatile("" ::: "memory");
}
struct IdMap { __device__ __forceinline__ int operator()(int n) const { return n; } };
struct YMap { __device__ __forceinline__ int operator()(int n) const { return n < 1024 ? n : (n < 2816 ? n + 8 : (n < 2824 ? n - 2816 + 1024 : -1)); } };

__device__ __forceinline__ void p0_prologue(const Frame& F, ArgsP a) {
    unsigned char* ws = a->ws; const int lane = lane_id();
    LAS float* scr = (LAS float*)(F.lds + F.wave * 16384);
    const int gw = F.gw, NGW = F.NGW;
    constexpr int I_IN = 16 * (NY / 32), I_OUT = 16 * 32, I_UP = 16 * (FF / 32), I_DN = 64 * 32, I_G = 16 * 32, I_P = 4 * 32, I_LAYER = I_IN + I_OUT + I_UP + I_DN + I_G + I_P;
    for (int it = gw; it < DEPTH * I_LAYER; it += NGW) {
        const int l = it / I_LAYER; int r = it % I_LAYER;
        if (r < I_IN) { transpose_item(a->w_in + (size_t)l * DM * INW, DM, INW, a->in_norm_g + l * DM, (bf16*)(ws + WS_WIN) + (size_t)l * NY * DM, NY / 32, scr, r, lane, YMap()); continue; } r -= I_IN;
        if (r < I_OUT) { transpose_item(a->w_out + (size_t)l * DM * DM, DM, DM, nullptr, (bf16*)(ws + WS_WOUT) + (size_t)l * DM * DM, DM / 32, scr, r, lane, IdMap()); continue; } r -= I_OUT;
        if (r < I_UP) { transpose_item(a->w_up + (size_t)l * DM * FF, DM, FF, a->mlp_norm_g + l * DM, (bf16*)(ws + WS_WUP) + (size_t)l * FF * DM, FF / 32, scr, r, lane, IdMap()); continue; } r -= I_UP;
        if (r < I_DN) { transpose_item(a->w_down + (size_t)l * FF * DM, FF, DM, nullptr, (bf16*)(ws + WS_WDN) + (size_t)l * DM * FF, DM / 32, scr, r, lane, IdMap()); continue; } r -= I_DN;
        if (r < I_G) { transpose_item(a->w_ple_gate + (size_t)l * DM * DM, DM, DM, a->ple_norm_g + l * DM, (bf16*)(ws + WS_WG) + (size_t)l * DM * DM, DM / 32, scr, r, lane, IdMap()); continue; } r -= I_G;
        transpose_item(a->w_ple_proj + (size_t)l * PLE * DM, PLE, DM, nullptr, (bf16*)(ws + WS_WP) + (size_t)l * DM * PLE, DM / 32, scr, r, lane, IdMap());
    }
    { bf16* XB = (bf16*)(ws + WS_XB0); ss_t* ss = (ss_t*)(ws + WS_STATS) + (size_t)SS_IN * M;
      for (int m0 = gw; m0 < M; m0 += 2 * NGW) { f32x4 v[2][4];
#pragma unroll
          for (int u = 0; u < 2; ++u) { const int mr = m0 + u * NGW; if (mr < M) { const GAS f32x4* xr = (const GAS f32x4*)(a->x + (size_t)mr * DM) + lane;
#pragma unroll
              for (int j = 0; j < 4; ++j) v[u][j] = xr[64 * j]; } }
#pragma unroll
          for (int u = 0; u < 2; ++u) { const int mr = m0 + u * NGW; if (mr < M) { GAS u32x2* o8 = (GAS u32x2*)(XB + (size_t)mr * DM) + lane; float s = 0.f;
#pragma unroll
              for (int j = 0; j < 4; ++j) { u32x2 w; w.x = pk2(v[u][j].x, v[u][j].y); w.y = pk2(v[u][j].z, v[u][j].w); o8[64 * j] = w;
                  const float a0 = bflo(w.x), a1 = bfhi(w.x), a2 = bflo(w.y), a3 = bfhi(w.y); s += (a0 * a0 + a1 * a1) + (a2 * a2 + a3 * a3); }
              s = wave_sum(s); if (lane == 0) ss[mr] = (ss_t)(long long)(s * 16777216.0f); } } } }
    { const size_t n8 = (size_t)DEPTH * M * PLE / 8; bf16* PB = (bf16*)a->out;
      for (size_t i0 = (size_t)gw * 64 + lane; i0 < n8; i0 += (size_t)NGW * 64 * 4) { f32x4 v0[4], v1[4];
#pragma unroll
          for (int u = 0; u < 4; ++u) { const size_t i = i0 + (size_t)u * NGW * 64; if (i < n8) { v0[u] = *(const GAS f32x4*)(a->p + i * 8); v1[u] = *(const GAS f32x4*)(a->p + i * 8 + 4); } }
#pragma unroll
          for (int u = 0; u < 4; ++u) { const size_t i = i0 + (size_t)u * NGW * 64; if (i < n8) { v4u w; w.x = pk2(v0[u].x, v0[u].y); w.y = pk2(v0[u].z, v0[u].w); w.z = pk2(v1[u].x, v1[u].y); w.w = pk2(v1[u].z, v1[u].w);
              const size_t l_ = i / ((size_t)M * 32), rem_ = i % ((size_t)M * 32), m_ = rem_ >> 5, k8_ = rem_ & 31; *(GAS v4u*)(PB + m_ * 2048 + l_ * 256 + k8_ * 8) = w; } } } }
    { float* rope = (float*)(ws + WS_ROPE);
      for (int i = gw * 64 + lane; i < M * 8; i += NGW * 64) { const int m = i >> 3, f = i & 7; double rev = (double)a->pos[m] * a->rope_rev[f]; rev -= __builtin_floor(rev); const float fr = (float)rev;
          rope[2 * i] = __builtin_amdgcn_cosf(fr); rope[2 * i + 1] = __builtin_amdgcn_sinf(fr); } }
    { float* by = (float*)(ws + WS_BIASY); YMap ym;
      for (int i = gw * 64 + lane; i < DEPTH * NY; i += NGW * 64) { const int l = i / NY, c = i % NY, s = ym(c); by[i] = s >= 0 ? a->b_in[l * INW + s] : 0.f; } }
}

__device__ __forceinline__ bf16x8 ld_frag(const LAS bf16* tile, int ld, int r0, int k0, int lane) { return *(const LAS bf16x8*)(tile + (r0 + (lane & 15)) * ld + k0 + 8 * (lane >> 4)); }
template <int K>
__device__ __forceinline__ f32x4 mma_tile(f32x4 acc, const LAS bf16* A, int lda, int r0, const LAS bf16* Bt, int ldb, int c0, int lane) {
#pragma unroll
    for (int k0 = 0; k0 < K; k0 += 32) acc = __builtin_amdgcn_mfma_f32_16x16x32_bf16(ld_frag(A, lda, r0, k0, lane), ld_frag(Bt, ldb, c0, k0, lane), acc, 0, 0, 0);
    return acc;
}
typedef short v4i16_t __attribute__((ext_vector_type(4)));
__device__ __forceinline__ bf16x8 ld_frag_tr(const LAS bf16* tile, int ld, int k0, int c0, int lane) {
    const int g = lane >> 4, q = (lane >> 2) & 3, p = lane & 3;
    const LAS bf16* p0 = tile + (k0 + 8 * g + q) * ld + c0 + 4 * p;
    const v4i16_t lo = __builtin_amdgcn_ds_read_tr16_b64_v4i16((LAS v4i16_t*)p0), hi = __builtin_amdgcn_ds_read_tr16_b64_v4i16((LAS v4i16_t*)(p0 + 4 * ld));
    return (bf16x8){lo[0], lo[1], lo[2], lo[3], hi[0], hi[1], hi[2], hi[3]};
}
template <int K>
__device__ __forceinline__ f32x4 mma_tile_nt(f32x4 acc, const LAS bf16* A, int lda, int r0, const LAS bf16* T, int ldt, int c0, int lane) {
#pragma unroll
    for (int k0 = 0; k0 < K; k0 += 32) acc = __builtin_amdgcn_mfma_f32_16x16x32_bf16(ld_frag(A, lda, r0, k0, lane), ld_frag_tr(T, ldt, k0, c0, lane), acc, 0, 0, 0);
    return acc;
}
template <int K>
__device__ __forceinline__ f32x4 mma_tile_tt(f32x4 acc, const LAS bf16* TA, int lda, int r0, const LAS bf16* TB, int ldb, int c0, int lane) {
#pragma unroll
    for (int k0 = 0; k0 < K; k0 += 32) acc = __builtin_amdgcn_mfma_f32_16x16x32_bf16(ld_frag_tr(TA, lda, k0, r0, lane), ld_frag_tr(TB, ldb, k0, c0, lane), acc, 0, 0, 0);
    return acc;
}
typedef float f32x2_t __attribute__((ext_vector_type(2))); typedef __bf16 bf16x2_t __attribute__((ext_vector_type(2)));
__device__ __forceinline__ unsigned cvtpk(float lo, float hi) { const f32x2_t v = {lo, hi}; return __builtin_bit_cast(unsigned, __builtin_convertvector(v, bf16x2_t)); }
__device__ __forceinline__ bf16 hbf(float x) { return (bf16)cvtpk(x, x); }
template <int CTRL> __device__ __forceinline__ float dpp_f(float v) { return __builtin_bit_cast(float, __builtin_amdgcn_mov_dpp(__builtin_bit_cast(int, v), CTRL, 0xF, 0xF, true)); }
template <int CTRL, int ROWMASK> __device__ __forceinline__ float dpp_id(float v, float ident) { return __builtin_bit_cast(float, __builtin_amdgcn_update_dpp(__builtin_bit_cast(int, ident), __builtin_bit_cast(int, v), CTRL, ROWMASK, 0xF, false)); }
__device__ __forceinline__ float red8_sum(float v) { v += dpp_f<0xB1>(v); v += dpp_f<0x4E>(v); v += dpp_f<0x141>(v); return v; }
__device__ __forceinline__ float red16_sum(float v) { v = red8_sum(v); v += dpp_f<0x140>(v); return v; }
__device__ __forceinline__ float red16_max(float v) { v = fmaxf(v, dpp_f<0xB1>(v)); v = fmaxf(v, dpp_f<0x4E>(v)); v = fmaxf(v, dpp_f<0x141>(v)); v = fmaxf(v, dpp_f<0x140>(v)); return v; }
__device__ __forceinline__ float xor16_partner(float x, int lane) { auto r = __builtin_amdgcn_permlane16_swap(__float_as_uint(x), __float_as_uint(x), false, false); return __uint_as_float((lane & 16) ? r[0] : r[1]); }
__device__ __forceinline__ float red_x16x32_sum(float x) { auto r = __builtin_amdgcn_permlane16_swap(__float_as_uint(x), __float_as_uint(x), false, false); x = __uint_as_float(r[0]) + __uint_as_float(r[1]);
    auto q = __builtin_amdgcn_permlane32_swap(__float_as_uint(x), __float_as_uint(x), false, false); return __uint_as_float(q[0]) + __uint_as_float(q[1]); }
__device__ __forceinline__ float scan_add(float v, int) { v += dpp_id<0x111, 0xF>(v, 0.f); v += dpp_id<0x112, 0xF>(v, 0.f); v += dpp_id<0x114, 0xF>(v, 0.f); v += dpp_id<0x118, 0xF>(v, 0.f); v += dpp_id<0x142, 0xA>(v, 0.f); v += dpp_id<0x143, 0xC>(v, 0.f); return v; }
__device__ __forceinline__ float scan_max(float v, int) { const float ni = -INFINITY; v = fmaxf(v, dpp_id<0x111, 0xF>(v, ni)); v = fmaxf(v, dpp_id<0x112, 0xF>(v, ni)); v = fmaxf(v, dpp_id<0x114, 0xF>(v, ni)); v = fmaxf(v, dpp_id<0x118, 0xF>(v, ni));
    v = fmaxf(v, dpp_id<0x142, 0xA>(v, ni)); v = fmaxf(v, dpp_id<0x143, 0xC>(v, ni)); return v; }
#define LBAR() asm volatile("s_waitcnt lgkmcnt(0)\n\ts_barrier" ::: "memory")
__device__ __forceinline__ float fexp(float x) { return __builtin_amdgcn_exp2f(x * 1.4426950408889634f); }
__device__ __forceinline__ float frcp(float x) { return __builtin_amdgcn_rcpf(x); }
__device__ __forceinline__ float fsig(float x) { return frcp(1.f + fexp(-x)); }

__device__ __forceinline__ void mlstm_task(const Frame& F, ArgsP a, int layer, int bh) {
    const int tid_ = F.wave * 64 + lane_id(); const int b = bh >> 2, h = bh & 3, tid = tid_, lane = tid & 63, w = F.wave;
    const bf16* Y = (const bf16*)(a->ws + WS_BIG) + (size_t)b * (Y_BLK / 2); bf16* MIX = (bf16*)(a->ws + WS_MIX) + (size_t)b * (MIX_BLK / 2);
    constexpr int LD = 72, TILE = 64 * LD, CTSZ = 80 * LD;
    LAS bf16* tiles = (LAS bf16*)(F.lds);
    LAS bf16* ctsb = tiles + 8 * TILE;
    LAS float* arr = (LAS float*)(ctsb + 2 * CTSZ);
    LAS float* cw = arr + 3 * 400;
#define MT(p_, k_) (tiles + ((p_) * 4 + (k_)) * TILE)
    const int j = tid >> 3, d8 = (tid & 7) * 8;
    for (int i = tid; i < 2 * CTSZ; i += 512) ctsb[i] = 0;
    if (tid < 64) { cw[512 + tid] = a->conv_b[layer * 512 + h * 64 + tid]; cw[576 + tid] = a->conv_b[layer * 512 + 256 + h * 64 + tid]; }
    if (tid < 256) { const int tap = tid >> 6, d = tid & 63; cw[tap * 64 + d] = a->conv_w[(layer * 4 + tap) * 512 + h * 64 + d]; cw[256 + tap * 64 + d] = a->conv_w[(layer * 4 + tap) * 512 + 256 + h * 64 + d]; }
    const float fbias = a->mlstm_f_bias[layer * 4 + h];
    const int cl = lane & 15, g = lane >> 4;
    float gnr[16];
#pragma unroll
    for (int et = 0; et < 4; ++et)
#pragma unroll
        for (int i = 0; i < 4; ++i) gnr[et * 4 + i] = a->mlstm_norm_g[layer * 256 + h * 64 + 16 * et + 4 * g + i];
    f32x4 Ct[5];
#pragma unroll
    for (int et = 0; et < 5; ++et) Ct[et] = (f32x4){0.f, 0.f, 0.f, 0.f};
    float mcar = 0.f;
    u32x4 rq[4], rk[4], rv; u32x2 rog[4]; unsigned short rgi = 0, rgf = 0;
    const u32x4 zero4 = {0u, 0u, 0u, 0u};
#define MLSTM_LOAD(c_) do { const int t_ = (c_) * 64 + j; const bf16* yr_ = Y + ((size_t)b * SEQ + t_) * NY; \
        _Pragma("unroll") for (int tap = 0; tap < 4; ++tap) { if (t_ - 3 + tap >= 0) { rq[tap] = *(const u32x4*)(yr_ + (tap - 3) * NY + YC_MQ + h * 64 + d8); rk[tap] = *(const u32x4*)(yr_ + (tap - 3) * NY + YC_MK + h * 64 + d8); } else { rq[tap] = zero4; rk[tap] = zero4; } } \
        rv = *(const u32x4*)(yr_ + YC_MV + h * 64 + d8); } while (0)
#define MLSTM_LOAD_NC(c_) do { const int t_ = (c_) * 64 + j; const bf16* yr_ = Y + ((size_t)b * SEQ + t_) * NY; \
        _Pragma("unroll") for (int tap = 0; tap < 4; ++tap) { rq[tap] = *(const u32x4*)(yr_ + (tap - 3) * NY + YC_MQ + h * 64 + d8); rk[tap] = *(const u32x4*)(yr_ + (tap - 3) * NY + YC_MK + h * 64 + d8); } \
        rv = *(const u32x4*)(yr_ + YC_MV + h * 64 + d8); } while (0)
#define MLSTM_LOAD_OG(c_) do { const bf16* yo_ = Y + ((size_t)b * SEQ + (c_) * 64 + 16 * (w & 3) + cl) * NY + YC_MO + h * 64 + 4 * g; \
        _Pragma("unroll") for (int et = 0; et < 4; ++et) rog[et] = *(const u32x2*)(yo_ + 16 * et); } while (0)
#define MLSTM_LOAD_G(c_) do { const bf16* yl_ = Y + ((size_t)b * SEQ + (c_) * 64 + lane) * NY; rgi = yl_[YC_MI + h]; rgf = yl_[YC_MF + h]; } while (0)
#define MLSTM_SCAN(c_) do { LAS float* A_ = arr + ((c_) % 3) * 400; const float ip_ = bf2f(rgi), lf_ = logsigmoid_f(bf2f(rgf) + fbias); const float bc_ = scan_add(lf_, lane), g_ = ip_ - bc_, cm_ = scan_max(g_, lane), av_ = fmaxf(mcar, cm_); \
        const float a63_ = __builtin_bit_cast(float, __builtin_amdgcn_readlane(__builtin_bit_cast(int, av_), 63)), b63_ = __builtin_bit_cast(float, __builtin_amdgcn_readlane(__builtin_bit_cast(int, bc_), 63)); \
        A_[lane] = av_; A_[64 + lane] = g_; A_[128 + lane] = fexp(mcar - av_); A_[192 + lane] = fexp(-(bc_ + av_)); A_[256 + lane] = fexp(g_ - a63_); if (lane == 0) A_[320] = fexp(mcar - a63_); mcar = b63_ + a63_; } while (0)
#define MLSTM_BUILD(c_, p_) do { const LAS float* A_ = arr + ((c_) % 3) * 400; float qa[8], ka[8]; \
        _Pragma("unroll") for (int i = 0; i < 8; ++i) { qa[i] = cw[512 + d8 + i]; ka[i] = cw[576 + d8 + i]; } \
        _Pragma("unroll") for (int tap = 0; tap < 4; ++tap) { f32x4 q0, q1, k0, k1; pg8::unpack8(rq[tap], q0, q1); pg8::unpack8(rk[tap], k0, k1); \
            _Pragma("unroll") for (int i = 0; i < 4; ++i) { qa[i] += cw[tap * 64 + d8 + i] * q0[i]; qa[4 + i] += cw[tap * 64 + d8 + 4 + i] * q1[i]; ka[i] += cw[256 + tap * 64 + d8 + i] * k0[i]; ka[4 + i] += cw[256 + tap * 64 + d8 + 4 + i] * k1[i]; } } \
        f32x4 q0, q1, k0, k1, kw0, kw1; const float wsj = A_[256 + j]; \
        _Pragma("unroll") for (int i = 0; i < 4; ++i) { q0[i] = qa[i] * fsig(qa[i]); q1[i] = qa[4 + i] * fsig(qa[4 + i]); k0[i] = ka[i] * fsig(ka[i]) * 0.125f; k1[i] = ka[4 + i] * fsig(ka[4 + i]) * 0.125f; kw0[i] = k0[i] * wsj; kw1[i] = k1[i] * wsj; } \
        *(LAS u32x4*)(MT(p_, 0) + j * LD + d8) = pg8::pack8(q0, q1); *(LAS u32x4*)(MT(p_, 1) + j * LD + d8) = pg8::pack8(k0, k1); *(LAS u32x4*)(MT(p_, 2) + j * LD + d8) = pg8::pack8(kw0, kw1); *(LAS u32x4*)(MT(p_, 3) + j * LD + d8) = rv; } while (0)
    { const int t_ = j; const bf16* yb_ = Y + (size_t)b * SEQ * NY;
#pragma unroll
      for (int tap = 0; tap < 4; ++tap) { const bf16* yr_ = yb_ + (size_t)max(t_ - 3 + tap, 0) * NY; rq[tap] = *(const u32x4*)(yr_ + YC_MQ + h * 64 + d8); rk[tap] = *(const u32x4*)(yr_ + YC_MK + h * 64 + d8); }
      rv = *(const u32x4*)(yb_ + (size_t)t_ * NY + YC_MV + h * 64 + d8);
#pragma unroll
      for (int tap = 0; tap < 4; ++tap) if (t_ - 3 + tap < 0) { rq[tap] = zero4; rk[tap] = zero4; } }
    MLSTM_LOAD_G(0); if (w == 4) MLSTM_SCAN(0);
    MLSTM_LOAD_G(1); if (w == 4) MLSTM_SCAN(1);
    LBAR();
    MLSTM_BUILD(0, 0);
    MLSTM_LOAD_NC(1);
    MLSTM_LOAD_G(2);
    LBAR();
    for (int c = 0; c < SEQ / 64; ++c) {
        const int p = c & 1;
        if (c + 1 < SEQ / 64) MLSTM_BUILD(c + 1, p ^ 1);
        MLSTM_LOAD_NC(min(c + 2, SEQ / 64 - 1)); MLSTM_LOAD_OG(c);
        asm volatile("" ::: "memory");
        const LAS float* A3 = arr + (c % 3) * 400;
        if (w < 4) {
            const int jt = w, jq = 16 * jt + cl; const LAS bf16* Qp = MT(p, 0); const LAS bf16* Kp = MT(p, 1); const LAS bf16* Vp = MT(p, 3); const LAS bf16* Cp = ctsb + p * CTSZ;
            const float aj = A3[jq], wj = A3[128 + jq], ej = A3[192 + jq];
            const bf16x8 qb0 = ld_frag(Qp, LD, 16 * jt, 0, lane), qb1 = ld_frag(Qp, LD, 16 * jt, 32, lane);
            f32x4 pt[4]; float dsum = 0.f;
#pragma unroll
            for (int st = 0; st < 4; ++st) { pt[st] = (f32x4){0.f, 0.f, 0.f, 0.f};
                if (st <= jt) { f32x4 s_ = (f32x4){0.f, 0.f, 0.f, 0.f};
                    s_ = __builtin_amdgcn_mfma_f32_16x16x32_bf16(ld_frag(Kp, LD, 16 * st, 0, lane), qb0, s_, 0, 0, 0); s_ = __builtin_amdgcn_mfma_f32_16x16x32_bf16(ld_frag(Kp, LD, 16 * st, 32, lane), qb1, s_, 0, 0, 0);
                    const f32x4 gs = *(const LAS f32x4*)(A3 + 64 + 16 * st + 4 * g);
#pragma unroll
                    for (int i = 0; i < 4; ++i) { const bool ok = (st < jt) || (4 * g + i <= cl); const float pv = ok ? s_[i] * fexp(gs[i] - aj) : 0.f; pt[st][i] = pv; dsum += pv; } } }
            bf16x8 pf[2];
#pragma unroll
            for (int t = 0; t < 2; ++t) { u32x4 pw; pw.x = cvtpk(pt[2 * t][0], pt[2 * t][1]); pw.y = cvtpk(pt[2 * t][2], pt[2 * t][3]); pw.z = cvtpk(pt[2 * t + 1][0], pt[2 * t + 1][1]); pw.w = cvtpk(pt[2 * t + 1][2], pt[2 * t + 1][3]); pf[t] = __builtin_bit_cast(bf16x8, pw); }
            f32x4 acc[5];
#pragma unroll
            for (int et = 0; et < 5; ++et) { acc[et] = (f32x4){0.f, 0.f, 0.f, 0.f}; acc[et] = __builtin_amdgcn_mfma_f32_16x16x32_bf16(ld_frag(Cp, LD, 16 * et, 0, lane), qb0, acc[et], 0, 0, 0); acc[et] = __builtin_amdgcn_mfma_f32_16x16x32_bf16(ld_frag(Cp, LD, 16 * et, 32, lane), qb1, acc[et], 0, 0, 0); }
            const float qn = red_x16x32_sum(acc[4][0]);
#pragma unroll
            for (int et = 0; et < 4; ++et) acc[et] = acc[et] * wj;
            { const int tq = (lane >> 2) & 3, tp = lane & 3;
#pragma unroll
              for (int t = 0; t < 2; ++t) { if (2 * t <= jt) { const LAS bf16* vb = Vp + (32 * t + 4 * g + tq) * LD + 4 * tp;
#pragma unroll
                  for (int et = 0; et < 4; ++et) { const v4i16_t lo = __builtin_amdgcn_ds_read_tr16_b64_v4i16((LAS v4i16_t*)(vb + 16 * et)), hi = __builtin_amdgcn_ds_read_tr16_b64_v4i16((LAS v4i16_t*)(vb + 16 * LD + 16 * et));
                      const bf16x8 vf = {lo[0], lo[1], lo[2], lo[3], hi[0], hi[1], hi[2], hi[3]}; acc[et] = __builtin_amdgcn_mfma_f32_16x16x32_bf16(vf, pf[t], acc[et], 0, 0, 0); } } } }
            const float den = red_x16x32_sum(dsum) + wj * qn; const float rinv = frcp(fmaxf(fabsf(den), ej));
            float ss = 0.f;
#pragma unroll
            for (int et = 0; et < 4; ++et) { acc[et] = acc[et] * rinv; ss += (acc[et][0] * acc[et][0] + acc[et][1] * acc[et][1]) + (acc[et][2] * acc[et][2] + acc[et][3] * acc[et][3]); }
            ss = red_x16x32_sum(ss); const float rs = rsqrtf(ss * (1.0f / 64.0f) + EPS);
            bf16* orow = MIX + ((size_t)b * SEQ + c * 64 + jq) * DM + h * 64 + 4 * g;
#pragma unroll
            for (int et = 0; et < 4; ++et) { const float o0 = bflo(rog[et].x), o1 = bfhi(rog[et].x), o2 = bflo(rog[et].y), o3 = bfhi(rog[et].y); u32x2 ov;
                ov.x = cvtpk(acc[et][0] * rs * gnr[4 * et] * fsig(o0), acc[et][1] * rs * gnr[4 * et + 1] * fsig(o1)); ov.y = cvtpk(acc[et][2] * rs * gnr[4 * et + 2] * fsig(o2), acc[et][3] * rs * gnr[4 * et + 3] * fsig(o3));
                *(u32x2*)(orow + 16 * et) = ov; }
        } else {
            const int dt = w - 4; const LAS bf16* Vp = MT(p, 3); const LAS bf16* Kwp = MT(p, 2); const float decay = A3[320];
            const unsigned one8 = (cl == 0) ? 0x3f803f80u : 0u; const u32x4 onew = {one8, one8, one8, one8}; const bf16x8 onesf = __builtin_bit_cast(bf16x8, onew);
            const bf16x8 kb0 = ld_frag_tr(Kwp, LD, 0, 16 * dt, lane), kb1 = ld_frag_tr(Kwp, LD, 32, 16 * dt, lane);
#pragma unroll
            for (int et = 0; et < 5; ++et) { Ct[et] = Ct[et] * decay;
                const bf16x8 va0 = (et < 4) ? ld_frag_tr(Vp, LD, 0, 16 * et, lane) : onesf, va1 = (et < 4) ? ld_frag_tr(Vp, LD, 32, 16 * et, lane) : onesf;
                Ct[et] = __builtin_amdgcn_mfma_f32_16x16x32_bf16(va0, kb0, Ct[et], 0, 0, 0); Ct[et] = __builtin_amdgcn_mfma_f32_16x16x32_bf16(va1, kb1, Ct[et], 0, 0, 0); }
            { LAS bf16* Cn = ctsb + (p ^ 1) * CTSZ;
#pragma unroll
              for (int et = 0; et < 4; ++et)
#pragma unroll
                  for (int i = 0; i < 4; ++i) Cn[(16 * et + 4 * g + i) * LD + 16 * dt + cl] = hbf(Ct[et][i]);
              if (g == 0) Cn[64 * LD + 16 * dt + cl] = hbf(Ct[4][0]); }
            if (w == 4 && c + 2 < SEQ / 64) MLSTM_SCAN(c + 2);
        }
        MLSTM_LOAD_G(min(c + 3, SEQ / 64 - 1));
        LBAR();
    }
#undef MLSTM_LOAD_NC
#undef MT
#undef MLSTM_LOAD
#undef MLSTM_LOAD_OG
#undef MLSTM_LOAD_G
#undef MLSTM_SCAN
#undef MLSTM_BUILD
}

__device__ __forceinline__ void hgrn_task(const Frame& F, ArgsP a, int layer, int bh) {
    const int tid_ = F.wave * 64 + lane_id(); const int b = bh >> 2, h = bh & 3, tid = tid_, lane = tid & 63, w = F.wave;
    const bf16* Y = (const bf16*)(a->ws + WS_BIG) + (size_t)b * (Y_BLK / 2); bf16* MIX = (bf16*)(a->ws + WS_MIX) + (size_t)b * (MIX_BLK / 2);
    constexpr int LD = 72, TILE = 64 * LD;
    LAS bf16* tiles = (LAS bf16*)(F.lds);
    LAS bf16* stb = tiles + 12 * TILE;
    LAS float* part = (LAS float*)(stb + 2 * TILE);
    LAS float* egb = part + 2 * 1024;
#define HT(p_, k_) (tiles + ((p_) * 6 + (k_)) * TILE)
    const int dp = tid & 31, d0 = 2 * dp, rgrp = tid >> 5, cl = lane & 15, g = lane >> 4;
    float lbv[2], omlv[2];
#pragma unroll
    for (int ch = 0; ch < 2; ++ch) { const int cidx = h * 64 + d0 + ch; float z[4]; float zm = -INFINITY;
#pragma unroll
      for (int q = 0; q < 4; ++q) { z[q] = a->hgrn_lb_logits[q * 256 + cidx]; zm = fmaxf(zm, z[q]); }
      float e[4], es = 0.f;
#pragma unroll
      for (int q = 0; q < 4; ++q) { e[q] = expf(z[q] - zm); es += e[q]; }
      float cum = 0.f, lb = 0.f;
#pragma unroll
      for (int q = 0; q < 4; ++q) { cum += e[q] / es; if (q == layer) lb = cum; }
      lb -= e[0] / es; if (layer == 0) lb = 0.f;
      lbv[ch] = lb; omlv[ch] = 1.f - lb; }
    for (int i = tid; i < 2 * TILE; i += 512) stb[i] = 0;
    float gnr[16];
#pragma unroll
    for (int et = 0; et < 4; ++et)
#pragma unroll
        for (int i = 0; i < 4; ++i) gnr[et * 4 + i] = a->hgrn_norm_g[layer * 256 + h * 64 + 16 * et + 4 * g + i];
    f32x4 Sr[4];
#pragma unroll
    for (int et = 0; et < 4; ++et) Sr[et] = (f32x4){0.f, 0.f, 0.f, 0.f};
    unsigned rq[4], rf[4], rv[4]; u32x2 rgt[4];
    float qf[4][2], ky[4][2], cs[4][2]; unsigned vraw[4];
#define HGRN_LOAD(c_) do { const bf16* yb_ = Y + ((size_t)b * SEQ + (c_) * 64 + 4 * rgrp) * NY + h * 64 + d0; \
        _Pragma("unroll") for (int r = 0; r < 4; ++r) { rq[r] = *(const unsigned*)(yb_ + r * NY + YC_HQ); rf[r] = *(const unsigned*)(yb_ + r * NY + YC_HF); rv[r] = *(const unsigned*)(yb_ + r * NY + YC_HI); } } while (0)
#define HGRN_LOAD_GATE(c_) do { const bf16* yo_ = Y + ((size_t)b * SEQ + (c_) * 64 + 16 * (w & 3) + cl) * NY + YC_HG + h * 64 + 4 * g; \
        _Pragma("unroll") for (int et = 0; et < 4; ++et) rgt[et] = *(const u32x2*)(yo_ + 16 * et); } while (0)
#define HGRN_A1(c_) do { float run0 = 0.f, run1 = 0.f; \
        _Pragma("unroll") for (int r = 0; r < 4; ++r) { vraw[r] = rv[r]; \
            { const float qv = bflo(rq[r]), fv = fmaxf(bflo(rf[r]), -80.f); qf[r][0] = qv * fsig(qv); const float t = fexp(-fv), sf = frcp(1.f + t); ky[r][0] = omlv[0] * t * sf; run0 += __builtin_amdgcn_logf(lbv[0] + omlv[0] * sf); cs[r][0] = run0; } \
            { const float qv = bfhi(rq[r]), fv = fmaxf(bfhi(rf[r]), -80.f); qf[r][1] = qv * fsig(qv); const float t = fexp(-fv), sf = frcp(1.f + t); ky[r][1] = omlv[1] * t * sf; run1 += __builtin_amdgcn_logf(lbv[1] + omlv[1] * sf); cs[r][1] = run1; } } \
        *(LAS f32x2_t*)(part + ((c_) & 1) * 1024 + rgrp * 64 + d0) = (f32x2_t){run0, run1}; } while (0)
#define HGRN_TILES(c_, p_) do { const LAS float* P_ = part + ((c_) & 1) * 1024 + d0; f32x2_t pco[8]; f32x2_t acc_ = {0.f, 0.f}, pre = {0.f, 0.f}; \
        _Pragma("unroll") for (int q = 0; q < 16; ++q) { if (q == rgrp) pre = acc_; acc_ += *(const LAS f32x2_t*)(P_ + q * 64); if (q & 1) pco[q >> 1] = acc_; }        \
        const f32x2_t g31 = pco[3], g63 = pco[7], gmid = (rgrp < 8) ? pco[1] : pco[5]; \
        _Pragma("unroll") for (int r = 0; r < 4; ++r) { const int l = 4 * rgrp + r; float vqt[2], vxa[2], vqc[2], vkc[2], vkr[2]; \
            _Pragma("unroll") for (int ch = 0; ch < 2; ++ch) { const float G = pre[ch] + cs[r][ch]; \
                vqt[ch] = qf[r][ch] * __builtin_amdgcn_exp2f(G); vkr[ch] = ky[r][ch] * __builtin_amdgcn_exp2f(g63[ch] - G); \
                vxa[ch] = (rgrp < 8) ? ky[r][ch] * __builtin_amdgcn_exp2f(g31[ch] - G) : qf[r][ch] * __builtin_amdgcn_exp2f(G - g31[ch]); \
                const float dm = fminf(fmaxf(G - gmid[ch], -86.f), 86.f); vqc[ch] = qf[r][ch] * __builtin_amdgcn_exp2f(dm); vkc[ch] = ky[r][ch] * __builtin_amdgcn_exp2f(-dm); } \
            *(LAS unsigned*)(HT(p_, 0) + l * LD + d0) = cvtpk(vqt[0], vqt[1]); *(LAS unsigned*)(HT(p_, 1) + l * LD + d0) = cvtpk(vxa[0], vxa[1]); *(LAS unsigned*)(HT(p_, 2) + l * LD + d0) = cvtpk(vqc[0], vqc[1]); \
            *(LAS unsigned*)(HT(p_, 3) + l * LD + d0) = cvtpk(vkc[0], vkc[1]); *(LAS unsigned*)(HT(p_, 4) + l * LD + d0) = cvtpk(vkr[0], vkr[1]); *(LAS unsigned*)(HT(p_, 5) + l * LD + d0) = vraw[r]; } \
        if (rgrp == 0) *(LAS f32x2_t*)(egb + ((c_) & 1) * 64 + d0) = (f32x2_t){__builtin_amdgcn_exp2f(g63[0]), __builtin_amdgcn_exp2f(g63[1])}; } while (0)
    HGRN_LOAD(0); HGRN_A1(0); HGRN_LOAD(1);
    LBAR();
    HGRN_TILES(0, 0); HGRN_A1(1); HGRN_LOAD(2);
    LBAR();
    for (int c = 0; c < SEQ / 64; ++c) {
        const int p = c & 1;
        if (c + 1 < SEQ / 64) HGRN_TILES(c + 1, p ^ 1);
        if (c + 2 < SEQ / 64) HGRN_A1(c + 2);
        HGRN_LOAD(min(c + 3, SEQ / 64 - 1)); HGRN_LOAD_GATE(c);
        asm volatile("" ::: "memory");
        if (w < 4) {
            const int rt = w; const LAS bf16* QTp = HT(p, 0); const LAS bf16* XAp = HT(p, 1); const LAS bf16* QCp = HT(p, 2); const LAS bf16* KCp = HT(p, 3); const LAS bf16* VRp = HT(p, 5); const LAS bf16* Sp = stb + p * TILE;
            f32x4 at[4];
#pragma unroll
            for (int st = 0; st < 4; ++st) { at[st] = (f32x4){0.f, 0.f, 0.f, 0.f};
                if (st <= rt) { const bool same = ((st >> 1) == (rt >> 1)); const LAS bf16* Aop = same ? KCp : XAp; const LAS bf16* Bop = same ? QCp : XAp;
                    f32x4 s_ = (f32x4){0.f, 0.f, 0.f, 0.f}; s_ = mma_tile<64>(s_, Aop, LD, 16 * st, Bop, LD, 16 * rt, lane);
#pragma unroll
                    for (int i = 0; i < 4; ++i) at[st][i] = ((st < rt) || (4 * g + i <= cl)) ? s_[i] : 0.f; } }
            bf16x8 pf[2];
#pragma unroll
            for (int t = 0; t < 2; ++t) { u32x4 pw; pw.x = cvtpk(at[2 * t][0], at[2 * t][1]); pw.y = cvtpk(at[2 * t][2], at[2 * t][3]); pw.z = cvtpk(at[2 * t + 1][0], at[2 * t + 1][1]); pw.w = cvtpk(at[2 * t + 1][2], at[2 * t + 1][3]); pf[t] = __builtin_bit_cast(bf16x8, pw); }
            f32x4 acc[4];
            { const bf16x8 qb0 = ld_frag(QTp, LD, 16 * rt, 0, lane), qb1 = ld_frag(QTp, LD, 16 * rt, 32, lane);
#pragma unroll
              for (int et = 0; et < 4; ++et) { acc[et] = (f32x4){0.f, 0.f, 0.f, 0.f}; acc[et] = __builtin_amdgcn_mfma_f32_16x16x32_bf16(ld_frag(Sp, LD, 16 * et, 0, lane), qb0, acc[et], 0, 0, 0); acc[et] = __builtin_amdgcn_mfma_f32_16x16x32_bf16(ld_frag(Sp, LD, 16 * et, 32, lane), qb1, acc[et], 0, 0, 0); } }
            { const int tq = (lane >> 2) & 3, tp = lane & 3;
#pragma unroll
              for (int t = 0; t < 2; ++t) { if (2 * t <= rt) { const LAS bf16* vb = VRp + (32 * t + 4 * g + tq) * LD + 4 * tp;
#pragma unroll
                  for (int et = 0; et < 4; ++et) { const v4i16_t lo = __builtin_amdgcn_ds_read_tr16_b64_v4i16((LAS v4i16_t*)(vb + 16 * et)), hi = __builtin_amdgcn_ds_read_tr16_b64_v4i16((LAS v4i16_t*)(vb + 16 * LD + 16 * et));
                      const bf16x8 vf = {lo[0], lo[1], lo[2], lo[3], hi[0], hi[1], hi[2], hi[3]}; acc[et] = __builtin_amdgcn_mfma_f32_16x16x32_bf16(vf, pf[t], acc[et], 0, 0, 0); } } } }
            float ss = 0.f;
#pragma unroll
            for (int et = 0; et < 4; ++et) ss += (acc[et][0] * acc[et][0] + acc[et][1] * acc[et][1]) + (acc[et][2] * acc[et][2] + acc[et][3] * acc[et][3]);
            ss = red_x16x32_sum(ss); const float rs = rsqrtf(ss * (1.0f / 64.0f) + EPS);
            bf16* orow = MIX + ((size_t)b * SEQ + c * 64 + 16 * rt + cl) * DM + 256 + h * 64 + 4 * g;
#pragma unroll
            for (int et = 0; et < 4; ++et) { const float g0 = bflo(rgt[et].x), g1 = bfhi(rgt[et].x), g2 = bflo(rgt[et].y), g3 = bfhi(rgt[et].y); u32x2 ov;
                ov.x = cvtpk(acc[et][0] * rs * gnr[4 * et] * (g0 * fsig(g0)), acc[et][1] * rs * gnr[4 * et + 1] * (g1 * fsig(g1))); ov.y = cvtpk(acc[et][2] * rs * gnr[4 * et + 2] * (g2 * fsig(g2)), acc[et][3] * rs * gnr[4 * et + 3] * (g3 * fsig(g3)));
                *(u32x2*)(orow + 16 * et) = ov; }
        } else {
            const int dt = w - 4; const LAS bf16* KRp = HT(p, 4); const LAS bf16* VRp = HT(p, 5); const float egd = egb[p * 64 + 16 * dt + cl];
            const bf16x8 kb0 = ld_frag_tr(KRp, LD, 0, 16 * dt, lane), kb1 = ld_frag_tr(KRp, LD, 32, 16 * dt, lane);
            LAS bf16* Sn = stb + (p ^ 1) * TILE;
#pragma unroll
            for (int et = 0; et < 4; ++et) { Sr[et] = Sr[et] * egd; Sr[et] = __builtin_amdgcn_mfma_f32_16x16x32_bf16(ld_frag_tr(VRp, LD, 0, 16 * et, lane), kb0, Sr[et], 0, 0, 0); Sr[et] = __builtin_amdgcn_mfma_f32_16x16x32_bf16(ld_frag_tr(VRp, LD, 32, 16 * et, lane), kb1, Sr[et], 0, 0, 0);
#pragma unroll
                for (int i = 0; i < 4; ++i) Sn[(16 * et + 4 * g + i) * LD + 16 * dt + cl] = hbf(Sr[et][i]); }
        }
        LBAR();
    }
#undef HT
#undef HGRN_LOAD
#undef HGRN_LOAD_GATE
#undef HGRN_A1
#undef HGRN_TILES
}

typedef float f32x16 __attribute__((ext_vector_type(16)));
__device__ __forceinline__ float swap32_sum(float x) { auto q = __builtin_amdgcn_permlane32_swap(__float_as_uint(x), __float_as_uint(x), false, false); return __uint_as_float(q[0]) + __uint_as_float(q[1]); }
__device__ __forceinline__ float swap32_max(float x) { auto q = __builtin_amdgcn_permlane32_swap(__float_as_uint(x), __float_as_uint(x), false, false); return fmaxf(__uint_as_float(q[0]), __uint_as_float(q[1])); }
__device__ __forceinline__ float swap32_partner(float x, int lane) { auto q = __builtin_amdgcn_permlane32_swap(__float_as_uint(x), __float_as_uint(x), false, false); return __uint_as_float((lane & 32) ? q[0] : q[1]); }
__device__ __forceinline__ void swa_loop(const Frame& F, ArgsP a, int layer, gu32* qctr, int ubase, unsigned limit) {
    const int tid_ = F.wave * 64 + lane_id(); const int tid = tid_, lane = tid & 63, w = F.wave;
    const bf16* Y0 = (const bf16*)(a->ws + WS_BIG); bf16* MIX0 = (bf16*)(a->ws + WS_MIX); const float* rope = (const float*)(a->ws + WS_ROPE);
    constexpr int LDK = 72;
    LAS bf16* Ks = (LAS bf16*)(F.lds); LAS bf16* Vs = Ks + 256 * LDK; LAS bf16* St = Vs + 256 * LDK + w * 32 * LDK;
    LAS float* gsh = (LAS float*)(Vs + 256 * LDK + 8 * 32 * LDK);
    volatile LAS unsigned* qslot = (volatile LAS unsigned*)(F.lds + MISC_OFF) + 12;
    const int qq = lane & 31, hh = lane >> 5, kk = tid >> 1, half = tid & 1;
    unsigned nxt_ = 0u;
    if (tid == 0) { *qslot = __hip_atomic_fetch_add(qctr, 1u, __ATOMIC_RELAXED, __HIP_MEMORY_SCOPE_AGENT); }
    if (tid < 64) gsh[tid] = a->swa_k_g[layer * 64 + tid]; else if (tid < 128) gsh[tid] = a->swa_q_g[layer * 64 + tid - 64]; else if (tid < 136) gsh[tid] = a->swa_sinks[layer * 8 + tid - 128];
    __syncthreads(); unsigned cur_u = *qslot; __syncthreads();
    if (cur_u >= limit) return;
    if (tid == 0) nxt_ = __hip_atomic_fetch_add(qctr, 1u, __ATOMIC_RELAXED, __HIP_MEMORY_SCOPE_AGENT);
    u32x4 kraw[4], vraw[4];
#define SWA_PREFETCH(u_) do { const int un_ = ubase + (int)(u_); const int qb_ = un_ & 15, kvh_ = (un_ >> 4) & 1, b_ = un_ >> 5; const int tk_ = max((qb_ - 1) * 128 + kk, 0); \
        { const bf16* yr_ = Y0 + (size_t)b_ * (Y_BLK / 2) + ((size_t)b_ * SEQ + tk_) * NY; \
            _Pragma("unroll") for (int q = 0; q < 4; ++q) { kraw[q] = *(const u32x4*)(yr_ + YC_SK + kvh_ * 64 + 32 * half + 8 * q); vraw[q] = *(const u32x4*)(yr_ + YC_SV + kvh_ * 64 + 32 * half + 8 * q); } } } while (0)
    u32x4 qraw[4]; f32x4 qrope[4];
#define SWA_LOADQ(u_, g_) do { const int un_ = ubase + (int)(u_); const int qb_ = un_ & 15, kvh_ = (un_ >> 4) & 1, b_ = un_ >> 5; \
        const size_t row_ = (size_t)b_ * SEQ + qb_ * 128 + (w & 1) * 64 + (g_) * 32 + qq; const bf16* yr_ = Y0 + (size_t)b_ * (Y_BLK / 2) + row_ * NY + YC_SQ + (kvh_ * 4 + (w >> 1)) * 64 + 8 * hh; \
        _Pragma("unroll") for (int t = 0; t < 4; ++t) { qraw[t] = *(const u32x4*)(yr_ + 16 * t); qrope[t] = *(const f32x4*)(rope + row_ * 16 + 4 * t); } } while (0)
    SWA_PREFETCH(cur_u);
    SWA_LOADQ(cur_u, 0);
    for (;;) {
    const int unit = ubase + (int)cur_u; const int qb = unit & 15, kvh = (unit >> 4) & 1, b = unit >> 5;
    bf16* MIX = MIX0 + (size_t)b * (MIX_BLK / 2);
    const int qh = kvh * 4 + (w >> 1);
    { const int tk = (qb - 1) * 128 + kk; f32x4 cs[4];
      { const size_t row_ = (size_t)b * SEQ + max(tk, 0);
#pragma unroll
        for (int q = 0; q < 4; ++q) cs[q] = *(const f32x4*)(rope + row_ * 16 + 4 * q); }
      asm volatile("" ::: "memory");
      if (tk >= 0) { float x[32];
#pragma unroll
          for (int q = 0; q < 4; ++q) *(LAS u32x4*)(Vs + kk * LDK + 32 * half + 8 * q) = vraw[q];
#pragma unroll
          for (int q = 0; q < 4; ++q) { f32x4 v0, v1; pg8::unpack8(kraw[q], v0, v1);
#pragma unroll
              for (int i = 0; i < 4; ++i) { x[8 * q + i] = v0[i]; x[8 * q + 4 + i] = v1[i]; } }
          float s = 0.f;
#pragma unroll
          for (int i = 0; i < 32; ++i) s += x[i] * x[i];
          s += dpp_f<0xB1>(s); const float rs = rsqrtf(s * (1.0f / 64.0f) + EPS);
#pragma unroll
          for (int q = 0; q < 8; ++q) { const f32x4 gk = *(const LAS f32x4*)(gsh + 32 * half + 4 * q);
#pragma unroll
              for (int i = 0; i < 4; ++i) x[4 * q + i] = x[4 * q + i] * rs * gk[i]; }
          if (half == 0) {
#pragma unroll
              for (int q = 0; q < 4; ++q) {
#pragma unroll
                  for (int e = 0; e < 2; ++e) { const int i = 2 * q + e; const float c_ = cs[q][2 * e], s_ = cs[q][2 * e + 1]; const float x1 = x[i], x2 = x[8 + i]; x[i] = x1 * c_ - x2 * s_; x[8 + i] = x2 * c_ + x1 * s_; } } }
#pragma unroll
          for (int q = 0; q < 4; ++q) { const f32x4 v0 = {x[8 * q], x[8 * q + 1], x[8 * q + 2], x[8 * q + 3]}, v1 = {x[8 * q + 4], x[8 * q + 5], x[8 * q + 6], x[8 * q + 7]}; *(LAS u32x4*)(Ks + kk * LDK + 32 * half + 8 * q) = pg8::pack8(v0, v1); } }
      else { unsigned z0 = 0u; asm volatile("" : "+v"(z0)); const u32x4 z = {z0, z0, z0, z0};
#pragma unroll
          for (int q = 0; q < 4; ++q) { *(LAS u32x4*)(Ks + kk * LDK + 32 * half + 8 * q) = z; *(LAS u32x4*)(Vs + kk * LDK + 32 * half + 8 * q) = z; } } }
    if (tid == 0) *qslot = nxt_;
    __syncthreads();
    const unsigned nxt_u = *qslot;
    const unsigned pf_u = nxt_u < limit ? nxt_u : cur_u;
    if (nxt_u < limit && tid == 0) nxt_ = __hip_atomic_fetch_add(qctr, 1u, __ATOMIC_RELAXED, __HIP_MEMORY_SCOPE_AGENT);
    SWA_PREFETCH(pf_u);
    const float sink2 = gsh[128 + qh] * 1.4426950408889634f;
    const LAS float* gq = gsh + 64;
#pragma unroll
    for (int grp = 0; grp < 2; ++grp) {
        const int q0 = (w & 1) * 64 + grp * 32, T0 = q0 >> 5;
        bf16x8 qf[4];
        { f32x4 v[4][2]; float s = 0.f;
#pragma unroll
          for (int t = 0; t < 4; ++t) { pg8::unpack8(qraw[t], v[t][0], v[t][1]);
#pragma unroll
              for (int i = 0; i < 4; ++i) s += v[t][0][i] * v[t][0][i] + v[t][1][i] * v[t][1][i]; }
          s = swap32_sum(s); const float rs = rsqrtf(s * (1.0f / 64.0f) + EPS) * (0.125f * 1.4426950408889634f);
#pragma unroll
          for (int t = 0; t < 4; ++t) { const f32x4 g0 = *(const LAS f32x4*)(gq + 16 * t + 8 * hh), g1 = *(const LAS f32x4*)(gq + 16 * t + 8 * hh + 4);
#pragma unroll
              for (int i = 0; i < 4; ++i) { v[t][0][i] *= rs * g0[i]; v[t][1][i] *= rs * g1[i]; } }
          { const float cs_[8] = {qrope[0][0], qrope[0][2], qrope[1][0], qrope[1][2], qrope[2][0], qrope[2][2], qrope[3][0], qrope[3][2]};
            const float sn_[8] = {qrope[0][1], qrope[0][3], qrope[1][1], qrope[1][3], qrope[2][1], qrope[2][3], qrope[3][1], qrope[3][3]};
#pragma unroll
            for (int i = 0; i < 4; ++i) { const float p0 = swap32_partner(v[0][0][i], lane), p1 = swap32_partner(v[0][1][i], lane);
                if (hh == 0) { v[0][0][i] = v[0][0][i] * cs_[i] - p0 * sn_[i]; v[0][1][i] = v[0][1][i] * cs_[4 + i] - p1 * sn_[4 + i]; }
                else { v[0][0][i] = v[0][0][i] * cs_[i] + p0 * sn_[i]; v[0][1][i] = v[0][1][i] * cs_[4 + i] + p1 * sn_[4 + i]; } } }
#pragma unroll
          for (int t = 0; t < 4; ++t) qf[t] = __builtin_bit_cast(bf16x8, pg8::pack8(v[t][0], v[t][1])); }
        if (grp == 0) SWA_LOADQ(cur_u, 1); else SWA_LOADQ(pf_u, 0);
        f32x16 x[5];
#pragma unroll
        for (int k = 0; k < 5; ++k) { f32x16 acc = {};
            if (!(qb == 0 && T0 + k < 4)) {
#pragma unroll
                for (int t = 0; t < 4; ++t) acc = __builtin_amdgcn_mfma_f32_32x32x16_bf16(*(const LAS bf16x8*)(Ks + (32 * (T0 + k) + qq) * LDK + 16 * t + 8 * hh), qf[t], acc, 0, 0, 0); }
            x[k] = acc; }
        float mx = sink2;
#pragma unroll
        for (int k = 0; k < 5; ++k) { const bool dead = (qb == 0 && T0 + k < 4);
#pragma unroll
            for (int i = 0; i < 16; ++i) { const int kr = (i & 3) + 8 * (i >> 2) + 4 * hh; bool ok = (k == 0) ? (kr > qq) : ((k == 4) ? (kr <= qq) : true); if (dead) ok = false; if (!ok) x[k][i] = -INFINITY; mx = fmaxf(mx, x[k][i]); } }
        mx = swap32_max(mx);
        float ls = 0.f; f32x16 o[2]; o[0] = (f32x16){}; o[1] = (f32x16){};
#pragma unroll
        for (int k = 0; k < 5; ++k) {
#pragma unroll
            for (int i = 0; i < 16; ++i) { x[k][i] = __builtin_amdgcn_exp2f(x[k][i] - mx); ls += x[k][i]; }
#pragma unroll
            for (int s = 0; s < 2; ++s) { u32x4 pw; pw.x = cvtpk(x[k][8 * s], x[k][8 * s + 1]); pw.y = cvtpk(x[k][8 * s + 2], x[k][8 * s + 3]); pw.z = cvtpk(x[k][8 * s + 4], x[k][8 * s + 5]); pw.w = cvtpk(x[k][8 * s + 6], x[k][8 * s + 7]);
                const bf16x8 pf = __builtin_bit_cast(bf16x8, pw);
                const int gg = lane >> 4, tq = (lane >> 2) & 3, tp = lane & 3; const LAS bf16* vb = Vs + (32 * (T0 + k) + 16 * s + 4 * (gg >> 1) + tq) * LDK + 16 * (gg & 1) + 4 * tp;
#pragma unroll
                for (int et = 0; et < 2; ++et) { const v4i16_t lo = __builtin_amdgcn_ds_read_tr16_b64_v4i16((LAS v4i16_t*)(vb + 32 * et)), hi = __builtin_amdgcn_ds_read_tr16_b64_v4i16((LAS v4i16_t*)(vb + 8 * LDK + 32 * et));
                    const bf16x8 vf = {lo[0], lo[1], lo[2], lo[3], hi[0], hi[1], hi[2], hi[3]};
                    o[et] = __builtin_amdgcn_mfma_f32_32x32x16_bf16(vf, pf, o[et], 0, 0, 0); } } }
        ls = swap32_sum(ls); const float inv = frcp(ls + __builtin_amdgcn_exp2f(sink2 - mx));
#pragma unroll
        for (int et = 0; et < 2; ++et)
#pragma unroll
            for (int blk = 0; blk < 4; ++blk) { u32x2 pv; pv.x = cvtpk(o[et][4 * blk] * inv, o[et][4 * blk + 1] * inv); pv.y = cvtpk(o[et][4 * blk + 2] * inv, o[et][4 * blk + 3] * inv); *(LAS u32x2*)(St + qq * LDK + 32 * et + 8 * blk + 4 * hh) = pv; }
        asm volatile("s_waitcnt lgkmcnt(0)" ::: "memory");
        { const size_t orow = (size_t)b * SEQ + qb * 128 + q0;
#pragma unroll
          for (int it = 0; it < 4; ++it) { const int r = it * 8 + (lane >> 3), ch = lane & 7; const u32x4 v = *(const LAS u32x4*)(St + r * LDK + ch * 8); *(u32x4*)(MIX + (orow + r) * DM + 512 + qh * 64 + ch * 8) = v; } }
        asm volatile("s_waitcnt lgkmcnt(0)" ::: "memory");
    }
    __syncthreads();
    if (nxt_u >= limit) break;
    cur_u = nxt_u;
    }
#undef SWA_PREFETCH
#undef SWA_LOADQ
}
constexpr int N_PHASES = 1 + 6 * DEPTH;
#ifndef REPEAT_PRO
#define REPEAT_PRO 1
#endif
#ifndef REPEAT_HGRN
#define REPEAT_HGRN 1
#endif
#ifndef REPEAT_MLSTM
#define REPEAT_MLSTM 1
#endif
#ifndef REPEAT_SWA
#define REPEAT_SWA 1
#endif
#ifndef EXTRA_BARRIERS
#define EXTRA_BARRIERS 0
#endif
#ifndef REP_IN
#define REP_IN 1
#endif
#ifndef REP_OUT
#define REP_OUT 1
#endif
#ifndef REP_UP
#define REP_UP 1
#endif
#ifndef REP_DOWN
#define REP_DOWN 1
#endif
#ifndef REP_PLE
#define REP_PLE 1
#endif
#ifndef REP_GATE
#define REP_GATE 1
#endif
__device__ __forceinline__ void grp_barrier(unsigned* base  , unsigned x, unsigned sh  ) {
    asm volatile("s_waitcnt vmcnt(0)" ::: "memory");
    __syncthreads();
    if (threadIdx.x == 0) {
        unsigned* ctr = base + CW_LBAR + 128 * x; unsigned* gen = ctr + 64; unsigned* tmo = base + CW_BAR + XB_TMO;
        __builtin_amdgcn_s_waitcnt(0);
        const unsigned old = xb_add(ctr, 1u); const unsigned g = old >> sh;
        if (((old + 1u) & ((1u << sh) - 1u)) == 0u) xb_add(gen, 1u);
        else XB_SPIN(xb_ld(gen) == g, base + CW_BAR);
        (void)tmo;
        __builtin_amdgcn_fence(__ATOMIC_ACQUIRE, "agent");
        asm volatile("s_waitcnt vmcnt(0)" ::: "memory");
    }
    __syncthreads();
}
__global__ void __launch_bounds__(NWAVES * 64, 2) trunk_fwd(Args args) {
    extern __shared__ __attribute__((aligned(16))) unsigned char lds_raw[];
    Frame F; F.lds = (LAS unsigned char*)lds_raw; F.wave = __builtin_amdgcn_readfirstlane((int)threadIdx.x >> 6); F.G = gridDim.x; F.gw = blockIdx.x * NWAVES + F.wave; F.NGW = F.G * NWAVES;
    for (int u = threadIdx.x; u < (LDS_BYTES - LDSCTL_OFF) / 4; u += NWAVES * 64) ((LAS unsigned*)(F.lds + LDSCTL_OFF))[u] = 0u;
    __syncthreads();
    const int lo = get_args()->ph_lo, hi = get_args()->ph_hi;
    volatile LAS unsigned* MISCW = (volatile LAS unsigned*)(F.lds + MISC_OFF);
    if (hi - lo > 1 && threadIdx.x == 0) { unsigned* barw = (unsigned*)((gu32*)(get_args()->ws + WS_CTL) + CW_BAR); const unsigned x_ = xb_xcc_id(); MISCW[11] = x_; MISCW[10] = xb_add(&barw[XB_XCNT(x_)], 1u); }
#ifndef REPEAT_MIX
#define REPEAT_MIX 1
#endif
#ifndef PHASE_MASK
#define PHASE_MASK 0xffff
#endif
#ifndef FORCE_GLOBAL
#define FORCE_GLOBAL 0
#endif
#ifndef GROUP_WGS
#define GROUP_WGS 32
#endif
#define PHM(b) ((PHASE_MASK >> (b)) & 1)
#ifndef PROBE_STAMP
#define PROBE_STAMP -1
#endif
#ifndef PROBE_SCALE
#define PROBE_SCALE 1
#endif
#ifndef PROBE_WG
#define PROBE_WG 0
#endif
#ifndef PROBE_CLOCK
#define PROBE_CLOCK 0
#endif
#define TS_BEGIN(k) do { if (PROBE_STAMP == (k) && (PROBE_WG < 0 || blockIdx.x == PROBE_WG) && threadIdx.x == 0) { MISCW[20] = (unsigned)__builtin_amdgcn_s_memrealtime(); MISCW[22] = (unsigned)__builtin_amdgcn_s_memtime(); } } while (0)
#define TS_END(k) do { if (PROBE_STAMP == (k) && (PROBE_WG < 0 || blockIdx.x == PROBE_WG) && threadIdx.x == 0) { MISCW[21] += (unsigned)__builtin_amdgcn_s_memrealtime() - MISCW[20]; MISCW[23] += (unsigned)__builtin_amdgcn_s_memtime() - MISCW[22]; } } while (0)
#define IN(k) (lo <= (k) && (k) < hi)
#define GLOBAL_BAR() do { XcdBarrier bar_; bar_.bar = (unsigned*)((gu32*)(get_args()->ws + WS_CTL) + CW_BAR); bar_.x = xb_xcc_id(); bar_.st = (volatile LAS unsigned*)(F.lds + MISC_OFF) + 8; xcd_barrier(bar_); } while (0)
#ifndef PAIR_SEAMS
#define PAIR_SEAMS 0
#endif
#define CW_PBAR (CW_QBAR + 128 * 64)
#define SEAM(k) do { if (IN(k) && IN((k) + 1)) { TS_BEGIN(7); if (F.local) { if (PAIR_SEAMS && F.gsz == 32) grp_barrier((unsigned*)((gu32*)(get_args()->ws + WS_CTL)) + (CW_PBAR - CW_LBAR), (unsigned)(F.grp >> 1), 6u); else grp_barrier((unsigned*)((gu32*)(get_args()->ws + WS_CTL)), (unsigned)F.grp, F.gsz == 8 ? 3u : 5u); } else GLOBAL_BAR(); TS_END(7); } } while (0)
#define SEAM_OWN(k) do { if (IN(k) && IN((k) + 1)) { if (F.local && F.gsz == 32) { TS_BEGIN(7); grp_barrier((unsigned*)((gu32*)(get_args()->ws + WS_CTL)) + (CW_QBAR - CW_LBAR), (unsigned)(8 * F.grp + (F.ceff & 7)), 2u); TS_END(7); } else if (!(F.local && F.gsz == 8)) SEAM(k); } } while (0)
#define PHASE_BEGIN ArgsP ap = get_args(); unsigned char* ws = ap->ws; ss_t* stats = (ss_t*)(ws + WS_STATS); bf16* Yb = (bf16*)(ws + WS_BIG); bf16* MIXb = (bf16*)(ws + WS_MIX); bf16* HID = (bf16*)(ws + WS_BIG); bf16* ERAW = (bf16*)(ws + WS_ERAW); \
        bf16* XBc = (bf16*)(ws + ((l & 1) ? WS_XB1 : WS_XB0)); bf16* XBn = (bf16*)(ws + ((l & 1) ? WS_XB0 : WS_XB1)); (void)stats; (void)Yb; (void)MIXb; (void)HID; (void)ERAW; (void)XBc; (void)XBn;
#define ORDER(N_) pg8::GroupOrder S; S.init(F.local ? F.gsz : M / 256, F.local ? F.gsz * F.grp : 0, (N_), F.gsz, F.ceff, F.local ? 0 : 1)

    F.local = 0; F.grp = 0; F.gsz = F.G; F.ceff = (int)blockIdx.x;
    TS_BEGIN(8); TS_BEGIN(0);
    if (PHM(6) && IN(0)) { for (int rp_ = 0; rp_ < REPEAT_PRO; ++rp_) p0_prologue(F, get_args()); }
    if (IN(0) && IN(1)) {
        GLOBAL_BAR();
        if (threadIdx.x == 0) { unsigned* barw = (unsigned*)((gu32*)(get_args()->ws + WS_CTL) + CW_BAR); unsigned ok = (gridDim.x == 256u) ? 1u : 0u;
#pragma unroll
            for (int j = 0; j < 16; ++j) { const unsigned c_ = xb_ld(&barw[XB_XCNT(j)]); if (c_ != (j < 8 ? 32u : 0u)) ok = 0u; }
            if (FORCE_GLOBAL) ok = 0u;
            MISCW[13] = ok; }
        __syncthreads();
        if (MISCW[13]) { const int x_ = (int)MISCW[11], r_ = (int)MISCW[10]; F.local = 1; F.gsz = GROUP_WGS; F.grp = x_ * (32 / GROUP_WGS) + r_ / GROUP_WGS; F.ceff = r_ % GROUP_WGS; }
        F.local = __builtin_amdgcn_readfirstlane(F.local); F.grp = __builtin_amdgcn_readfirstlane(F.grp); F.ceff = __builtin_amdgcn_readfirstlane(F.ceff); F.gsz = __builtin_amdgcn_readfirstlane(F.gsz);
    }

    TS_END(0);
    for (int l = 0; l < DEPTH; ++l) {
        const int pb = 1 + 6 * l;
        TS_BEGIN(1); if (PHM(0) && IN(pb)) { PHASE_BEGIN pg8::Gemm g{XBc, (const bf16*)(ws + WS_WIN) + (size_t)l * NY * DM, M, NY, DM, DM, 0}; ORDER(NY);
            pg8::EpiIn E{Yb, NY, (const float*)(ws + WS_BIASY) + l * NY, stats + (size_t)(SS_IN + l) * M, Y_BLK / 2};
            for (int rr_ = 0; rr_ < REP_IN; ++rr_) pg8::gemm_phase<pg8::EpiIn, pg8::GroupOrder, true, true>(F.lds, g, S, E, F.wave); }
        TS_END(1); SEAM(pb);
        TS_BEGIN(2); if (PHM(1) && IN(pb + 1)) { for (int rep_ = 0; rep_ < REPEAT_MIX; ++rep_) {
            const int ntask = F.local ? F.gsz : 256, half_ = ntask >> 1, bh0 = F.local ? half_ * F.grp : 0;
            for (int task = F.ceff; task < ntask; task += F.gsz) {
                if (task < half_) { TS_BEGIN(9); for (int r1_ = 0; r1_ < REPEAT_MLSTM; ++r1_) mlstm_task(F, get_args(), l, bh0 + task); TS_END(9); } else { TS_BEGIN(10); for (int r2_ = 0; r2_ < REPEAT_HGRN; ++r2_) hgrn_task(F, get_args(), l, bh0 + task - half_); TS_END(10); } }
            swa_loop(F, get_args(), l, (gu32*)(get_args()->ws + WS_CTL) + CW_QUEUE + 64 * (32 * l + F.grp) + 16 * rep_, F.local ? 4 * F.gsz * F.grp : 0, F.local ? (unsigned)(4 * F.gsz) : 1024u); } }
        TS_END(2); SEAM(pb + 1);
        TS_BEGIN(3); if (PHM(2) && IN(pb + 2)) { PHASE_BEGIN pg8::Gemm g{MIXb, (const bf16*)(ws + WS_WOUT) + (size_t)l * DM * DM, M, DM, DM, DM, MIX_BLK}; ORDER(DM);
            for (int rr_ = 0; rr_ < REP_OUT; ++rr_) { pg8::EpiRes E{XBc, rr_ ? XBn : XBc, DM, rr_ ? (ss_t*)(ws + WS_CTL + 512 * 1024) : stats + (size_t)(SS_MLP + l) * M};
            pg8::gemm_phase<pg8::EpiRes, pg8::GroupOrder, true, true>(F.lds, g, S, E, F.wave); } }
        TS_END(3); SEAM(pb + 2);
        TS_BEGIN(4); if (PHM(3) && IN(pb + 3)) { PHASE_BEGIN pg8::Gemm g{XBc, (const bf16*)(ws + WS_WUP) + (size_t)l * FF * DM, M, FF, DM, DM, 0}; ORDER(FF);
            pg8::EpiUp E{HID, FF, stats + (size_t)(SS_MLP + l) * M};
            for (int rr_ = 0; rr_ < REP_UP; ++rr_) pg8::gemm_phase<pg8::EpiUp, pg8::GroupOrder, true, true>(F.lds, g, S, E, F.wave); }
        TS_END(4); SEAM_OWN(pb + 3);
        TS_BEGIN(5); if (PHM(4) && IN(pb + 4)) {
            { PHASE_BEGIN pg8::Gemm g{HID, (const bf16*)(ws + WS_WDN) + (size_t)l * DM * FF, M, DM, FF, FF, 0}; ORDER(DM);
              for (int rr_ = 0; rr_ < REP_DOWN; ++rr_) { pg8::EpiRes E{XBc, rr_ ? XBn : XBc, DM, rr_ ? (ss_t*)(ws + WS_CTL + 512 * 1024) : stats + (size_t)(SS_PLE + l) * M};
              pg8::gemm_phase<pg8::EpiRes, pg8::GroupOrder, true, true>(F.lds, g, S, E, F.wave); } }
            int go2_ = 1; asm volatile("" : "+s"(go2_));
            if (go2_) { PHASE_BEGIN pg8::Gemm g{(const bf16*)ap->out + (size_t)l * PLE, (const bf16*)(ws + WS_WP) + (size_t)l * DM * PLE, M, DM, PLE, 2048, 0}; ORDER(DM);
              for (int rr_ = 0; rr_ < REP_PLE; ++rr_) { pg8::EpiPle E{ERAW, DM, rr_ ? (ss_t*)(ws + WS_CTL + 512 * 1024) : stats + (size_t)(SS_E + l) * M, ap->ple_post_g + l * DM};
              pg8::gemm_phase<pg8::EpiPle, pg8::GroupOrder, true, true>(F.lds, g, S, E, F.wave); } } }
        TS_END(5); SEAM_OWN(pb + 4);
        TS_BEGIN(6); if (PHM(5) && IN(pb + 5)) { PHASE_BEGIN pg8::Gemm g{XBc, (const bf16*)(ws + WS_WG) + (size_t)l * DM * DM, M, DM, DM, DM, 0}; ORDER(DM);
            const bool last = (l == DEPTH - 1);
            if (!last) { for (int rr_ = 0; rr_ < REP_GATE; ++rr_) { pg8::EpiGate<false> E{XBc, XBn, nullptr, ERAW, DM, stats + (size_t)(SS_PLE + l) * M, stats + (size_t)(SS_E + l) * M, rr_ ? (ss_t*)(ws + WS_CTL + 512 * 1024) : stats + (size_t)(SS_IN + l + 1) * M};
                pg8::gemm_phase<pg8::EpiGate<false>, pg8::GroupOrder, true, true>(F.lds, g, S, E, F.wave); } }
            else { for (int rr_ = 0; rr_ < REP_GATE; ++rr_) { pg8::EpiGate<true> E{XBc, XBn, ap->out, ERAW, DM, stats + (size_t)(SS_PLE + l) * M, stats + (size_t)(SS_E + l) * M, nullptr};
                pg8::gemm_phase<pg8::EpiGate<true>, pg8::GroupOrder, true, true>(F.lds, g, S, E, F.wave); } } }
        TS_END(6); SEAM(pb + 5);
    }
    TS_END(8);
    if (PROBE_STAMP >= 0 && (PROBE_WG < 0 || blockIdx.x == PROBE_WG) && threadIdx.x == 0) { const unsigned long long w_ = PROBE_CLOCK ? (unsigned long long)MISCW[23] * 10000ull / (MISCW[21] ? MISCW[21] : 1u) : (unsigned long long)MISCW[21] * PROBE_SCALE;
        const unsigned long long t0_ = __builtin_amdgcn_s_memrealtime(); while (__builtin_amdgcn_s_memrealtime() - t0_ < w_) __builtin_amdgcn_s_sleep(64); }
#undef IN
#undef SEAM
}

#ifndef MK_N_LAUNCHES
#define MK_N_LAUNCHES 1
#endif
extern "C" void kernel_launch(void* const* d_in, const int* in_sizes, int n_in, void* d_out, int out_size, void* d_ws, size_t ws_size, hipStream_t stream) {
    static int grid = 0;
    if (grid == 0) {
        if (n_in != 23 || in_sizes[0] != M * DM || out_size != M * DM || ws_size < WS_END) { fprintf(stderr, "kernel_launch: unexpected shapes (n_in %d in0 %d out %d ws %zu); nothing launched\n", n_in, n_in > 0 ? in_sizes[0] : -1, out_size, ws_size); grid = -1; return; }
        int dev = 0, cus = 0, per_cu = 0;
        if (hipGetDevice(&dev) != hipSuccess || hipDeviceGetAttribute(&cus, hipDeviceAttributeMultiprocessorCount, dev) != hipSuccess) { grid = -1; return; }
        if (hipFuncSetAttribute((const void*)trunk_fwd, hipFuncAttributeMaxDynamicSharedMemorySize, LDS_BYTES) != hipSuccess) { fprintf(stderr, "kernel_launch: hipFuncSetAttribute failed\n"); grid = -1; return; }
        if (hipOccupancyMaxActiveBlocksPerMultiprocessor(&per_cu, (const void*)trunk_fwd, NWAVES * 64, LDS_BYTES) != hipSuccess || per_cu < 1) { fprintf(stderr, "kernel_launch: occupancy query says %d blocks per CU\n", per_cu); }
        (void)hipGetLastError();
        grid = cus;
    }
    if (grid < 0) return;
    if (hipMemsetAsync((char*)d_ws, 0, ZERO_BYTES, stream) != hipSuccess) return;
    Args a{};
    a.x = (const float*)d_in[0]; a.p = (const float*)d_in[1]; a.pos = (const int*)d_in[2];
    a.in_norm_g = (const float*)d_in[3]; a.w_in = (const float*)d_in[4]; a.b_in = (const float*)d_in[5]; a.mlstm_f_bias = (const float*)d_in[6]; a.conv_w = (const float*)d_in[7]; a.conv_b = (const float*)d_in[8];
    a.mlstm_norm_g = (const float*)d_in[9]; a.hgrn_lb_logits = (const float*)d_in[10]; a.hgrn_norm_g = (const float*)d_in[11]; a.swa_q_g = (const float*)d_in[12]; a.swa_k_g = (const float*)d_in[13]; a.swa_sinks = (const float*)d_in[14];
    a.w_out = (const float*)d_in[15]; a.mlp_norm_g = (const float*)d_in[16]; a.w_up = (const float*)d_in[17]; a.w_down = (const float*)d_in[18]; a.ple_norm_g = (const float*)d_in[19]; a.w_ple_gate = (const float*)d_in[20];
    a.w_ple_proj = (const float*)d_in[21]; a.ple_post_g = (const float*)d_in[22];
    a.out = (float*)d_out; a.ws = (unsigned char*)d_ws;
    for (int i = 0; i < 8; ++i) a.rope_rev[i] = pow(500000.0, -(double)i / 8.0) / 6.283185307179586476925286766559;
#if MK_N_LAUNCHES == 1
    a.ph_lo = 0; a.ph_hi = N_PHASES;
    hipLaunchKernelGGL(trunk_fwd, dim3(grid), dim3(NWAVES * 64), LDS_BYTES, stream, a);
#else
    for (int ph = 0; ph < N_PHASES; ++ph) { a.ph_lo = ph; a.ph_hi = ph + 1; hipLaunchKernelGGL(trunk_fwd, dim3(grid), dim3(NWAVES * 64), LDS_BYTES, stream, a); }
#endif
}
```
